# Optimizing an MI355X kernel written in HIP

```python
import math
import jax, jax.numpy as jnp
from jax import lax
import numpy as np

D_MODEL = 1024
BATCH = 8
SEQ = 4096
DEPTH = 4

CHUNK = 64
N_MIXERS = 3
EPS = 1e-6

GLA_HEADS = 4
GLA_DK = D_MODEL // 2
GLA_DV = D_MODEL
GLA_DKH = GLA_DK // GLA_HEADS
GLA_DVH = GLA_DV // GLA_HEADS
GLA_RANK = 16
GLA_TAU = 16.0
GLA_IN = 2 * GLA_DK + 2 * GLA_DV + GLA_RANK

CONV_WIDTH = 31

FOX_HEADS = 16
FOX_DH = D_MODEL // FOX_HEADS
FOX_IN = 4 * D_MODEL + FOX_HEADS
Q_BLOCK = 128

D_FF = 2816
N_EXPERTS = 8
TOP_K = 2
D_FF_EXPERT = 3584
MOE_BLOCK = 512

kernel_name = "hybrid_gla_conformer_fox_moe_adaln"


def rms_norm(x, g=None):
    xf = x.astype(jnp.float32)
    y = xf * lax.rsqrt(jnp.mean(xf * xf, axis=-1, keepdims=True) + EPS)
    if g is not None:
        y = y * g.astype(jnp.float32)
    return y.astype(x.dtype)


def gla_mixer(h, w_in, w_gate2, b_gate, gn_g, w_out):
    B, S, _ = h.shape
    nc = S // CHUNK
    f32 = jnp.float32
    q, k, v, r, glr = jnp.split(h @ w_in, [GLA_DK, 2 * GLA_DK, 2 * GLA_DK + GLA_DV,
                                          2 * GLA_DK + 2 * GLA_DV], axis=-1)
    log_a = jax.nn.log_sigmoid((glr @ w_gate2 + b_gate).astype(f32)) / GLA_TAU

    def to_chunks(t, dh):
        return jnp.moveaxis(t.reshape(B, nc, CHUNK, GLA_HEADS, dh), 1, 0)

    qc = to_chunks(q, GLA_DKH).astype(f32) * (GLA_DKH ** -0.5)
    kc = to_chunks(k, GLA_DKH).astype(f32)
    vc = to_chunks(v, GLA_DVH).astype(f32)
    cum = jnp.cumsum(to_chunks(log_a, GLA_DKH), axis=2)
    tot = cum[:, :, -1]
    kd = kc * jnp.exp(tot[:, :, None] - cum)

    def step(state, inp):
        q_i, kd_i, v_i, tot_i = inp
        state = state * jnp.exp(tot_i)[..., None] + jnp.einsum('bchk,bchv->bhkv', kd_i, v_i)
        o_i = jnp.einsum('bchk,bhkv->bchv', q_i, state)
        return state, o_i

    s0 = jnp.zeros((B, GLA_HEADS, GLA_DKH, GLA_DVH), f32)
    _, o = lax.scan(step, s0, (qc, kd, vc, tot))
    o = jnp.moveaxis(o, 0, 1).reshape(B, S, GLA_HEADS, GLA_DVH)
    o = rms_norm(o, gn_g.reshape(GLA_HEADS, GLA_DVH)).astype(h.dtype).reshape(B, S, GLA_DV)
    return (o * jax.nn.silu(r)) @ w_out


def conv_mixer(h, w_in, b_in, dw, dw_b, ln_g, ln_b, w_out, b_out):
    a, g = jnp.split(h @ w_in + b_in, 2, axis=-1)
    u = a * jax.nn.sigmoid(g)
    u = lax.conv_general_dilated(u, dw[:, None, :].astype(u.dtype), window_strides=(1,),
                                 padding=[(CONV_WIDTH - 1, 0)],
                                 dimension_numbers=('NWC', 'WIO', 'NWC'),
                                 feature_group_count=D_MODEL) + dw_b
    uf = u.astype(jnp.float32)
    mu = jnp.mean(uf, axis=-1, keepdims=True)
    var = jnp.mean(jnp.square(uf - mu), axis=-1, keepdims=True)
    u = ((uf - mu) * lax.rsqrt(var + EPS) * ln_g + ln_b).astype(h.dtype)
    return jax.nn.silu(u) @ w_out + b_out


def fox_mixer(h, w_in, b_f, qn_g, kn_g, w_out):
    B, S, D = h.shape
    f32 = jnp.float32
    q, k, v, fl, og = jnp.split(h @ w_in, [D, 2 * D, 3 * D, 3 * D + FOX_HEADS], axis=-1)
    q = rms_norm(q.reshape(B, S, FOX_HEADS, FOX_DH), qn_g)
    k = rms_norm(k.reshape(B, S, FOX_HEADS, FOX_DH), kn_g)
    v = v.reshape(B, S, FOX_HEADS, FOX_DH)
    cum = jnp.cumsum(jax.nn.log_sigmoid((fl + b_f).astype(f32)), axis=1)
    cum_k = jnp.transpose(cum, (0, 2, 1))
    nb = S // Q_BLOCK
    qb = jnp.moveaxis(q.reshape(B, nb, Q_BLOCK, FOX_HEADS, FOX_DH), 1, 0)
    cq = jnp.moveaxis(cum_k.reshape(B, FOX_HEADS, nb, Q_BLOCK), 2, 0)
    kpos = jnp.arange(S)
    scale = FOX_DH ** -0.5

    def block(args):
        q_i, c_i, i = args
        s = jnp.einsum('bqhd,bkhd->bhqk', q_i, k, preferred_element_type=f32) * scale
        s = s + (c_i[..., None] - cum_k[:, :, None, :])
        qpos = i * Q_BLOCK + jnp.arange(Q_BLOCK)
        s = jnp.where((kpos[None, :] <= qpos[:, None])[None, None], s, -jnp.inf)
        p = jax.nn.softmax(s, axis=-1)
        return jnp.einsum('bhqk,bkhd->bqhd', p.astype(v.dtype), v)

    o = lax.map(block, (qb, cq, jnp.arange(nb)))
    o = jnp.moveaxis(o, 0, 1).reshape(B, S, D)
    return (o * jax.nn.sigmoid(og)) @ w_out


def swiglu(h, w13, w2):
    a, b = jnp.split(h @ w13, 2, axis=-1)
    return (jax.nn.silu(a) * b) @ w2


def moe_swiglu(h, router, w13, w2):
    B, S, D = h.shape
    N = B * S
    xt = h.reshape(N, D)
    top_l, top_e = lax.top_k((xt @ router).astype(jnp.float32), TOP_K)
    gates = jax.nn.softmax(top_l, axis=-1)
    A = N * TOP_K
    e_flat = top_e.reshape(A)
    tok = jnp.arange(A, dtype=jnp.int32) // TOP_K
    order = jnp.argsort(e_flat)
    e_sorted = e_flat[order]
    counts = jnp.bincount(e_flat, length=N_EXPERTS)
    start = jnp.cumsum(counts) - counts
    padded = (counts + MOE_BLOCK - 1) // MOE_BLOCK * MOE_BLOCK
    pad_end = jnp.cumsum(padded)
    pad_start = pad_end - padded
    dest = pad_start[e_sorted] + jnp.arange(A, dtype=jnp.int32) - start[e_sorted]
    n_blocks = -(-A // MOE_BLOCK) + N_EXPERTS
    P = n_blocks * MOE_BLOCK
    slot_tok = jnp.zeros((P,), jnp.int32).at[dest].set(tok[order])
    slot_gate = jnp.zeros((P,), h.dtype).at[dest].set(gates.reshape(A)[order].astype(h.dtype))
    block_e = jnp.minimum(jnp.searchsorted(pad_end, jnp.arange(n_blocks, dtype=jnp.int32) * MOE_BLOCK,
                                           side='right'), N_EXPERTS - 1)

    def run_block(args):
        toks, g, e = args
        a, u = jnp.split(xt[toks] @ w13[e], 2, axis=-1)
        return ((jax.nn.silu(a) * u) @ w2[e]) * g[:, None]

    yb = lax.map(run_block, (slot_tok.reshape(n_blocks, MOE_BLOCK),
                             slot_gate.reshape(n_blocks, MOE_BLOCK), block_e))
    y = jnp.zeros_like(xt).at[slot_tok].add(yb.reshape(P, D))
    return y.reshape(B, S, D)


def setup_inputs(seed: int = 0) -> dict:
    key = jax.random.key(seed)
    keys = iter(jax.random.split(key, 48))
    D = D_MODEL
    n_gla = len(range(0, DEPTH, N_MIXERS))
    n_conv = len(range(1, DEPTH, N_MIXERS))
    n_fox = len(range(2, DEPTH, N_MIXERS))
    n_dense = len(range(0, DEPTH, 2))
    n_moe = len(range(1, DEPTH, 2))

    def nrm(shape, scale):
        return jax.random.normal(next(keys), shape, jnp.float32) * scale

    def gain(shape):
        return 1.0 + nrm(shape, 0.1)

    return {
        "x": nrm((BATCH, SEQ, D), 1.0),
        "c": nrm((BATCH, D), 1.0),
        "ada_w": nrm((DEPTH, D, 6 * D), 0.5 * D ** -0.5),
        "ada_b": nrm((DEPTH, 6 * D), 0.02),
        "gla_w_in": nrm((n_gla, D, GLA_IN), D ** -0.5),
        "gla_w_gate2": nrm((n_gla, GLA_RANK, GLA_DK), GLA_RANK ** -0.5),
        "gla_b_gate": 1.5 + nrm((n_gla, GLA_DK), 0.5),
        "gla_gn_g": gain((n_gla, GLA_DV)),
        "gla_w_out": nrm((n_gla, GLA_DV, D), GLA_DV ** -0.5),
        "conv_w_in": nrm((n_conv, D, 2 * D), D ** -0.5),
        "conv_b_in": nrm((n_conv, 2 * D), 0.02),
        "conv_dw": nrm((n_conv, CONV_WIDTH, D), CONV_WIDTH ** -0.5),
        "conv_dw_b": nrm((n_conv, D), 0.02),
        "conv_ln_g": gain((n_conv, D)),
        "conv_ln_b": nrm((n_conv, D), 0.02),
        "conv_w_out": nrm((n_conv, D, D), D ** -0.5),
        "conv_b_out": nrm((n_conv, D), 0.02),
        "fox_w_in": nrm((n_fox, D, FOX_IN), D ** -0.5),
        "fox_b_f": jax.random.uniform(next(keys), (n_fox, FOX_HEADS), jnp.float32, 1.0, 5.0),
        "fox_qn_g": gain((n_fox, FOX_DH)),
        "fox_kn_g": gain((n_fox, FOX_DH)),
        "fox_w_out": nrm((n_fox, D, D), D ** -0.5),
        "ffn_w13": nrm((n_dense, D, 2 * D_FF), D ** -0.5),
        "ffn_w2": nrm((n_dense, D_FF, D), D_FF ** -0.5),
        "moe_router": nrm((n_moe, D, N_EXPERTS), D ** -0.5),
        "moe_w13": nrm((n_moe, N_EXPERTS, D, 2 * D_FF_EXPERT), D ** -0.5),
        "moe_w2": nrm((n_moe, N_EXPERTS, D_FF_EXPERT, D), D_FF_EXPERT ** -0.5),
        "norm_f_g": gain((D,)),
    }


def reference(x, c, ada_w, ada_b,
              gla_w_in, gla_w_gate2, gla_b_gate, gla_gn_g, gla_w_out,
              conv_w_in, conv_b_in, conv_dw, conv_dw_b, conv_ln_g, conv_ln_b, conv_w_out, conv_b_out,
              fox_w_in, fox_b_f, fox_qn_g, fox_kn_g, fox_w_out,
              ffn_w13, ffn_w2, moe_router, moe_w13, moe_w2, norm_f_g):
    cond = jax.nn.silu(c)
    for i in range(DEPTH):
        mod = (cond @ ada_w[i] + ada_b[i])[:, None, :]
        sh1, sc1, g1, sh2, sc2, g2 = jnp.split(mod, 6, axis=-1)
        h = rms_norm(x) * (1 + sc1) + sh1
        m, j = i % N_MIXERS, i // N_MIXERS
        if m == 0:
            y = gla_mixer(h, gla_w_in[j], gla_w_gate2[j], gla_b_gate[j], gla_gn_g[j], gla_w_out[j])
        elif m == 1:
            y = conv_mixer(h, conv_w_in[j], conv_b_in[j], conv_dw[j], conv_dw_b[j],
                           conv_ln_g[j], conv_ln_b[j], conv_w_out[j], conv_b_out[j])
        else:
            y = fox_mixer(h, fox_w_in[j], fox_b_f[j], fox_qn_g[j], fox_kn_g[j], fox_w_out[j])
        x = x + g1 * y
        h = rms_norm(x) * (1 + sc2) + sh2
        if i % 2 == 0:
            y = swiglu(h, ffn_w13[i // 2], ffn_w2[i // 2])
        else:
            y = moe_swiglu(h, moe_router[i // 2], moe_w13[i // 2], moe_w2[i // 2])
        x = x + g2 * y
    return rms_norm(x, norm_f_g)
```

```cpp
#include <hip/hip_runtime.h>
#include <cstdio>
#include <cstdint>
#include <utility>

#ifndef MK_N_LAUNCHES
#define MK_N_LAUNCHES 1
#endif
#ifndef DUP_PH
#define DUP_PH -1
#endif
#define NREP(p) ((DUP_PH == (p)) ? 2 : 1)
#ifndef DUP_NORM
#define DUP_NORM 0
#endif
#ifndef MOE_FP8
#define MOE_FP8 1
#endif
#ifndef FFN_FP8
#define FFN_FP8 1
#endif
#ifndef ABLATE
#define ABLATE -1
#endif

#define LAS __attribute__((address_space(3)))
#define GAS __attribute__((address_space(1)))
typedef unsigned short bf16_t;
typedef short bf16x8 __attribute__((ext_vector_type(8)));
typedef float f32x4 __attribute__((ext_vector_type(4)));
typedef float f32x2 __attribute__((ext_vector_type(2)));
typedef unsigned u32x4 __attribute__((ext_vector_type(4)));
typedef unsigned u32x2 __attribute__((ext_vector_type(2)));
typedef __bf16 bf16x2_t __attribute__((ext_vector_type(2)));

constexpr int NB = 8, SEQ = 4096, D = 1024, NTOK = NB * SEQ, DEPTH = 4;
constexpr int GLA_IN = 3088, FOX_IN = 4112, DFF = 2816, DFE = 3584, NE = 8, MOD_W = 6 * D;
constexpr int CONVW = 31;
constexpr float EPS = 1e-6f;
constexpr float LOG2E = 1.4426950408889634f;
constexpr float QSCALE = 0.125f * LOG2E;
constexpr int NTHR = 512, NWAVES = 8;
constexpr int MOE_CAP = NTOK;
constexpr int MOE_MAXT = NTOK * 2 / 256 + NE;

constexpr size_t MiB = 1u << 20;
constexpr size_t WS_CTL = 0, CTL_ZERO_BYTES = 1 * MiB;
constexpr size_t WS_MOD = 1 * MiB;
constexpr size_t WS_W = 2 * MiB;
constexpr size_t SZ_GLA_IN = (size_t)3072 * D * 2, SZ_SQ = (size_t)D * D * 2, SZ_CONV_IN = (size_t)2048 * D * 2, SZ_FOX_IN = (size_t)4096 * D * 2;
constexpr size_t SZ_FFN13 = (size_t)2 * DFF * D * 2, SZ_FFN2 = (size_t)D * DFF * 2, SZ_MOE13 = (size_t)2 * DFE * D * 2, SZ_MOE2 = (size_t)D * DFE * 2;
constexpr size_t W_GLA_IN = WS_W, W_GLA_OUT = W_GLA_IN + 2 * SZ_GLA_IN, W_CONV_IN = W_GLA_OUT + 2 * SZ_SQ, W_CONV_OUT = W_CONV_IN + SZ_CONV_IN;
constexpr size_t W_FOX_IN = W_CONV_OUT + SZ_SQ, W_FOX_OUT = W_FOX_IN + SZ_FOX_IN, W_FFN13 = W_FOX_OUT + SZ_SQ, W_FFN2 = W_FFN13 + 2 * SZ_FFN13;
constexpr size_t W_MOE13 = W_FFN2 + 2 * SZ_FFN2, W_MOE2 = W_MOE13 + 16 * SZ_MOE13, W_END = W_MOE2 + 16 * SZ_MOE2;
constexpr size_t MOE13_STRIDE = MOE_FP8 ? SZ_MOE13 / 2 : SZ_MOE13, MOE2_STRIDE = MOE_FP8 ? SZ_MOE2 / 2 : SZ_MOE2;
constexpr size_t WS_X = (W_END + MiB - 1) / MiB * MiB;
constexpr size_t WS_H = WS_X + (size_t)NTOK * D * 4;
constexpr size_t WS_Y = WS_H + (size_t)NTOK * D * 2;
constexpr size_t WS_TOK = WS_Y + (size_t)MOE_MAXT * 256 * D * 2;
constexpr size_t WS_TINFO = WS_TOK + (size_t)NE * MOE_CAP * 4;
constexpr size_t WS_LF = WS_TINFO + (size_t)NTOK * 16;
constexpr size_t WS_CUMG = WS_LF + (size_t)NTOK * 16 * 4;
constexpr size_t WS_SCR = WS_CUMG + (size_t)NB * 16 * SEQ * 4;
constexpr size_t SCR_BYTES = (size_t)MOE_MAXT * 256 * DFE * 2;
constexpr size_t WS_END = WS_SCR + SCR_BYTES;
constexpr size_t S_QG = 0, S_KD = S_QG + (size_t)NTOK * 512 * 2, S_V = S_KD + (size_t)NTOK * 512 * 2, S_R = S_V + (size_t)NTOK * D * 2;
constexpr size_t S_DK = S_R + (size_t)NTOK * D * 2, S_ET = S_DK + (size_t)NTOK * 512 * 4, S_DR = S_ET + (size_t)512 * 512 * 4, S_O = S_DR + (size_t)512 * 8 * 512 * 4, S_A2 = S_O + (size_t)NTOK * D * 2;
static_assert(S_A2 + (size_t)NTOK * D * 2 <= SCR_BYTES, "GLA scratch");
constexpr size_t S_FQ = 0, S_FK = (size_t)NTOK * D * 2, S_FV = 2 * S_FK, S_FG = 3 * S_FK;
static_assert(4 * S_FK <= S_A2, "fox scratch");
constexpr int CW_BAR = 4096;
constexpr int CW_ATTQ = 16384 + 512;
constexpr int CW_CNT = 16384;

__device__ __forceinline__ int opaque_tid() { int t = threadIdx.x; asm volatile("" : "+v"(t)); return t; }
#define FENCE() do { asm volatile("" ::: "memory"); __builtin_amdgcn_sched_barrier(0); } while (0)
__device__ __forceinline__ unsigned pk2(float lo, float hi) { f32x2 v = {lo, hi}; bf16x2_t b = __builtin_convertvector(v, bf16x2_t); return __builtin_bit_cast(unsigned, b); }
constexpr float F8_W13 = 32.0f, F8_HID = 4.0f, F8_W2 = 64.0f;
__device__ __forceinline__ float f8clamp(float x) { return __builtin_amdgcn_fmed3f(x, -448.0f, 448.0f); }
__device__ __forceinline__ unsigned pk4_fp8(float a, float b, float c, float d) { int w = __builtin_amdgcn_cvt_pk_fp8_f32(f8clamp(a), f8clamp(b), 0, false); w = __builtin_amdgcn_cvt_pk_fp8_f32(f8clamp(c), f8clamp(d), w, true); return (unsigned)w; }
__device__ __forceinline__ float bf_lo(unsigned w) { return __uint_as_float(w << 16); }
__device__ __forceinline__ float bf_hi(unsigned w) { return __uint_as_float(w & 0xffff0000u); }
__device__ __forceinline__ float wave_sum(float v) {
#pragma unroll
    for (int o = 1; o < 64; o <<= 1) v += __shfl_xor(v, o);
    return v;
}
template <int N> __device__ __forceinline__ void xreduce(float (&v)[N], int lane) {
    constexpr int LG = (N == 64) ? 6 : (N == 32) ? 5 : (N == 16) ? 4 : (N == 8) ? 3 : 0;
    static_assert(LG > 0, "xreduce N");
#pragma unroll
    for (int s = 0; s < LG; ++s) {
        const int off = 32 >> s, n = N >> (s + 1);
        const bool hi = (lane & off) != 0;
#pragma unroll
        for (int i = 0; i < n; ++i) { float lo_v = v[i], hi_v = v[i + n]; asm volatile("" : "+v"(lo_v), "+v"(hi_v));
            const float keep = hi ? hi_v : lo_v; const float send = hi ? lo_v : hi_v; v[i] = keep + __shfl_xor(send, off); }
    }
#pragma unroll
    for (int off = (32 >> LG); off >= 1; off >>= 1) v[0] += __shfl_xor(v[0], off);
}
__device__ __forceinline__ float fast_sigmoid(float x) { return __builtin_amdgcn_rcpf(1.0f + __expf(-x)); }
__device__ __forceinline__ float fast_silu(float x) { return x * fast_sigmoid(x); }
__device__ __forceinline__ float log_sigmoid(float z) { return fminf(z, 0.f) - 0.6931471805599453f * __builtin_amdgcn_logf(1.0f + __builtin_amdgcn_exp2f(-LOG2E * fabsf(z))); }

#define XB_TMO      128
#define XB_XCNT(j)  (256  + 64 * (j))
#define XB_XSUB(j)  (1280 + 64 * (j))
#define XB_XGEN(j)  (2304 + 64 * (j))
#define XB_TOP      3328
#define XB_TOPGEN   3392
#define XCD_BAR_WORDS 3456
#define XB_SPIN_CAP (1u << 22)
__device__ __forceinline__ unsigned xb_ld(unsigned* p)              { return __hip_atomic_load(p, __ATOMIC_RELAXED, __HIP_MEMORY_SCOPE_AGENT); }
__device__ __forceinline__ unsigned xb_add(unsigned* p, unsigned v) { return __hip_atomic_fetch_add(p, v, __ATOMIC_RELAXED, __HIP_MEMORY_SCOPE_AGENT); }
__device__ __forceinline__ unsigned xb_xcc_id() { return (unsigned)__builtin_amdgcn_s_getreg((3 << 11) | 20) & 0xFu; }
#define XB_SPIN(cond, bar) do { unsigned _sp = 0; while (cond) { __builtin_amdgcn_s_sleep(1); \
    if ((++_sp & 255u) == 0u) { if (xb_ld(&(bar)[XB_TMO])) break; if (_sp > XB_SPIN_CAP) { atomicAdd(&(bar)[XB_TMO], 1u); break; } } } } while (0)
struct XcdBarrier { unsigned* bar; unsigned x; volatile LAS unsigned* st; };
__device__ __forceinline__ XcdBarrier xcd_barrier_post(unsigned* bar, volatile LAS unsigned* st) {
    XcdBarrier b; b.bar = bar; b.x = xb_xcc_id(); b.st = st;
    if (threadIdx.x == 0) (void)xb_add(&bar[XB_XCNT(b.x)], 1u);
    return b;
}
__device__ __forceinline__ void xcd_barrier_complete(unsigned* bar, unsigned x, unsigned& nloc, unsigned& nx) {
    const unsigned G = gridDim.x * gridDim.y * gridDim.z;
    unsigned sum, cnt, mine, sp = 0u;
    for (;;) {
        sum = 0u; cnt = 0u; mine = 0u;
#pragma unroll
        for (unsigned j = 0; j < 16; ++j) { const unsigned c = xb_ld(&bar[XB_XCNT(j)]); sum += c; cnt += (c > 0u) ? 1u : 0u; mine = (j == x) ? c : mine; }
        if (sum == G) break;
        __builtin_amdgcn_s_sleep(1);
        if ((++sp & 255u) == 0u) { if (xb_ld(&bar[XB_TMO])) break; if (sp > XB_SPIN_CAP) { atomicAdd(&bar[XB_TMO], 1u); break; } }
    }
    nloc = mine > 0u ? mine : 1u; nx = cnt > 0u ? cnt : 1u;
}
__device__ __forceinline__ void xcd_barrier(const XcdBarrier& b) {
    asm volatile("s_waitcnt vmcnt(0)" ::: "memory");
    __syncthreads();
    if (threadIdx.x == 0) {
        unsigned* bar = b.bar; unsigned bx = b.x;
        asm volatile("" : "+s"(bar), "+s"(bx));
        __builtin_amdgcn_s_waitcnt(0);
        unsigned nloc = b.st[0], nx = b.st[1];
        if (nloc == 0u) { xcd_barrier_complete(bar, bx, nloc, nx); b.st[0] = nloc; b.st[1] = nx; }
        const unsigned old = xb_add(&bar[XB_XSUB(bx)], 1u);
        const unsigned gen = old / nloc;
        if (old + 1u == (gen + 1u) * nloc) {
            __builtin_amdgcn_fence(__ATOMIC_RELEASE, "agent");
            asm volatile("s_waitcnt vmcnt(0)" ::: "memory");
            const unsigned og = xb_add(&bar[XB_TOP], 1u);
            const unsigned tg = og / nx;
            if (og + 1u == (tg + 1u) * nx) xb_add(&bar[XB_TOPGEN], 1u);
            else XB_SPIN(xb_ld(&bar[XB_TOPGEN]) == tg, bar);
            __builtin_amdgcn_fence(__ATOMIC_ACQUIRE, "agent");
            xb_add(&bar[XB_XGEN(bx)], 1u);
            asm volatile("s_waitcnt vmcnt(0)" ::: "memory");
        } else {
            XB_SPIN(xb_ld(&bar[XB_XGEN(bx)]) == gen, bar);
            __builtin_amdgcn_fence(__ATOMIC_ACQUIRE, "agent");
            asm volatile("s_waitcnt vmcnt(0)" ::: "memory");
        }
    }
    __syncthreads();
}

namespace pg8 {
constexpr int BM = 256, BK = 64, HALF = 128, HTB = HALF * BK * 2, STAGE_BYTES = 8 * HTB, NXCD = 8, WGM = 8;
__host__ __device__ __forceinline__ int lds_byte(int r, int c) { const int st = (r >> 4) * 2 + (c >> 5), rr = r & 15, cc = c & 31, ob = rr * 64 + cc * 2; return st * 1024 + (ob ^ (((ob >> 9) & 1) << 5)); }
__host__ __device__ __forceinline__ void stage_rc(int b, int& R, int& C) { const int st = b / 1024, sb = b % 1024, swz = sb ^ (((sb >> 9) & 1) << 5); R = (st >> 1) * 16 + swz / 64; C = (st & 1) * 32 + (swz % 64) / 2; }
__host__ __device__ __forceinline__ int perm32(int rho) { const int n = rho >> 4, i = rho & 15; return 8 * (i >> 2) + 4 * n + (i & 3); }
struct Unit { int pm, pn, e; };

__device__ __forceinline__ bool order_next(int i, int G, int c, int nM, int nN, int& pm, int& pn) {
    const int nwg = nM * nN; const long L = (long)i * G + c; if (L >= nwg) return false;
    int wgid = (int)L; { const int q = nwg / NXCD, r = nwg % NXCD, xcd = wgid % NXCD, off = wgid / NXCD; wgid = (xcd < r ? xcd * (q + 1) : r * (q + 1) + (xcd - r) * q) + off; }
    const int nig = WGM * nN, gid = wgid / nig, fm = gid * WGM, gsz = (nM - fm) < WGM ? (nM - fm) : WGM;
    pm = fm + ((wgid % nig) % gsz); pn = (wgid % nig) / gsz; return true;
}
struct DenseSched {
    int nM, nN, G, c, KB; const char* Bt;
    __device__ __forceinline__ bool next(int i, Unit& u) const { u.e = 0; return order_next(i, G, c, nM, nN, u.pm, u.pn); }
    __device__ __forceinline__ int row(const Unit& u, int lr) const { return u.pm * BM + lr; }
    __device__ __forceinline__ const char* b_tile(const Unit& u) const { return Bt + (size_t)u.pn * BM * KB; }
};
struct MoeSched {
    int nM, nN, G, c, KB; const char* Bt; size_t estride; const int* tok; const LAS int* tab;
    __device__ __forceinline__ bool next(int i, Unit& u) const {
        if (!order_next(i, G, c, nM, nN, u.pm, u.pn)) return false;
        int e = 0;
#pragma unroll
        for (int j = 1; j < NE; ++j) e = (u.pm >= tab[j]) ? j : e;
        u.e = e; return true;
    }
    __device__ __forceinline__ int row(const Unit& u, int lr) const {
        if (tok == nullptr) return u.pm * BM + lr;
        const int pos = (u.pm - tab[u.e]) * BM + lr;
        return pos < tab[16 + u.e] ? tok[u.e * MOE_CAP + pos] : 0;
    }
    __device__ __forceinline__ const char* b_tile(const Unit& u) const { return Bt + (size_t)u.e * estride + (size_t)u.pn * BM * KB; }
};

typedef int v8i32 __attribute__((ext_vector_type(8)));
__device__ __forceinline__ const char* uni_ptr(const char* p) { const unsigned long long v = (unsigned long long)p; const unsigned lo = (unsigned)__builtin_amdgcn_readfirstlane((int)(unsigned)v), hi = (unsigned)__builtin_amdgcn_readfirstlane((int)(unsigned)(v >> 32)); return (const char*)(((unsigned long long)hi << 32) | lo); }
__device__ __forceinline__ v8i32 cat8(bf16x8 lo, bf16x8 hi) { const u32x4 a = __builtin_bit_cast(u32x4, lo), b = __builtin_bit_cast(u32x4, hi); return (v8i32){(int)a.x, (int)a.y, (int)a.z, (int)a.w, (int)b.x, (int)b.y, (int)b.z, (int)b.w}; }
template <class Epi, class Sched, bool FP8 = false>
__device__ __forceinline__ void gemm_phase(LAS unsigned char* lds, const char* Abase, const Sched& S, const Epi& E) {
    const int tid = opaque_tid(), wid = __builtin_amdgcn_readfirstlane(tid >> 6), lane = tid & 63, wr = wid >> 2, wc = wid & 3, fr = lane & 15, fq = lane >> 4;
    const int KB = S.KB, nt = KB / (BK * 2);
    int Rp[2], Cp[2]; unsigned voffB[2];
#pragma unroll
    for (int i = 0; i < 2; ++i) { int R, C; stage_rc(tid * 16 + i * 8192, R, C); Rp[i] = R; Cp[i] = C; const int Rb = Epi::PERM ? ((R & ~31) + perm32(R & 31)) : R; voffB[i] = (unsigned)(Rb * KB + C * 2); }
    const size_t kstep = (size_t)(BK * 2);
    const size_t hstep = (size_t)HALF * KB;
    const unsigned ldsw = (unsigned)wid * 1024u;
    const unsigned lds0 = (unsigned)__builtin_amdgcn_readfirstlane((int)((unsigned)(size_t)lds + ldsw));
    const int aoff = lds_byte(wr * 64 + fr, fq * 8), boff = lds_byte(wc * 32 + fr, fq * 8);
#define PG8_SA(b, h) (((b) * 2 + (h)) * HTB)
#define PG8_SB(b, h) ((4 + (b) * 2 + (h)) * HTB)
#define PG8_GLDS(sbase, voff32, ldsdst) do { unsigned _keep; asm volatile("s_mov_b32 %0, m0\n\ts_mov_b32 m0, %3\n\ts_nop 0\n\tglobal_load_lds_dwordx4 %1, %2\n\ts_mov_b32 m0, %0" \
        : "=&s"(_keep) : "v"(voff32), "s"(sbase), "s"(ldsdst) : "memory"); } while (0)
#define PG8_STAGE(bufoff, gbase, voff) do { const char* _sb = uni_ptr((const char*)(gbase)); _Pragma("unroll") for (int _i = 0; _i < 2; ++_i) \
        PG8_GLDS(_sb, (voff)[_i], lds0 + (unsigned)((bufoff) + _i * 8192)); } while (0)
#define PG8_STAGEA(bufoff, ra2, koff) do { const char* _sb = uni_ptr(Abase + (size_t)(koff)); _Pragma("unroll") for (int _i = 0; _i < 2; ++_i) \
        PG8_GLDS(_sb, (ra2)[_i], lds0 + (unsigned)((bufoff) + _i * 8192)); } while (0)
#define PG8_LDA(dst, b, h) do { _Pragma("unroll") for (int m = 0; m < 4; ++m) _Pragma("unroll") for (int k = 0; k < 2; ++k) dst[m][k] = *(const LAS bf16x8*)(lds + PG8_SA(b, h) + aoff + m * 2048 + k * 1024); } while (0)
#define PG8_LDB(dst, b, h) do { _Pragma("unroll") for (int n = 0; n < 2; ++n) _Pragma("unroll") for (int k = 0; k < 2; ++k) dst[n][k] = *(const LAS bf16x8*)(lds + PG8_SB(b, h) + boff + n * 2048 + k * 1024); } while (0)
#define PG8_MMA(ai, bj, At, Bt) do { __builtin_amdgcn_s_setprio(1); _Pragma("unroll") for (int m = 0; m < 4; ++m) _Pragma("unroll") for (int n = 0; n < 2; ++n) { \
        if constexpr (FP8) { const v8i32 _b8 = cat8(Bt[n][0], Bt[n][1]), _a8 = cat8(At[m][0], At[m][1]); \
            asm volatile("v_mfma_f32_16x16x128_f8f6f4 %0, %1, %2, %0" : "+v"(acc[ai][bj][m][n]) : "v"(_b8), "v"(_a8)); } \
        else { _Pragma("unroll") for (int k = 0; k < 2; ++k) acc[ai][bj][m][n] = __builtin_amdgcn_mfma_f32_16x16x32_bf16(Bt[n][k], At[m][k], acc[ai][bj][m][n], 0, 0, 0); } } \
        __builtin_amdgcn_s_setprio(0); } while (0)
#define PG8_WAIT_V(n) asm volatile("s_waitcnt vmcnt(" #n ")" ::: "memory")
#define PG8_WAIT_L(n) asm volatile("s_waitcnt lgkmcnt(" #n ")" ::: "memory")
#define PG8_BAR __builtin_amdgcn_s_barrier()
#define PG8_SCHED __builtin_amdgcn_sched_barrier(0)
#define PG8_ROWS(u, ra) do { _Pragma("unroll") for (int _h = 0; _h < 2; ++_h) _Pragma("unroll") for (int _i = 0; _i < 2; ++_i) \
        ra[_h][_i] = (unsigned)(S.row(u, _h * HALF + Rp[_i]) * KB + Cp[_i] * 2); } while (0)
    unsigned f8one = 0x7F7F7F7Fu; asm volatile("" : "+v"(f8one));
    Unit cur, nxt; int ui = 0;
    if (!S.next(0, cur)) return;
    bool has_next = S.next(1, nxt);
    unsigned ra_cur[2][2], ra_nxt[2][2];
    PG8_ROWS(cur, ra_cur);
    if (has_next) { PG8_ROWS(nxt, ra_nxt); } else {
#pragma unroll
        for (int h = 0; h < 2; ++h) { ra_nxt[h][0] = ra_cur[h][0]; ra_nxt[h][1] = ra_cur[h][1]; } }
    f32x4 acc[2][2][4][2];
#pragma unroll
    for (int a = 0; a < 2; ++a)
#pragma unroll
        for (int b = 0; b < 2; ++b)
#pragma unroll
            for (int m = 0; m < 4; ++m)
#pragma unroll
                for (int n = 0; n < 2; ++n) acc[a][b][m][n] = (f32x4){0.f, 0.f, 0.f, 0.f};
    bf16x8 At[4][2], B0[2][2], B1[2][2];
    const char* cB = S.b_tile(cur);
    PG8_STAGE(PG8_SB(0, 0), cB, voffB); PG8_STAGE(PG8_SB(0, 1), cB + hstep, voffB); PG8_STAGEA(PG8_SA(0, 0), ra_cur[0], 0); PG8_STAGEA(PG8_SA(0, 1), ra_cur[1], 0);
    if (wr == 1) PG8_BAR;
    PG8_WAIT_V(2); PG8_BAR;
    PG8_STAGE(PG8_SB(1, 0), cB + kstep, voffB); PG8_STAGEA(PG8_SA(1, 0), ra_cur[0], kstep); PG8_STAGE(PG8_SB(1, 1), cB + hstep + kstep, voffB);
    PG8_WAIT_V(6); PG8_BAR;
    for (;;) {
        const char* nB = has_next ? S.b_tile(nxt) : cB;
        for (int t = 0; t < nt; t += 2) {
            const bool last = (t == nt - 2);
            const size_t k1 = (size_t)(t + 1) * kstep;
            const size_t k2 = last ? (size_t)0 : (size_t)(t + 2) * kstep; const char* b2 = last ? nB : cB + (size_t)(t + 2) * kstep;
            const size_t k3 = k2 + kstep; const char* b3 = b2 + kstep;
            unsigned r2[2][2];
#pragma unroll
            for (int h = 0; h < 2; ++h) { r2[h][0] = last ? ra_nxt[h][0] : ra_cur[h][0]; r2[h][1] = last ? ra_nxt[h][1] : ra_cur[h][1]; }
            PG8_LDB(B0, 0, 0); PG8_LDB(B1, 0, 1); PG8_SCHED; PG8_LDA(At, 0, 0); PG8_STAGEA(PG8_SA(1, 1), ra_cur[1], k1);
            PG8_WAIT_V(8); PG8_WAIT_L(0); PG8_BAR; PG8_MMA(0, 0, At, B0); PG8_MMA(0, 1, At, B1); PG8_BAR; PG8_SCHED;
            PG8_LDA(At, 0, 1); PG8_STAGE(PG8_SB(0, 0), b2, voffB); PG8_STAGE(PG8_SB(0, 1), b2 + hstep, voffB); PG8_STAGEA(PG8_SA(0, 0), r2[0], k2);
            PG8_WAIT_V(8); PG8_WAIT_L(0); PG8_BAR; PG8_MMA(1, 0, At, B0); PG8_MMA(1, 1, At, B1); PG8_BAR; PG8_SCHED;
            PG8_LDB(B0, 1, 0); PG8_LDB(B1, 1, 1); PG8_SCHED; PG8_LDA(At, 1, 0); PG8_STAGEA(PG8_SA(0, 1), r2[1], k2);
            PG8_WAIT_V(8); PG8_WAIT_L(0); PG8_BAR; PG8_MMA(0, 0, At, B0); PG8_MMA(0, 1, At, B1); PG8_BAR; PG8_SCHED;
            PG8_LDA(At, 1, 1); PG8_STAGE(PG8_SB(1, 0), b3, voffB); PG8_STAGE(PG8_SB(1, 1), b3 + hstep, voffB); PG8_STAGEA(PG8_SA(1, 0), r2[0], k3);
            PG8_WAIT_V(8); PG8_WAIT_L(0); PG8_BAR; PG8_MMA(1, 0, At, B0); PG8_MMA(1, 1, At, B1); PG8_BAR; PG8_SCHED;
        }
        if (wr == 0) PG8_BAR;
        if constexpr (FP8) asm volatile("s_nop 15\n\ts_nop 7" ::: "memory");
        Unit nx2; const bool hn2 = has_next && S.next(ui + 2, nx2); int rr2[2][2];
        if (hn2) {
#pragma unroll
            for (int h = 0; h < 2; ++h) { rr2[h][0] = S.row(nx2, h * HALF + Rp[0]); rr2[h][1] = S.row(nx2, h * HALF + Rp[1]); } }
        asm volatile("" ::: "memory");
        E(acc, cur, wr, wc, fr, fq);
        if (!has_next) break;
#pragma unroll
        for (int a = 0; a < 2; ++a)
#pragma unroll
            for (int b = 0; b < 2; ++b)
#pragma unroll
                for (int m = 0; m < 4; ++m)
#pragma unroll
                    for (int n = 0; n < 2; ++n) acc[a][b][m][n] = (f32x4){0.f, 0.f, 0.f, 0.f};
        cur = nxt; cB = nB; ++ui;
#pragma unroll
        for (int h = 0; h < 2; ++h) { ra_cur[h][0] = ra_nxt[h][0]; ra_cur[h][1] = ra_nxt[h][1]; }
        has_next = hn2; nxt = nx2;
        if (has_next) {
#pragma unroll
            for (int h = 0; h < 2; ++h) { ra_nxt[h][0] = (unsigned)(rr2[h][0] * KB + Cp[0] * 2); ra_nxt[h][1] = (unsigned)(rr2[h][1] * KB + Cp[1] * 2); } }
        if (wr == 1) PG8_BAR;
    }
    PG8_WAIT_V(0);
    PG8_BAR;
#undef PG8_SA
#undef PG8_SB
#undef PG8_STAGE
#undef PG8_STAGEA
#undef PG8_LDA
#undef PG8_LDB
#undef PG8_MMA
#undef PG8_WAIT_V
#undef PG8_WAIT_L
#undef PG8_BAR
#undef PG8_SCHED
#undef PG8_ROWS
}

typedef const f32x4 (&AccRef)[2][2][4][2];
struct EpiOut {
    static constexpr bool PERM = true;
    const float* xin32; const bf16_t* xin; bf16_t* xout; const float* gate; const float* bias; float gscale;
    __device__ __forceinline__ void operator()(AccRef acc, const Unit& u, int wr, int wc, int fr, int fq) const {
        const int row0 = u.pm * BM + wr * 64 + fr, col0 = u.pn * BM + wc * 32 + 8 * fq, b = (u.pm * BM) / SEQ;
        f32x4 gv[2][2], bv[2][2];
#pragma unroll
        for (int bj = 0; bj < 2; ++bj)
#pragma unroll
            for (int n = 0; n < 2; ++n) { gv[bj][n] = *(const f32x4*)(gate + (size_t)b * MOD_W + col0 + bj * HALF + n * 4) * gscale;
                bv[bj][n] = bias ? *(const f32x4*)(bias + col0 + bj * HALF + n * 4) : (f32x4){0.f, 0.f, 0.f, 0.f}; }
        if (xin32 != nullptr) {
#pragma unroll
            for (int ai = 0; ai < 2; ++ai)
#pragma unroll
                for (int m = 0; m < 4; ++m) { const size_t off = (size_t)(row0 + ai * HALF + m * 16) * D + col0;
#pragma unroll
                    for (int bj = 0; bj < 2; ++bj) { const f32x4 x0 = *(const f32x4*)(xin32 + off + bj * HALF), x1 = *(const f32x4*)(xin32 + off + bj * HALF + 4);
                        const f32x4 v0 = x0 + gv[bj][0] * (acc[ai][bj][m][0] + bv[bj][0]), v1 = x1 + gv[bj][1] * (acc[ai][bj][m][1] + bv[bj][1]);
                        u32x4 w; w.x = pk2(v0[0], v0[1]); w.y = pk2(v0[2], v0[3]); w.z = pk2(v1[0], v1[1]); w.w = pk2(v1[2], v1[3]);
                        *(u32x4*)(xout + off + bj * HALF) = w; }
                    asm volatile("" ::: "memory"); }
        } else {
#pragma unroll
            for (int ai = 0; ai < 2; ++ai)
#pragma unroll
                for (int m = 0; m < 4; ++m) { const size_t off = (size_t)(row0 + ai * HALF + m * 16) * D + col0;
#pragma unroll
                    for (int bj = 0; bj < 2; ++bj) { const u32x4 xw = *(const u32x4*)(xin + off + bj * HALF);
                        const f32x4 x0 = {bf_lo(xw.x), bf_hi(xw.x), bf_lo(xw.y), bf_hi(xw.y)}, x1 = {bf_lo(xw.z), bf_hi(xw.z), bf_lo(xw.w), bf_hi(xw.w)};
                        const f32x4 v0 = x0 + gv[bj][0] * (acc[ai][bj][m][0] + bv[bj][0]), v1 = x1 + gv[bj][1] * (acc[ai][bj][m][1] + bv[bj][1]);
                        u32x4 w; w.x = pk2(v0[0], v0[1]); w.y = pk2(v0[2], v0[3]); w.z = pk2(v1[0], v1[1]); w.w = pk2(v1[2], v1[3]);
                        *(u32x4*)(xout + off + bj * HALF) = w; }
                    asm volatile("" ::: "memory"); }
        }
    }
};
template <int MODE, bool F8OUT = false> struct EpiGated {
    static constexpr bool PERM = true;
    bf16_t* O; int ldc; const float* bias; int hid; float ascale, oscale;
    __device__ __forceinline__ void operator()(AccRef acc, const Unit& u, int wr, int wc, int fr, int fq) const {
        const int row0 = u.pm * BM + wr * 64 + fr, col0 = u.pn * HALF + wc * 32 + 8 * fq;
        f32x4 ba[2], bb[2];
#pragma unroll
        for (int n = 0; n < 2; ++n) { ba[n] = (MODE == 1) ? *(const f32x4*)(bias + col0 + 4 * n) : (f32x4){0.f, 0.f, 0.f, 0.f}; bb[n] = (MODE == 1) ? *(const f32x4*)(bias + hid + col0 + 4 * n) : (f32x4){0.f, 0.f, 0.f, 0.f}; }
#pragma unroll
        for (int ai = 0; ai < 2; ++ai)
#pragma unroll
            for (int m = 0; m < 4; ++m) { bf16_t* rowp = O + (size_t)(row0 + ai * HALF + m * 16) * ldc + col0; float o[8];
#pragma unroll
                for (int n = 0; n < 2; ++n) {
                    if constexpr (MODE == 0) {
                        const f32x4 A4 = acc[ai][0][m][n], U4 = acc[ai][1][m][n]; const float c1 = -LOG2E * ascale, kk = 1.0f / (ascale * ascale * (F8OUT ? oscale : 1.0f));
                        const f32x4 t = A4 * c1; f32x4 e;
#pragma unroll
                        for (int i = 0; i < 4; ++i) e[i] = __builtin_amdgcn_exp2f(t[i]);
                        const f32x4 d = e * kk + kk; f32x4 r;
#pragma unroll
                        for (int i = 0; i < 4; ++i) r[i] = __builtin_amdgcn_rcpf(d[i]);
                        const f32x4 ov = (A4 * U4) * r;
#pragma unroll
                        for (int i = 0; i < 4; ++i) o[4 * n + i] = ov[i];
                        continue; }
                    const f32x4 a = acc[ai][0][m][n] * ascale + ba[n], g = acc[ai][1][m][n] * ascale + bb[n];
                    const f32x4 t = ((MODE == 0) ? a : g) * (-LOG2E); f32x4 e;
#pragma unroll
                    for (int i = 0; i < 4; ++i) e[i] = __builtin_amdgcn_exp2f(t[i]);
                    const f32x4 d = e + 1.0f; f32x4 r;
#pragma unroll
                    for (int i = 0; i < 4; ++i) r[i] = __builtin_amdgcn_rcpf(d[i]);
                    const f32x4 ov = (a * r) * ((MODE == 0) ? g : (f32x4){1.f, 1.f, 1.f, 1.f}) * (F8OUT ? oscale : 1.0f);
#pragma unroll
                    for (int i = 0; i < 4; ++i) o[4 * n + i] = ov[i]; }
                if constexpr (F8OUT) { u32x2 w; w.x = pk4_fp8(o[0], o[1], o[2], o[3]); w.y = pk4_fp8(o[4], o[5], o[6], o[7]);
                    *(u32x2*)((unsigned char*)O + (size_t)(row0 + ai * HALF + m * 16) * ldc + col0) = w; }
                else { u32x4 w; w.x = pk2(o[0], o[1]); w.y = pk2(o[2], o[3]); w.z = pk2(o[4], o[5]); w.w = pk2(o[6], o[7]);
                    *(u32x4*)rowp = w; } }
    }
};
struct EpiBf16 {
    static constexpr bool PERM = true;
    bf16_t* O; int ldc; float scale;
    __device__ __forceinline__ void operator()(AccRef acc, const Unit& u, int wr, int wc, int fr, int fq) const {
        const int row0 = u.pm * BM + wr * 64 + fr, col0 = u.pn * BM + wc * 32 + 8 * fq;
#pragma unroll
        for (int ai = 0; ai < 2; ++ai)
#pragma unroll
            for (int m = 0; m < 4; ++m) { bf16_t* rowp = O + (size_t)(row0 + ai * HALF + m * 16) * ldc + col0;
#pragma unroll
                for (int bj = 0; bj < 2; ++bj) { const f32x4 v0 = acc[ai][bj][m][0] * scale, v1 = acc[ai][bj][m][1] * scale;
                    u32x4 w; w.x = pk2(v0[0], v0[1]); w.y = pk2(v0[2], v0[3]); w.z = pk2(v1[0], v1[1]); w.w = pk2(v1[2], v1[3]);
                    *(u32x4*)(rowp + bj * HALF) = w; } }
    }
};
struct EpiGlaIn {
    static constexpr bool PERM = true;
    bf16_t *Q, *KD, *V, *R; const float* Dk; const float* dref;
    __device__ __forceinline__ void operator()(AccRef acc, const Unit& u, int wr, int wc, int fr, int fq) const {
        const int row0 = u.pm * BM + wr * 64 + fr, cw = wc * 32 + 8 * fq;
        const int type = (u.pn < 2) ? 0 : (u.pn < 4) ? 1 : (u.pn < 8) ? 2 : 3;
        const int tcol = (type == 0) ? u.pn * BM : (type == 1) ? (u.pn - 2) * BM : (type == 2) ? (u.pn - 4) * BM : (u.pn - 8) * BM;
        bf16_t* base = (type == 0) ? Q : (type == 1) ? KD : (type == 2) ? V : R; const int ldc = (type < 2) ? 512 : D;
#pragma unroll
        for (int ai = 0; ai < 2; ++ai)
#pragma unroll
            for (int m = 0; m < 4; ++m) { const int row = row0 + ai * HALF + m * 16;
#pragma unroll
                for (int bj = 0; bj < 2; ++bj) { const int col = tcol + bj * HALF + cw; f32x4 v0 = acc[ai][bj][m][0], v1 = acc[ai][bj][m][1];
                    if (type == 0) { v0 = v0 * 0.08838834764831845f; v1 = v1 * 0.08838834764831845f; }
                    else if (type == 1) { const float* rp = dref + (size_t)(row >> 4) * 512 + col;
                        const u32x4 cw = *(const u32x4*)((const bf16_t*)Dk + (size_t)row * 512 + col); const f32x4 c0 = (f32x4){bf_lo(cw.x), bf_hi(cw.x), bf_lo(cw.y), bf_hi(cw.y)}, c1 = (f32x4){bf_lo(cw.z), bf_hi(cw.z), bf_lo(cw.w), bf_hi(cw.w)}, r0 = *(const f32x4*)rp, r1 = *(const f32x4*)(rp + 4);
#pragma unroll
                        for (int i = 0; i < 4; ++i) { v0[i] *= __expf(r0[i] - c0[i]); v1[i] *= __expf(r1[i] - c1[i]); } }
                    else if (type == 3) {
#pragma unroll
                        for (int i = 0; i < 4; ++i) { v0[i] = fast_silu(v0[i]); v1[i] = fast_silu(v1[i]); } }
                    u32x4 w; w.x = pk2(v0[0], v0[1]); w.y = pk2(v0[2], v0[3]); w.z = pk2(v1[0], v1[1]); w.w = pk2(v1[2], v1[3]);
                    *(u32x4*)(base + (size_t)row * ldc + col) = w; } }
    }
};
struct EpiFoxIn {
    static constexpr bool PERM = true;
    bf16_t *Q, *Kb, *V, *G; const float *qg, *kg;
    __device__ __forceinline__ void operator()(AccRef acc, const Unit& u, int wr, int wc, int fr, int fq) const {
        const int row0 = u.pm * BM + wr * 64 + fr, type = u.pn >> 2;
        bf16_t* base = (type == 0) ? Q : (type == 1) ? Kb : (type == 2) ? V : G;
        const int colw = (u.pn & 3) * BM + 64 * wc + 8 * fq;
        f32x4 gn[2][2];
#pragma unroll
        for (int bj = 0; bj < 2; ++bj)
#pragma unroll
            for (int n = 0; n < 2; ++n) { const f32x4 gq = *(const f32x4*)(qg + 32 * bj + 8 * fq + 4 * n) * QSCALE, gk = *(const f32x4*)(kg + 32 * bj + 8 * fq + 4 * n);
                gn[bj][n] = (type == 0) ? gq : gk; }
#pragma unroll
        for (int ai = 0; ai < 2; ++ai)
#pragma unroll
            for (int m = 0; m < 4; ++m) { const int row = row0 + ai * HALF + m * 16; float rs = 1.f;
                if (type < 2) { float ss = 0.f;
#pragma unroll
                    for (int bj = 0; bj < 2; ++bj)
#pragma unroll
                        for (int n = 0; n < 2; ++n) { const f32x4 x = acc[ai][bj][m][n]; ss += (x[0] * x[0] + x[1] * x[1]) + (x[2] * x[2] + x[3] * x[3]); }
                    ss += __shfl_xor(ss, 16); ss += __shfl_xor(ss, 32);
                    rs = __builtin_amdgcn_rsqf(ss * (1.0f / 64.0f) + EPS); }
#pragma unroll
                for (int bj = 0; bj < 2; ++bj) { f32x4 v0 = acc[ai][bj][m][0], v1 = acc[ai][bj][m][1];
                    if (type < 2) { v0 = v0 * rs * gn[bj][0]; v1 = v1 * rs * gn[bj][1]; }
                    else if (type == 3) {
#pragma unroll
                        for (int i = 0; i < 4; ++i) { v0[i] = fast_sigmoid(v0[i]); v1[i] = fast_sigmoid(v1[i]); } }
                    u32x4 w; w.x = pk2(v0[0], v0[1]); w.y = pk2(v0[2], v0[3]); w.z = pk2(v1[0], v1[1]); w.w = pk2(v1[2], v1[3]);
                    *(u32x4*)(base + (size_t)row * D + colw + 32 * bj) = w; } }
    }
};
}

constexpr int RING_BYTES = 131072;
constexpr int LDS_TAB = 135168;
constexpr int LDS_MISC = LDS_TAB + 256;
constexpr int LDS_BYTES = 147456;

struct Args { const float* in[28]; float* out; unsigned char* ws; int ph_lo, ph_hi; };
enum { I_X = 0, I_C, I_ADA_W, I_ADA_B, I_GLA_WIN, I_GLA_WG2, I_GLA_BG, I_GLA_GN, I_GLA_WOUT, I_CONV_WIN, I_CONV_BIN, I_CONV_DW, I_CONV_DWB, I_CONV_LNG, I_CONV_LNB, I_CONV_WOUT, I_CONV_BOUT,
       I_FOX_WIN, I_FOX_BF, I_FOX_QN, I_FOX_KN, I_FOX_WOUT, I_FFN_W13, I_FFN_W2, I_MOE_R, I_MOE_W13, I_MOE_W2, I_NORMF };

__device__ __forceinline__ const float* karg_in(int i) {
    asm volatile("" : "+s"(i));
    const __attribute__((address_space(4))) char* ka = (const __attribute__((address_space(4))) char*)__builtin_amdgcn_kernarg_segment_ptr();
    return *(const float* const __attribute__((address_space(4)))*)(ka + 8 * i);
}
__device__ __forceinline__ int opq(int x) { asm volatile("" : "+s"(x)); return x; }
__device__ __forceinline__ unsigned char* karg_ws() {
    int i = 29; asm volatile("" : "+s"(i));
    const __attribute__((address_space(4))) char* ka = (const __attribute__((address_space(4))) char*)__builtin_amdgcn_kernarg_segment_ptr();
    return *(unsigned char* const __attribute__((address_space(4)))*)(ka + 8 * i);
}
template <int MODE, bool F8 = false>
__device__ __forceinline__ void tr_item(const float* W, int K, int pitch, int ncols, bf16_t* WT, LAS float* scr, int item, int lane, int hid, float f8scale = 1.0f) {
    constexpr int KD = F8 ? 128 : 64;
    const int nblk = ncols / 32, kb = item / nblk, nb = item % nblk, k0 = KD * kb, L0 = 32 * nb;
    int src0 = L0, dst0 = L0;
    if (MODE == 1) { if (L0 < hid) dst0 = 256 * (L0 / 128) + (L0 % 128); else { const int n = L0 - hid; dst0 = 256 * (n / 128) + 128 + (n % 128); } }
    if (MODE == 2) { src0 = (L0 < 3072) ? L0 : L0 + 16; const int tile = L0 / 256, within = L0 % 256, wc = within / 64, bj = (within % 64) / 32; dst0 = tile * 256 + 128 * bj + 32 * wc; }
#pragma unroll 8
    for (int i = 0; i < KD / 2; ++i) { const int kk = 2 * i + (lane >> 5); scr[kk * 33 + (lane & 31)] = W[(size_t)(k0 + kk) * pitch + src0 + (lane & 31)]; }
    asm volatile("s_waitcnt lgkmcnt(0)" ::: "memory");
    const int c = lane & 7;
#pragma unroll
    for (int j = 0; j < 4; ++j) { const int n = (lane >> 3) + 8 * j; const LAS float* s = scr + ((KD / 8) * c) * 33 + n;
        if constexpr (F8) { u32x4 o; o.x = pk4_fp8(s[0 * 33] * f8scale, s[1 * 33] * f8scale, s[2 * 33] * f8scale, s[3 * 33] * f8scale); o.y = pk4_fp8(s[4 * 33] * f8scale, s[5 * 33] * f8scale, s[6 * 33] * f8scale, s[7 * 33] * f8scale);
            o.z = pk4_fp8(s[8 * 33] * f8scale, s[9 * 33] * f8scale, s[10 * 33] * f8scale, s[11 * 33] * f8scale); o.w = pk4_fp8(s[12 * 33] * f8scale, s[13 * 33] * f8scale, s[14 * 33] * f8scale, s[15 * 33] * f8scale);
            *(u32x4*)((unsigned char*)WT + (size_t)(dst0 + n) * K + k0 + 16 * c) = o; }
        else { u32x4 o; o.x = pk2(s[0 * 33], s[1 * 33]); o.y = pk2(s[2 * 33], s[3 * 33]); o.z = pk2(s[4 * 33], s[5 * 33]); o.w = pk2(s[6 * 33], s[7 * 33]);
            *(u32x4*)(WT + (size_t)(dst0 + n) * K + k0 + 8 * c) = o; } }
    asm volatile("s_waitcnt lgkmcnt(0)" ::: "memory");
}

__device__ __forceinline__ void phase_prologue(LAS unsigned char* lds, const Args& a, int vcu, int G) {
    const int tid = opaque_tid(), lane = tid & 63, wave = __builtin_amdgcn_readfirstlane(tid >> 6);
    unsigned char* ws = a.ws;
    LAS float* cond = (LAS float*)lds;
    LAS float* part = (LAS float*)(lds + 32768);
    for (int i = tid; i < NB * D; i += NTHR) { const int b = i / D, k = i % D; const float v = karg_in(I_C)[i]; cond[k * 8 + b] = v * fast_sigmoid(v); }
    __syncthreads();
    float* mod = (float*)(ws + WS_MOD);
    for (int task = blockIdx.x; task < DEPTH * MOD_W / 32; task += G) {
        const int J0 = task * 32, L = J0 / MOD_W, j0 = J0 % MOD_W, col = lane & 31, kp = lane >> 5;
        const float* w = karg_in(I_ADA_W) + (size_t)L * D * MOD_W + j0 + col;
        float acc[8];
#pragma unroll
        for (int b = 0; b < 8; ++b) acc[b] = 0.f;
#pragma unroll 8
        for (int i = 0; i < 64; ++i) { const int k = wave * 128 + 2 * i + kp; const float wv = w[(size_t)k * MOD_W];
            const f32x4 c0 = *(const LAS f32x4*)(cond + k * 8), c1 = *(const LAS f32x4*)(cond + k * 8 + 4);
            acc[0] += wv * c0[0]; acc[1] += wv * c0[1]; acc[2] += wv * c0[2]; acc[3] += wv * c0[3]; acc[4] += wv * c1[0]; acc[5] += wv * c1[1]; acc[6] += wv * c1[2]; acc[7] += wv * c1[3]; }
#pragma unroll
        for (int b = 0; b < 8; ++b) acc[b] += __shfl_xor(acc[b], 32);
        if (kp == 0) {
#pragma unroll
            for (int b = 0; b < 8; ++b) part[(wave * 8 + b) * 32 + col] = acc[b]; }
        __syncthreads();
        if (tid < 256) { const int b = tid >> 5, cc = tid & 31; float s = karg_in(I_ADA_B)[L * MOD_W + j0 + cc];
#pragma unroll
            for (int w8 = 0; w8 < 8; ++w8) s += part[(w8 * 8 + b) * 32 + cc];
            mod[((size_t)L * NB + b) * MOD_W + j0 + cc] = s; }
        __syncthreads();
    }
    LAS float* scr = (LAS float*)(lds + wave * 16896);
    const int gw = vcu * NWAVES + wave, NGW = G * NWAVES;
    constexpr int IT_GLA_IN = (D / 64) * (3072 / 32), IT_SQ = (D / 64) * (D / 32), IT_CONV_IN = (D / 64) * (2048 / 32), IT_FOX_IN = (D / 64) * (4096 / 32);
    constexpr int IT_FFN13 = (D / (FFN_FP8 ? 128 : 64)) * (2 * DFF / 32), IT_FFN2 = (DFF / 64) * (D / 32), IT_MOE13 = (D / (MOE_FP8 ? 128 : 64)) * (2 * DFE / 32), IT_MOE2 = (DFE / (MOE_FP8 ? 128 : 64)) * (D / 32);
    constexpr int NITEMS = 2 * IT_GLA_IN + 2 * IT_SQ + IT_CONV_IN + IT_SQ + IT_FOX_IN + IT_SQ + 2 * IT_FFN13 + 2 * IT_FFN2 + 16 * IT_MOE13 + 16 * IT_MOE2;
    for (int it = gw; it < NITEMS; it += NGW) {
        int r = it;
        if (r < 2 * IT_GLA_IN) { const int j = r / IT_GLA_IN; r %= IT_GLA_IN; tr_item<0>(karg_in(I_GLA_WIN) + (size_t)j * D * GLA_IN, D, GLA_IN, 3072, (bf16_t*)(ws + W_GLA_IN + j * SZ_GLA_IN), scr, r, lane, 0); continue; } r -= 2 * IT_GLA_IN;
        if (r < 2 * IT_SQ) { const int j = r / IT_SQ; r %= IT_SQ; tr_item<0>(karg_in(I_GLA_WOUT) + (size_t)j * D * D, D, D, D, (bf16_t*)(ws + W_GLA_OUT + j * SZ_SQ), scr, r, lane, 0); continue; } r -= 2 * IT_SQ;
        if (r < IT_CONV_IN) { tr_item<1>(karg_in(I_CONV_WIN), D, 2048, 2048, (bf16_t*)(ws + W_CONV_IN), scr, r, lane, 1024); continue; } r -= IT_CONV_IN;
        if (r < IT_SQ) { tr_item<0>(karg_in(I_CONV_WOUT), D, D, D, (bf16_t*)(ws + W_CONV_OUT), scr, r, lane, 0); continue; } r -= IT_SQ;
        if (r < IT_FOX_IN) { tr_item<2>(karg_in(I_FOX_WIN), D, FOX_IN, 4096, (bf16_t*)(ws + W_FOX_IN), scr, r, lane, 0); continue; } r -= IT_FOX_IN;
        if (r < IT_SQ) { tr_item<0>(karg_in(I_FOX_WOUT), D, D, D, (bf16_t*)(ws + W_FOX_OUT), scr, r, lane, 0); continue; } r -= IT_SQ;
        if (r < 2 * IT_FFN13) { const int j = r / IT_FFN13; r %= IT_FFN13; tr_item<1, FFN_FP8 != 0>(karg_in(I_FFN_W13) + (size_t)j * D * 2 * DFF, D, 2 * DFF, 2 * DFF, (bf16_t*)(ws + W_FFN13 + j * SZ_FFN13), scr, r, lane, DFF, F8_W13); continue; } r -= 2 * IT_FFN13;
        if (r < 2 * IT_FFN2) { const int j = r / IT_FFN2; r %= IT_FFN2; tr_item<0>(karg_in(I_FFN_W2) + (size_t)j * DFF * D, DFF, D, D, (bf16_t*)(ws + W_FFN2 + j * SZ_FFN2), scr, r, lane, 0); continue; } r -= 2 * IT_FFN2;
        if (r < 16 * IT_MOE13) { const int j = r / IT_MOE13; r %= IT_MOE13; tr_item<1, MOE_FP8 != 0>(karg_in(I_MOE_W13) + (size_t)j * D * 2 * DFE, D, 2 * DFE, 2 * DFE, (bf16_t*)(ws + W_MOE13 + j * MOE13_STRIDE), scr, r, lane, DFE, F8_W13); continue; } r -= 16 * IT_MOE13;
        { const int j = r / IT_MOE2; r %= IT_MOE2; tr_item<0, MOE_FP8 != 0>(karg_in(I_MOE_W2) + (size_t)j * DFE * D, DFE, D, D, (bf16_t*)(ws + W_MOE2 + j * MOE2_STRIDE), scr, r, lane, 0, F8_W2); }
    }
}

struct NormArgs {
    const float* xin; float* xout; bf16_t* H; const float* sc; const float* sh;
    int combine; const bf16_t* Y; const u32x4* tinfo; const float* g2p; const unsigned* cntp;
    const float* wx; int wx_pitch; float cscale;
    const float* w2; const float* bvec;
    float* Dk; float* dref; float* etot; float* lf;
    int* tok; u32x4* tinfo_out; unsigned* cnt;
    const float* gamma; float* out;
};
template <int VAR>
__device__ __forceinline__ void norm_phase(LAS unsigned char* lds, const NormArgs& a, int G) {
    const int tid = opaque_tid(), lane = tid & 63, wave = __builtin_amdgcn_readfirstlane(tid >> 6);
    constexpr int NX = (VAR == 1 || VAR == 2) ? 16 : (VAR == 3) ? 8 : 0;
    LAS float* WX = (LAS float*)lds;
    LAS float* W2 = (LAS float*)(lds + 65536);
    LAS float* BG = (LAS float*)(lds + 98304);
    LAS float* TOTW = (LAS float*)(lds + 100352);
    LAS int* SEL_E = (LAS int*)(lds + 65536);
    LAS float* SEL_G = (LAS float*)(lds + 65536 + 512);
    LAS int* BASE = (LAS int*)(lds + 65536 + 1024);
    LAS int* TAB = (LAS int*)(lds + LDS_TAB);
    if constexpr (NX > 0) {
        for (int idx = tid; idx < D * NX; idx += NTHR) { const int k = idx / NX, n = idx % NX; const float v = a.wx[(size_t)k * a.wx_pitch + n];
            const int l = (k & 255) >> 2, j = k >> 8, i = k & 3; WX[((((j * 4 + i) * (NX / 4) + (n >> 2)) * 64 + l) << 2) + (n & 3)] = v; }
    }
    if (VAR == 1) { for (int idx = tid; idx < 16 * 512; idx += NTHR) W2[idx] = a.w2[idx]; for (int idx = tid; idx < 512; idx += NTHR) BG[idx] = a.bvec[idx]; }
    if (a.combine && tid == 0) { int s = 0; for (int e = 0; e < NE; ++e) { TAB[e] = s; s += ((int)a.cntp[e] + 255) >> 8; } TAB[8] = s; }
    __syncthreads();
    for (int g = blockIdx.x; g < NTOK / 64; g += G) {
        const int b = g / (SEQ / 64);
        f32x4 scv[4], shv[4], g2v[4], gmv[4];
#pragma unroll
        for (int j = 0; j < 4; ++j) {
            if (VAR != 4) { scv[j] = *(const f32x4*)(a.sc + (size_t)b * MOD_W + 4 * lane + 256 * j) + 1.0f; shv[j] = *(const f32x4*)(a.sh + (size_t)b * MOD_W + 4 * lane + 256 * j); }
            else gmv[j] = *(const f32x4*)(a.gamma + 4 * lane + 256 * j);
            if (a.combine) g2v[j] = *(const f32x4*)(a.g2p + (size_t)b * MOD_W + 4 * lane + 256 * j) * a.cscale; }
        float run[8];
        if (VAR == 1) {
#pragma unroll
            for (int c = 0; c < 8; ++c) run[c] = 0.f; }
        const bf16_t* xin16 = (const bf16_t*)a.xin; bf16_t* xout16 = (bf16_t*)a.xout;
        u32x2 xn[4];
#pragma unroll
        for (int j = 0; j < 4; ++j) xn[j] = *(const u32x2*)(xin16 + (size_t)(g * 64 + wave * 8) * D + 4 * lane + 256 * j);
#pragma unroll 1
        for (int r = 0; r < 8; ++r) {
            const int row = g * 64 + wave * 8 + r;
            f32x4 x[4];
#pragma unroll
            for (int j = 0; j < 4; ++j) x[j] = (f32x4){bf_lo(xn[j].x), bf_hi(xn[j].x), bf_lo(xn[j].y), bf_hi(xn[j].y)};
            if (r < 7) {
#pragma unroll
                for (int j = 0; j < 4; ++j) xn[j] = *(const u32x2*)(xin16 + (size_t)(row + 1) * D + 4 * lane + 256 * j); }
            if (a.combine) {
                const u32x4 ti = a.tinfo[row];
                const int e0 = ti.x >> 15, e1 = ti.y >> 15; const size_t r0 = (size_t)TAB[e0] * 256 + (ti.x & 32767u), r1 = (size_t)TAB[e1] * 256 + (ti.y & 32767u);
                const float ga = __uint_as_float(ti.z), gb = __uint_as_float(ti.w);
#pragma unroll
                for (int j = 0; j < 4; ++j) { const u32x2 y0 = *(const u32x2*)(a.Y + r0 * D + 4 * lane + 256 * j), y1 = *(const u32x2*)(a.Y + r1 * D + 4 * lane + 256 * j);
                    f32x4 m; m[0] = ga * bf_lo(y0.x) + gb * bf_lo(y1.x); m[1] = ga * bf_hi(y0.x) + gb * bf_hi(y1.x); m[2] = ga * bf_lo(y0.y) + gb * bf_lo(y1.y); m[3] = ga * bf_hi(y0.y) + gb * bf_hi(y1.y);
                    x[j] = x[j] + g2v[j] * m; if (VAR != 4) { u32x2 xw; xw.x = pk2(x[j][0], x[j][1]); xw.y = pk2(x[j][2], x[j][3]); *(u32x2*)(xout16 + (size_t)row * D + 4 * lane + 256 * j) = xw; } }
            }
            float ss = 0.f;
#pragma unroll
            for (int j = 0; j < 4; ++j) ss += (x[j][0] * x[j][0] + x[j][1] * x[j][1]) + (x[j][2] * x[j][2] + x[j][3] * x[j][3]);
            const float rstd = __builtin_amdgcn_rsqf(wave_sum(ss) * (1.0f / D) + EPS);
            if (VAR == 4) {
#pragma unroll
                for (int j = 0; j < 4; ++j) *(f32x4*)(a.out + (size_t)row * D + 4 * lane + 256 * j) = x[j] * rstd * gmv[j];
                continue;
            }
            f32x4 h[4];
#pragma unroll
            for (int j = 0; j < 4; ++j) { h[j] = x[j] * rstd * scv[j] + shv[j];
                if ((VAR == 3 && MOE_FP8) || (VAR == 0 && a.wx_pitch < 0)) {        *(unsigned*)((unsigned char*)a.H + (size_t)row * D + 4 * lane + 256 * j) = pk4_fp8(h[j][0], h[j][1], h[j][2], h[j][3]); }
                else { u32x2 w; w.x = pk2(h[j][0], h[j][1]); w.y = pk2(h[j][2], h[j][3]); *(u32x2*)(a.H + (size_t)row * D + 4 * lane + 256 * j) = w; } }
            if constexpr (NX > 0) {
                float p[NX];
#pragma unroll
                for (int n = 0; n < NX; ++n) p[n] = 0.f;
#pragma unroll
                for (int j = 0; j < 4; ++j)
#pragma unroll
                    for (int i = 0; i < 4; ++i)
                    {
#pragma unroll
                        for (int n4 = 0; n4 < NX / 4; ++n4) { const f32x4 w = *(const LAS f32x4*)(WX + ((((j * 4 + i) * (NX / 4) + n4) * 64 + lane) << 2));
                            p[4 * n4 + 0] += h[j][i] * w[0]; p[4 * n4 + 1] += h[j][i] * w[1]; p[4 * n4 + 2] += h[j][i] * w[2]; p[4 * n4 + 3] += h[j][i] * w[3]; }
                        if (i & 1) { if constexpr (NX == 16) asm volatile("" : "+v"(p[0]), "+v"(p[1]), "+v"(p[2]), "+v"(p[3]), "+v"(p[4]), "+v"(p[5]), "+v"(p[6]), "+v"(p[7]), "+v"(p[8]), "+v"(p[9]), "+v"(p[10]), "+v"(p[11]), "+v"(p[12]), "+v"(p[13]), "+v"(p[14]), "+v"(p[15]) :: "memory");
                            else asm volatile("" : "+v"(p[0]), "+v"(p[1]), "+v"(p[2]), "+v"(p[3]), "+v"(p[4]), "+v"(p[5]), "+v"(p[6]), "+v"(p[7]) :: "memory");
                            __builtin_amdgcn_sched_barrier(0); } }
                xreduce<NX>(p, lane);
                const float red = p[0];
                if (VAR == 1) {
                    float gl[16];
#pragma unroll
                    for (int n = 0; n < 16; ++n) gl[n] = __uint_as_float(__builtin_amdgcn_readlane(__float_as_uint(red), 4 * n));
#pragma unroll
                    for (int jj = 0; jj < 2; ++jj) { f32x4 z = *(const LAS f32x4*)(BG + 256 * jj + 4 * lane);
#pragma unroll
                        for (int n = 0; n < 16; ++n) { z = z + gl[n] * *(const LAS f32x4*)(W2 + n * 512 + 256 * jj + 4 * lane); if ((n & 3) == 3) { asm volatile("" : "+v"(z) :: "memory"); __builtin_amdgcn_sched_barrier(0); } }
#pragma unroll
                        for (int i = 0; i < 4; ++i) run[4 * jj + i] += log_sigmoid(z[i]) * (1.0f / 16.0f);
                        *(f32x4*)(a.Dk + (size_t)row * 512 + 256 * jj + 4 * lane) = (f32x4){run[4 * jj], run[4 * jj + 1], run[4 * jj + 2], run[4 * jj + 3]}; }
                }
                if (VAR == 2) { if ((lane & 3) == 0) { const int n = lane >> 2; a.lf[(size_t)row * 16 + n] = log_sigmoid(red + a.bvec[n]); } }
                if (VAR == 3) {
                    float lg[8];
#pragma unroll
                    for (int n = 0; n < 8; ++n) lg[n] = __uint_as_float(__builtin_amdgcn_readlane(__float_as_uint(red), 8 * n));
                    int e0 = 0; float l0 = lg[0];
#pragma unroll
                    for (int n = 1; n < 8; ++n) if (lg[n] > l0) { l0 = lg[n]; e0 = n; }
                    int e1 = -1; float l1 = -3.0e38f;
#pragma unroll
                    for (int n = 0; n < 8; ++n) if (n != e0 && lg[n] > l1) { l1 = lg[n]; e1 = n; }
                    const float g0 = 1.0f / (1.0f + __expf(l1 - l0));
                    if (lane == 0) { const int lr = wave * 8 + r; SEL_E[lr * 2] = e0; SEL_E[lr * 2 + 1] = e1; SEL_G[lr * 2] = g0; SEL_G[lr * 2 + 1] = 1.0f - g0; }
                }
            }
            FENCE();
        }
        if (VAR == 1) {
#pragma unroll
            for (int jj = 0; jj < 2; ++jj) { f32x4 t; t[0] = run[4 * jj]; t[1] = run[4 * jj + 1]; t[2] = run[4 * jj + 2]; t[3] = run[4 * jj + 3]; *(LAS f32x4*)(TOTW + wave * 512 + 256 * jj + 4 * lane) = t; }
            __syncthreads();
#pragma unroll
            for (int jj = 0; jj < 2; ++jj) { f32x4 off = (f32x4){0.f, 0.f, 0.f, 0.f}, tot = (f32x4){0.f, 0.f, 0.f, 0.f};
#pragma unroll
                for (int w8 = 0; w8 < 8; ++w8) { const f32x4 t = *(const LAS f32x4*)(TOTW + w8 * 512 + 256 * jj + 4 * lane); tot = tot + t; if (w8 < wave) off = off + t; }
                *(f32x4*)(a.dref + ((size_t)g * 8 + wave) * 512 + 256 * jj + 4 * lane) = tot - off;
                if (wave == 0) { f32x4 e;
#pragma unroll
                    for (int i = 0; i < 4; ++i) e[i] = __expf(tot[i]);
                    *(f32x4*)(a.etot + (size_t)g * 512 + 256 * jj + 4 * lane) = e; } }
            __syncthreads();
        }
        if (VAR == 3) {
            __syncthreads();
            if (tid < NE) { int c = 0; for (int q = 0; q < 128; ++q) c += (SEL_E[q] == tid) ? 1 : 0; BASE[tid] = c ? (int)atomicAdd(a.cnt + tid, (unsigned)c) : 0; }
            __syncthreads();
            if (tid < 128) { const int e = SEL_E[tid]; int pos = BASE[e]; for (int q = 0; q < tid; ++q) pos += (SEL_E[q] == e) ? 1 : 0;
                const int row = g * 64 + (tid >> 1); a.tok[e * MOE_CAP + pos] = row;
                unsigned* ti = (unsigned*)(a.tinfo_out + row); ti[tid & 1] = (unsigned)(e * MOE_CAP + pos); ti[2 + (tid & 1)] = __float_as_uint(SEL_G[tid]); }
            __syncthreads();
        }
    }
}


template <int VAR>
__device__ __forceinline__ void norm_mfma(LAS unsigned char* lds, const NormArgs& a, int G) {
    const int tid = opaque_tid(), lane = tid & 63, wave = __builtin_amdgcn_readfirstlane(tid >> 6), r = lane & 15, g = lane >> 4;
    constexpr int NXv = (VAR == 3) ? 8 : 16, WP = 1032;
    LAS bf16_t* WT = (LAS bf16_t*)lds; LAS bf16_t* WTL = (LAS bf16_t*)(lds + 33024);
    LAS float* SC = (LAS float*)(lds + 66048); LAS float* SH = SC + 1024; LAS float* G2 = SH + 1024;
    LAS bf16_t* W2T = (LAS bf16_t*)(lds + 78336); LAS float* BG = (LAS float*)(lds + 94720); LAS float* GL = (LAS float*)(lds + 96768); LAS float* TOT = (LAS float*)(lds + 105472);
    LAS float* LG = (LAS float*)(lds + 78336); LAS int* SEL_E = (LAS int*)(lds + 82432); LAS float* SEL_G = (LAS float*)(lds + 83456); LAS int* BASE = (LAS int*)(lds + 84480);
    LAS int* TAB = (LAS int*)(lds + LDS_TAB);
    for (int idx = tid; idx < D * 16; idx += NTHR) { const int k = idx >> 4, n = idx & 15; const float v = (n < NXv) ? a.wx[(size_t)k * a.wx_pitch + n] : 0.f;
        const unsigned hi = pk2(v, 0.f) & 0xffffu; WT[n * WP + k] = (bf16_t)hi;
        if (VAR == 3) WTL[n * WP + k] = (bf16_t)(pk2(v - __uint_as_float(hi << 16), 0.f) & 0xffffu); }
    if (VAR == 1) { for (int idx = tid; idx < 16 * 512; idx += NTHR) { const int rr = idx >> 9, col = idx & 511; W2T[col * 16 + rr] = (bf16_t)(pk2(a.w2[idx], 0.f) & 0xffffu); }
        for (int idx = tid; idx < 512; idx += NTHR) BG[idx] = a.bvec[idx]; }
    if (a.combine && tid == 0) { int sx = 0; for (int e = 0; e < NE; ++e) { TAB[e] = sx; sx += ((int)a.cntp[e] + 255) >> 8; } TAB[8] = sx; }
    for (int rb = blockIdx.x; rb < NTOK / 128; rb += G) {
        const int b = rb / (SEQ / 128), row = rb * 128 + wave * 16 + r;
        __syncthreads();
        for (int k = tid; k < D; k += NTHR) { SC[k] = a.sc[(size_t)b * MOD_W + k] + 1.0f; SH[k] = a.sh[(size_t)b * MOD_W + k]; if (a.combine) G2[k] = a.g2p[(size_t)b * MOD_W + k] * a.cscale; }
        __syncthreads();
        const float* xr = a.xin + (size_t)row * D + 8 * g; float* xw = a.xout + (size_t)row * D + 8 * g;
        float ss = 0.f;
        if (a.combine) {
            const u32x4 ti = a.tinfo[row];
            const size_t r0 = (size_t)TAB[ti.x >> 15] * 256 + (ti.x & 32767u), r1 = (size_t)TAB[ti.y >> 15] * 256 + (ti.y & 32767u);
            const float ga = __uint_as_float(ti.z), gb = __uint_as_float(ti.w);
            const bf16_t* y0p = a.Y + r0 * D + 8 * g; const bf16_t* y1p = a.Y + r1 * D + 8 * g;
#pragma unroll 4
            for (int sK = 0; sK < 32; ++sK) { f32x4 x0 = *(const f32x4*)(xr + 32 * sK), x1 = *(const f32x4*)(xr + 32 * sK + 4);
                const u32x4 y0 = *(const u32x4*)(y0p + 32 * sK), y1 = *(const u32x4*)(y1p + 32 * sK);
                const f32x4 g0 = *(const LAS f32x4*)(G2 + 32 * sK + 8 * g), g1 = *(const LAS f32x4*)(G2 + 32 * sK + 8 * g + 4);
                f32x4 m0, m1; m0[0] = ga * bf_lo(y0.x) + gb * bf_lo(y1.x); m0[1] = ga * bf_hi(y0.x) + gb * bf_hi(y1.x); m0[2] = ga * bf_lo(y0.y) + gb * bf_lo(y1.y); m0[3] = ga * bf_hi(y0.y) + gb * bf_hi(y1.y);
                m1[0] = ga * bf_lo(y0.z) + gb * bf_lo(y1.z); m1[1] = ga * bf_hi(y0.z) + gb * bf_hi(y1.z); m1[2] = ga * bf_lo(y0.w) + gb * bf_lo(y1.w); m1[3] = ga * bf_hi(y0.w) + gb * bf_hi(y1.w);
                x0 = x0 + g0 * m0; x1 = x1 + g1 * m1; *(f32x4*)(xw + 32 * sK) = x0; *(f32x4*)(xw + 32 * sK + 4) = x1;
                ss += (x0[0] * x0[0] + x0[1] * x0[1]) + (x0[2] * x0[2] + x0[3] * x0[3]) + (x1[0] * x1[0] + x1[1] * x1[1]) + (x1[2] * x1[2] + x1[3] * x1[3]); }
        } else {
#pragma unroll 8
            for (int sK = 0; sK < 32; ++sK) { const f32x4 x0 = *(const f32x4*)(xr + 32 * sK), x1 = *(const f32x4*)(xr + 32 * sK + 4);
                ss += (x0[0] * x0[0] + x0[1] * x0[1]) + (x0[2] * x0[2] + x0[3] * x0[3]) + (x1[0] * x1[0] + x1[1] * x1[1]) + (x1[2] * x1[2] + x1[3] * x1[3]); }
        }
        ss += __shfl_xor(ss, 16); ss += __shfl_xor(ss, 32);
        const float rstd = __builtin_amdgcn_rsqf(ss * (1.0f / D) + EPS);
        const float* x2 = (a.combine ? (const float*)a.xout : a.xin) + (size_t)row * D + 8 * g;
        f32x4 acc = (f32x4){0.f, 0.f, 0.f, 0.f};
#pragma unroll 4
        for (int sK = 0; sK < 32; ++sK) { const f32x4 x0 = *(const f32x4*)(x2 + 32 * sK), x1 = *(const f32x4*)(x2 + 32 * sK + 4);
            const f32x4 c0 = *(const LAS f32x4*)(SC + 32 * sK + 8 * g), c1 = *(const LAS f32x4*)(SC + 32 * sK + 8 * g + 4), s0 = *(const LAS f32x4*)(SH + 32 * sK + 8 * g), s1 = *(const LAS f32x4*)(SH + 32 * sK + 8 * g + 4);
            const f32x4 h0 = x0 * rstd * c0 + s0, h1 = x1 * rstd * c1 + s1;
            u32x4 hw; hw.x = pk2(h0[0], h0[1]); hw.y = pk2(h0[2], h0[3]); hw.z = pk2(h1[0], h1[1]); hw.w = pk2(h1[2], h1[3]);
            if (VAR == 3 && MOE_FP8) { u32x2 w8; w8.x = pk4_fp8(h0[0], h0[1], h0[2], h0[3]); w8.y = pk4_fp8(h1[0], h1[1], h1[2], h1[3]); *(u32x2*)((unsigned char*)a.H + (size_t)row * D + 32 * sK + 8 * g) = w8; }
            else *(u32x4*)(a.H + (size_t)row * D + 32 * sK + 8 * g) = hw;
            const bf16x8 af = __builtin_bit_cast(bf16x8, hw), bw = *(const LAS bf16x8*)(WT + r * WP + 32 * sK + 8 * g);
            acc = __builtin_amdgcn_mfma_f32_16x16x32_bf16(af, bw, acc, 0, 0, 0);
            if (VAR == 3) {
                u32x4 lw; lw.x = pk2(h0[0] - bf_lo(hw.x), h0[1] - bf_hi(hw.x)); lw.y = pk2(h0[2] - bf_lo(hw.y), h0[3] - bf_hi(hw.y)); lw.z = pk2(h1[0] - bf_lo(hw.z), h1[1] - bf_hi(hw.z)); lw.w = pk2(h1[2] - bf_lo(hw.w), h1[3] - bf_hi(hw.w));
                const bf16x8 bl = *(const LAS bf16x8*)(WTL + r * WP + 32 * sK + 8 * g);
                acc = __builtin_amdgcn_mfma_f32_16x16x32_bf16(__builtin_bit_cast(bf16x8, lw), bw, acc, 0, 0, 0);
                acc = __builtin_amdgcn_mfma_f32_16x16x32_bf16(af, bl, acc, 0, 0, 0); } }
        const int grow0 = rb * 128 + wave * 16;
        if (VAR == 2) {
            const float bfv = a.bvec[r];
#pragma unroll
            for (int i = 0; i < 4; ++i) a.lf[(size_t)(grow0 + 4 * g + i) * 16 + r] = log_sigmoid(acc[i] + bfv);
        }
        if (VAR == 3) {
            if (r < 8) {
#pragma unroll
                for (int i = 0; i < 4; ++i) LG[(wave * 16 + 4 * g + i) * 8 + r] = acc[i]; }
            asm volatile("s_waitcnt lgkmcnt(0)" ::: "memory");
            if (lane < 16) { const int lr = wave * 16 + lane; float lg[8];
                const f32x4 la = *(const LAS f32x4*)(LG + lr * 8), lb = *(const LAS f32x4*)(LG + lr * 8 + 4);
                lg[0] = la[0]; lg[1] = la[1]; lg[2] = la[2]; lg[3] = la[3]; lg[4] = lb[0]; lg[5] = lb[1]; lg[6] = lb[2]; lg[7] = lb[3];
                int e0 = 0; float l0 = lg[0];
#pragma unroll
                for (int n = 1; n < 8; ++n) { const bool up = lg[n] > l0; l0 = up ? lg[n] : l0; e0 = up ? n : e0; }
                int e1 = 0; float l1 = -3.0e38f;
#pragma unroll
                for (int n = 0; n < 8; ++n) { const bool up = (n != e0) && (lg[n] > l1); l1 = up ? lg[n] : l1; e1 = up ? n : e1; }
                const float g0 = 1.0f / (1.0f + __expf(l1 - l0));
                SEL_E[lr * 2] = e0; SEL_E[lr * 2 + 1] = e1; SEL_G[lr * 2] = g0; SEL_G[lr * 2 + 1] = 1.0f - g0; }
            __syncthreads();
            if (tid < NE) { int c = 0; for (int q = 0; q < 256; ++q) c += (SEL_E[q] == tid) ? 1 : 0; BASE[tid] = c ? (int)atomicAdd(a.cnt + tid, (unsigned)c) : 0; }
            __syncthreads();
            if (tid < 256) { const int e = SEL_E[tid]; int pos = BASE[e]; for (int q = 0; q < tid; ++q) pos += (SEL_E[q] == e) ? 1 : 0;
                const int trow = rb * 128 + (tid >> 1); a.tok[e * MOE_CAP + pos] = trow;
                unsigned* ti = (unsigned*)(a.tinfo_out + trow); ti[tid & 1] = (unsigned)(e * MOE_CAP + pos); ti[2 + (tid & 1)] = __float_as_uint(SEL_G[tid]); }
        }
        if (VAR == 1) {
            LAS float* GLw = GL + wave * (16 * 17);
#pragma unroll
            for (int i = 0; i < 4; ++i) GLw[(4 * g + i) * 17 + r] = acc[i];
            asm volatile("s_waitcnt lgkmcnt(0)" ::: "memory");
            bf16x8 bg8; { float t[8];
#pragma unroll
                for (int j = 0; j < 8; ++j) t[j] = (g < 2) ? GLw[r * 17 + 8 * (g & 1) + j] : 0.f;
                u32x4 tw; tw.x = pk2(t[0], t[1]); tw.y = pk2(t[2], t[3]); tw.z = pk2(t[4], t[5]); tw.w = pk2(t[6], t[7]); bg8 = __builtin_bit_cast(bf16x8, tw); }
#pragma unroll 2
            for (int cb = 0; cb < 32; ++cb) {
                u32x4 aw = *(const LAS u32x4*)(W2T + (16 * cb + r) * 16 + 8 * (g & 1)); if (g >= 2) aw = (u32x4){0u, 0u, 0u, 0u};
                const f32x4 z = __builtin_amdgcn_mfma_f32_16x16x32_bf16(__builtin_bit_cast(bf16x8, aw), bg8, (f32x4){0.f, 0.f, 0.f, 0.f}, 0, 0, 0);
                const f32x4 bgv = *(const LAS f32x4*)(BG + 16 * cb + 4 * g);
                f32x4 la;
#pragma unroll
                for (int i = 0; i < 4; ++i) la[i] = log_sigmoid(z[i] + bgv[i]) * (1.0f / 16.0f);
#pragma unroll
                for (int off = 1; off < 16; off <<= 1) {
#pragma unroll
                    for (int i = 0; i < 4; ++i) { const float t = __shfl_up(la[i], off, 16); la[i] += (r >= off) ? t : 0.f; } }
                *(f32x4*)(a.Dk + (size_t)row * 512 + 16 * cb + 4 * g) = la;
                if (r == 15) *(LAS f32x4*)(TOT + wave * 512 + 16 * cb + 4 * g) = la;
            }
            __syncthreads();
            const int w0 = wave & ~3;
#pragma unroll
            for (int j = 0; j < 8; ++j) { const int c = lane + 64 * j; float tot = 0.f, off = 0.f;
#pragma unroll
                for (int w4 = 0; w4 < 4; ++w4) { const float t = TOT[(w0 + w4) * 512 + c]; tot += t; off += (w0 + w4 < wave) ? t : 0.f; }
                a.dref[((size_t)rb * 8 + wave) * 512 + c] = tot - off;
                if ((wave & 3) == 0) a.etot[((size_t)rb * 2 + (wave >> 2)) * 512 + c] = __expf(tot); }
        }
    }
}


template <int VAR, bool XF32 = false>
__device__ __forceinline__ void norm_mfma2(LAS unsigned char* lds, const NormArgs& a, int G) {
    const int tid = opaque_tid(), lane = tid & 63, wave = __builtin_amdgcn_readfirstlane(tid >> 6), r = lane & 15, g = lane >> 4;
    constexpr int NXv = (VAR == 3) ? 8 : 16, WP = 1032;
    LAS bf16_t* WT = (LAS bf16_t*)lds; LAS bf16_t* WTL = (LAS bf16_t*)(lds + 33024);
    LAS float* SC = (LAS float*)(lds + 66048); LAS float* SH = SC + 1024; LAS float* G2 = SH + 1024;
    LAS bf16_t* W2T = (LAS bf16_t*)(lds + 78336); LAS float* BG = (LAS float*)(lds + 94720); LAS float* TOT = (LAS float*)(lds + 96768);
    LAS float* PS = (LAS float*)(lds + 113152);
    LAS float* PA = (LAS float*)(lds + 113664);
    LAS float* OUTS = (LAS float*)(lds + 121856);
    LAS int* SEL_E = (LAS int*)(lds + 123008); LAS float* SEL_G = (LAS float*)(lds + 124032); LAS int* BASE = (LAS int*)(lds + 125056);
    LAS int* TAB = (LAS int*)(lds + LDS_TAB);
    for (int idx = tid; idx < D * 16; idx += NTHR) { const int k = idx >> 4, n = idx & 15; const float v = (n < NXv) ? a.wx[(size_t)k * a.wx_pitch + n] : 0.f;
        const unsigned hi = pk2(v, 0.f) & 0xffffu; WT[n * WP + k] = (bf16_t)hi;
        if (VAR == 3) WTL[n * WP + k] = (bf16_t)(pk2(v - __uint_as_float(hi << 16), 0.f) & 0xffffu); }
    if (VAR == 1) { for (int idx = tid; idx < 16 * 512; idx += NTHR) { const int rr = idx >> 9, col = idx & 511; W2T[col * 16 + rr] = (bf16_t)(pk2(a.w2[idx], 0.f) & 0xffffu); }
        for (int idx = tid; idx < 512; idx += NTHR) BG[idx] = a.bvec[idx]; }
    if (a.combine && tid == 0) { int sx = 0; for (int e = 0; e < NE; ++e) { TAB[e] = sx; sx += ((int)a.cntp[e] + 255) >> 8; } TAB[8] = sx; }
    const int kw = 128 * wave + 8 * g;
    for (int rb = blockIdx.x; rb < NTOK / 128; rb += G) {
        const int b = rb / (SEQ / 128);
        __syncthreads();
        for (int k = tid; k < D; k += NTHR) { SC[k] = a.sc[(size_t)b * MOD_W + k] + 1.0f; SH[k] = a.sh[(size_t)b * MOD_W + k]; if (a.combine) G2[k] = a.g2p[(size_t)b * MOD_W + k] * a.cscale; }
        __syncthreads();
        f32x4 xa[4][2]; u32x4 xb[4];
#define NM2_LOAD(ROW) do { if constexpr (XF32) { const float* xr = a.xin + (size_t)(ROW) * D + kw; \
            _Pragma("unroll") for (int sK = 0; sK < 4; ++sK) { xa[sK][0] = *(const f32x4*)(xr + 32 * sK); xa[sK][1] = *(const f32x4*)(xr + 32 * sK + 4); } } \
        else { const bf16_t* xr = (const bf16_t*)a.xin + (size_t)(ROW) * D + kw; \
            _Pragma("unroll") for (int sK = 0; sK < 4; ++sK) xb[sK] = *(const u32x4*)(xr + 32 * sK); } } while (0)
        NM2_LOAD(rb * 128 + r);
#pragma unroll 1
        for (int gi = 0; gi < 8; ++gi) {
            const int row = rb * 128 + gi * 16 + r;
            f32x4 x[4][2];
#pragma unroll
            for (int sK = 0; sK < 4; ++sK) { if constexpr (XF32) { x[sK][0] = xa[sK][0]; x[sK][1] = xa[sK][1]; }
                else { x[sK][0] = (f32x4){bf_lo(xb[sK].x), bf_hi(xb[sK].x), bf_lo(xb[sK].y), bf_hi(xb[sK].y)}; x[sK][1] = (f32x4){bf_lo(xb[sK].z), bf_hi(xb[sK].z), bf_lo(xb[sK].w), bf_hi(xb[sK].w)}; } }
            if (gi < 7) NM2_LOAD(row + 16);
            if (a.combine) {
                const u32x4 ti = a.tinfo[row];
                const size_t r0 = (size_t)TAB[ti.x >> 15] * 256 + (ti.x & 32767u), r1 = (size_t)TAB[ti.y >> 15] * 256 + (ti.y & 32767u);
                const float ga = __uint_as_float(ti.z), gb = __uint_as_float(ti.w);
                const bf16_t* y0p = a.Y + r0 * D + kw; const bf16_t* y1p = a.Y + r1 * D + kw; bf16_t* xw = (bf16_t*)a.xout + (size_t)row * D + kw;
#pragma unroll
                for (int sK = 0; sK < 4; ++sK) { const u32x4 y0 = *(const u32x4*)(y0p + 32 * sK), y1 = *(const u32x4*)(y1p + 32 * sK);
                    const f32x4 g0 = *(const LAS f32x4*)(G2 + kw + 32 * sK), g1 = *(const LAS f32x4*)(G2 + kw + 32 * sK + 4);
                    f32x4 m0, m1; m0[0] = ga * bf_lo(y0.x) + gb * bf_lo(y1.x); m0[1] = ga * bf_hi(y0.x) + gb * bf_hi(y1.x); m0[2] = ga * bf_lo(y0.y) + gb * bf_lo(y1.y); m0[3] = ga * bf_hi(y0.y) + gb * bf_hi(y1.y);
                    m1[0] = ga * bf_lo(y0.z) + gb * bf_lo(y1.z); m1[1] = ga * bf_hi(y0.z) + gb * bf_hi(y1.z); m1[2] = ga * bf_lo(y0.w) + gb * bf_lo(y1.w); m1[3] = ga * bf_hi(y0.w) + gb * bf_hi(y1.w);
                    x[sK][0] = x[sK][0] + g0 * m0; x[sK][1] = x[sK][1] + g1 * m1;
                    u32x4 xs; xs.x = pk2(x[sK][0][0], x[sK][0][1]); xs.y = pk2(x[sK][0][2], x[sK][0][3]); xs.z = pk2(x[sK][1][0], x[sK][1][1]); xs.w = pk2(x[sK][1][2], x[sK][1][3]); *(u32x4*)(xw + 32 * sK) = xs; }
            }
            float ss = 0.f;
#pragma unroll
            for (int sK = 0; sK < 4; ++sK) { const f32x4 x0 = x[sK][0], x1 = x[sK][1];
                ss += (x0[0] * x0[0] + x0[1] * x0[1]) + (x0[2] * x0[2] + x0[3] * x0[3]) + (x1[0] * x1[0] + x1[1] * x1[1]) + (x1[2] * x1[2] + x1[3] * x1[3]); }
            ss += __shfl_xor(ss, 16); ss += __shfl_xor(ss, 32);
            if (g == 0) PS[wave * 16 + r] = ss;
            __syncthreads();
            float st = 0.f;
#pragma unroll
            for (int w8 = 0; w8 < 8; ++w8) st += PS[w8 * 16 + r];
            const float rstd = __builtin_amdgcn_rsqf(st * (1.0f / D) + EPS);
            f32x4 acc = (f32x4){0.f, 0.f, 0.f, 0.f};
#pragma unroll
            for (int sK = 0; sK < 4; ++sK) {
                const f32x4 c0 = *(const LAS f32x4*)(SC + kw + 32 * sK), c1 = *(const LAS f32x4*)(SC + kw + 32 * sK + 4), s0 = *(const LAS f32x4*)(SH + kw + 32 * sK), s1 = *(const LAS f32x4*)(SH + kw + 32 * sK + 4);
                const f32x4 h0 = x[sK][0] * rstd * c0 + s0, h1 = x[sK][1] * rstd * c1 + s1;
                u32x4 hw; hw.x = pk2(h0[0], h0[1]); hw.y = pk2(h0[2], h0[3]); hw.z = pk2(h1[0], h1[1]); hw.w = pk2(h1[2], h1[3]);
                if (VAR == 3 && MOE_FP8) { u32x2 w8; w8.x = pk4_fp8(h0[0], h0[1], h0[2], h0[3]); w8.y = pk4_fp8(h1[0], h1[1], h1[2], h1[3]); *(u32x2*)((unsigned char*)a.H + (size_t)row * D + kw + 32 * sK) = w8; }
                else *(u32x4*)(a.H + (size_t)row * D + kw + 32 * sK) = hw;
                const bf16x8 af = __builtin_bit_cast(bf16x8, hw), bw = *(const LAS bf16x8*)(WT + r * WP + kw + 32 * sK);
                acc = __builtin_amdgcn_mfma_f32_16x16x32_bf16(af, bw, acc, 0, 0, 0);
                if (VAR == 3) {
                    u32x4 lw; lw.x = pk2(h0[0] - bf_lo(hw.x), h0[1] - bf_hi(hw.x)); lw.y = pk2(h0[2] - bf_lo(hw.y), h0[3] - bf_hi(hw.y)); lw.z = pk2(h1[0] - bf_lo(hw.z), h1[1] - bf_hi(hw.z)); lw.w = pk2(h1[2] - bf_lo(hw.w), h1[3] - bf_hi(hw.w));
                    const bf16x8 bl = *(const LAS bf16x8*)(WTL + r * WP + kw + 32 * sK);
                    acc = __builtin_amdgcn_mfma_f32_16x16x32_bf16(__builtin_bit_cast(bf16x8, lw), bw, acc, 0, 0, 0);
                    acc = __builtin_amdgcn_mfma_f32_16x16x32_bf16(af, bl, acc, 0, 0, 0); } }
#pragma unroll
            for (int i = 0; i < 4; ++i) PA[(wave * 16 + 4 * g + i) * 16 + r] = acc[i];
            __syncthreads();
            if (tid < 256) { float o = 0.f;
#pragma unroll
                for (int w8 = 0; w8 < 8; ++w8) o += PA[w8 * 256 + tid];
                OUTS[(tid >> 4) * 17 + (tid & 15)] = o; }
            __syncthreads();
            const int grow0 = rb * 128 + gi * 16;
            if (VAR == 2) { if (tid < 256) { const int rr = tid >> 4, n = tid & 15; a.lf[(size_t)(grow0 + rr) * 16 + n] = log_sigmoid(OUTS[rr * 17 + n] + a.bvec[n]); } }
            if (VAR == 3) {
                if (tid < 16) { const int lr = gi * 16 + tid; float lg[8];
#pragma unroll
                    for (int n = 0; n < 8; ++n) lg[n] = OUTS[tid * 17 + n];
                    int e0 = 0; float l0 = lg[0];
#pragma unroll
                    for (int n = 1; n < 8; ++n) { const bool up = lg[n] > l0; l0 = up ? lg[n] : l0; e0 = up ? n : e0; }
                    int e1 = 0; float l1 = -3.0e38f;
#pragma unroll
                    for (int n = 0; n < 8; ++n) { const bool up = (n != e0) && (lg[n] > l1); l1 = up ? lg[n] : l1; e1 = up ? n : e1; }
                    const float g0 = 1.0f / (1.0f + __expf(l1 - l0));
                    SEL_E[lr * 2] = e0; SEL_E[lr * 2 + 1] = e1; SEL_G[lr * 2] = g0; SEL_G[lr * 2 + 1] = 1.0f - g0; } }
            if (VAR == 1) {
                bf16x8 bg8; { float t[8];
#pragma unroll
                    for (int j = 0; j < 8; ++j) t[j] = (g < 2) ? OUTS[r * 17 + 8 * (g & 1) + j] : 0.f;
                    u32x4 tw; tw.x = pk2(t[0], t[1]); tw.y = pk2(t[2], t[3]); tw.z = pk2(t[4], t[5]); tw.w = pk2(t[6], t[7]); bg8 = __builtin_bit_cast(bf16x8, tw); }
#pragma unroll
                for (int c4 = 0; c4 < 4; ++c4) { const int cb = 4 * wave + c4;
                    u32x4 aw = *(const LAS u32x4*)(W2T + (16 * cb + r) * 16 + 8 * (g & 1)); if (g >= 2) aw = (u32x4){0u, 0u, 0u, 0u};
                    const f32x4 z = __builtin_amdgcn_mfma_f32_16x16x32_bf16(__builtin_bit_cast(bf16x8, aw), bg8, (f32x4){0.f, 0.f, 0.f, 0.f}, 0, 0, 0);
                    const f32x4 bgv = *(const LAS f32x4*)(BG + 16 * cb + 4 * g);
                    f32x4 la;
#pragma unroll
                    for (int i = 0; i < 4; ++i) la[i] = log_sigmoid(z[i] + bgv[i]) * (1.0f / 16.0f);
#pragma unroll
                    for (int off = 1; off < 16; off <<= 1) {
#pragma unroll
                        for (int i = 0; i < 4; ++i) { const float t = __shfl_up(la[i], off, 16); la[i] += (r >= off) ? t : 0.f; } }
                    { u32x2 dw; dw.x = pk2(la[0], la[1]); dw.y = pk2(la[2], la[3]); *(u32x2*)((bf16_t*)a.Dk + (size_t)row * 512 + 16 * cb + 4 * g) = dw; }
                    if (r == 15) *(LAS f32x4*)(TOT + gi * 512 + 16 * cb + 4 * g) = la; } }
        }
        if (VAR == 1) {
            __syncthreads();
#pragma unroll
            for (int j = 0; j < 8; ++j) { const int idx = tid + NTHR * j, gi = idx >> 9, c = idx & 511, g0i = gi & ~3; float tot = 0.f, off = 0.f;
#pragma unroll
                for (int w4 = 0; w4 < 4; ++w4) { const float t = TOT[(g0i + w4) * 512 + c]; tot += t; off += (g0i + w4 < gi) ? t : 0.f; }
                a.dref[((size_t)rb * 8 + gi) * 512 + c] = tot - off;
                if ((gi & 3) == 0) a.etot[((size_t)rb * 2 + (gi >> 2)) * 512 + c] = __expf(tot); }
        }
        if (VAR == 3) {
            __syncthreads();
            if (tid < NE) { int c = 0; for (int q = 0; q < 256; ++q) c += (SEL_E[q] == tid) ? 1 : 0; BASE[tid] = c ? (int)atomicAdd(a.cnt + tid, (unsigned)c) : 0; }
            __syncthreads();
            if (tid < 256) { const int e = SEL_E[tid]; int pos = BASE[e]; for (int q = 0; q < tid; ++q) pos += (SEL_E[q] == e) ? 1 : 0;
                const int trow = rb * 128 + (tid >> 1); a.tok[e * MOE_CAP + pos] = trow;
                unsigned* ti = (unsigned*)(a.tinfo_out + trow); ti[tid & 1] = (unsigned)(e * MOE_CAP + pos); ti[2 + (tid & 1)] = __float_as_uint(SEL_G[tid]); }
        }
    }
}
#undef NM2_LOAD

__device__ __forceinline__ void gla_scan_phase(LAS unsigned char* lds, const bf16_t* Qg, const bf16_t* KD, const bf16_t* V, const float* etot, bf16_t* O, int vcu, int G) {
    const int tid = opaque_tid();
    constexpr int QP = 272;
    LAS unsigned char* Qs = lds; LAS unsigned char* Ks = lds + 64 * QP; LAS unsigned char* Vs = lds + 2 * 64 * QP;
    LAS float* Sl = (LAS float*)(lds + 2 * 64 * QP + 4096); LAS float* Et = Sl + 128 * 32;
    for (int u = vcu; u < NB * 4 * 8; u += G) {
        const int b = u >> 5, h = (u >> 3) & 3, vs = u & 7;
        const int kg = tid >> 5, v = tid & 31;
        const int oc = tid >> 3, ov = tid & 7;
        float S[8];
#pragma unroll
        for (int i = 0; i < 8; ++i) S[i] = 0.f;
        u32x4 pq[2], pk[2], pv; float pe = 0.f; pv = (u32x4){0u, 0u, 0u, 0u};
        auto fetch = [&](int n) {
            const size_t row0 = (size_t)b * SEQ + (size_t)n * 64;
#pragma unroll
            for (int i = 0; i < 2; ++i) { const int idx = tid + i * NTHR, r = idx >> 4, c = idx & 15;
                pq[i] = *(const u32x4*)(Qg + (row0 + r) * 512 + h * 128 + c * 8); pk[i] = *(const u32x4*)(KD + (row0 + r) * 512 + h * 128 + c * 8); }
            if (tid < 256) { const int r = tid >> 2, c = tid & 3; pv = *(const u32x4*)(V + (row0 + r) * D + h * 256 + vs * 32 + c * 8); }
            if (tid < 128) pe = etot[((size_t)b * 64 + n) * 512 + h * 128 + tid];
        };
        fetch(0);
        for (int n = 0; n < 64; ++n) {
#pragma unroll
            for (int i = 0; i < 2; ++i) { const int idx = tid + i * NTHR, r = idx >> 4, c = idx & 15; *(LAS u32x4*)(Qs + r * QP + c * 16) = pq[i]; *(LAS u32x4*)(Ks + r * QP + c * 16) = pk[i]; }
            if (tid < 256) { const int r = tid >> 2, c = tid & 3; *(LAS u32x4*)(Vs + r * 64 + c * 16) = pv; }
            if (tid < 128) Et[tid] = pe;
            __syncthreads();
            if (n + 1 < 64) fetch(n + 1);
#pragma unroll
            for (int i = 0; i < 8; ++i) S[i] *= Et[kg * 8 + i];
#pragma unroll 4
            for (int c = 0; c < 64; ++c) { const u32x4 kw = *(const LAS u32x4*)(Ks + c * QP + kg * 16); const float vv = __uint_as_float((unsigned)(*(const LAS unsigned short*)(Vs + c * 64 + v * 2)) << 16);
                S[0] += bf_lo(kw.x) * vv; S[1] += bf_hi(kw.x) * vv; S[2] += bf_lo(kw.y) * vv; S[3] += bf_hi(kw.y) * vv; S[4] += bf_lo(kw.z) * vv; S[5] += bf_hi(kw.z) * vv; S[6] += bf_lo(kw.w) * vv; S[7] += bf_hi(kw.w) * vv; }
#pragma unroll
            for (int i = 0; i < 8; ++i) Sl[(kg * 8 + i) * 32 + v] = S[i];
            __syncthreads();
            f32x4 o = (f32x4){0.f, 0.f, 0.f, 0.f};
#pragma unroll 2
            for (int k8 = 0; k8 < 16; ++k8) { const u32x4 qw = *(const LAS u32x4*)(Qs + oc * QP + k8 * 16);
                const float qf[8] = {bf_lo(qw.x), bf_hi(qw.x), bf_lo(qw.y), bf_hi(qw.y), bf_lo(qw.z), bf_hi(qw.z), bf_lo(qw.w), bf_hi(qw.w)};
#pragma unroll
                for (int i = 0; i < 8; ++i) o = o + qf[i] * *(const LAS f32x4*)(Sl + (k8 * 8 + i) * 32 + ov * 4); }
            u32x2 w; w.x = pk2(o[0], o[1]); w.y = pk2(o[2], o[3]);
            *(u32x2*)(O + ((size_t)b * SEQ + (size_t)n * 64 + oc) * D + h * 256 + vs * 32 + ov * 4) = w;
            __syncthreads();
        }
    }
}


namespace gscan {
typedef short v4i16_t __attribute__((ext_vector_type(4)));
__device__ __forceinline__ unsigned off_b(unsigned row, unsigned ch) { return 256u * row + 16u * (ch ^ (((row & 3u) << 2) | ((row >> 2) & 3u))); }
__device__ __forceinline__ unsigned off_v(unsigned row, unsigned half) { return 64u * row + 32u * (half ^ ((row >> 3) & 1u)); }
constexpr int IMG_Q = 0, IMG_K = 16384, IMG_V = 32768, IMG_E = 36864, BUFB = 37376, ST_OFF = 2 * BUFB;
__device__ __forceinline__ bf16x8 tr8(const LAS unsigned char* p0, const LAS unsigned char* p1) {
    const v4i16_t lo = __builtin_amdgcn_ds_read_tr16_b64_v4i16((LAS v4i16_t*)p0), hi = __builtin_amdgcn_ds_read_tr16_b64_v4i16((LAS v4i16_t*)p1);
    return (bf16x8){lo[0], lo[1], lo[2], lo[3], hi[0], hi[1], hi[2], hi[3]};
}
#define GS_BAR() do { asm volatile("s_waitcnt lgkmcnt(0)" ::: "memory"); __builtin_amdgcn_s_barrier(); asm volatile("" ::: "memory"); } while (0)
struct Pre { u32x4 q[2], k[2], v; float e; };
__device__ __forceinline__ void gload(Pre& r, const bf16_t* Qg, const bf16_t* KD, const bf16_t* V, const float* etot, int b, int h, int vs, int n, int tid) {
    const size_t row0 = (size_t)b * SEQ + (size_t)n * 64;
#pragma unroll
    for (int i = 0; i < 2; ++i) { const int idx = tid + i * NTHR, rr = idx >> 4, c = idx & 15;
        r.q[i] = *(const u32x4*)(Qg + (row0 + rr) * 512 + h * 128 + c * 8); r.k[i] = *(const u32x4*)(KD + (row0 + rr) * 512 + h * 128 + c * 8); }
    if (tid < 256) { const int rr = tid >> 2, c = tid & 3; r.v = *(const u32x4*)(V + (row0 + rr) * D + h * 256 + vs * 32 + c * 8); }
    if (tid < 128) r.e = etot[((size_t)b * 64 + n) * 512 + h * 128 + tid];
}
__device__ __forceinline__ void lwrite(const Pre& r, LAS unsigned char* buf, int tid) {
#pragma unroll
    for (int i = 0; i < 2; ++i) { const int idx = tid + i * NTHR, rr = idx >> 4, c = idx & 15; *(LAS u32x4*)(buf + IMG_Q + off_b(rr, c)) = r.q[i]; *(LAS u32x4*)(buf + IMG_K + off_b(rr, c)) = r.k[i]; }
    if (tid < 256) { const int rr = tid >> 2, c = tid & 3; *(LAS u32x4*)(buf + IMG_V + off_v(rr, c >> 1) + 16 * (c & 1)) = r.v; }
    if (tid < 128) *(LAS float*)(buf + IMG_E + 4 * tid) = r.e;
}
__device__ __forceinline__ void chunk(LAS unsigned char* lds, LAS unsigned char* buf, f32x4& S0, f32x4& S1, bf16_t* Orow0, int w, int lane) {
    const int g = lane >> 4, l15 = lane & 15, q = l15 >> 2, p = lane & 3;
    LAS unsigned char* ST = lds + ST_OFF;
    { const f32x4 et = *(const LAS f32x4*)(buf + IMG_E + 4 * (16 * w + 4 * g));
        S0 = S0 * et; S1 = S1 * et;
#pragma unroll
        for (int ks = 0; ks < 2; ++ks) {
            const unsigned r0 = 32 * ks + 8 * g + q, r1 = r0 + 4;
            const bf16x8 a = tr8(buf + IMG_K + off_b(r0, 2 * w + (p >> 1)) + 8 * (p & 1), buf + IMG_K + off_b(r1, 2 * w + (p >> 1)) + 8 * (p & 1));
            const bf16x8 b0 = tr8(buf + IMG_V + off_v(r0, 0) + 8 * p, buf + IMG_V + off_v(r1, 0) + 8 * p);
            const bf16x8 b1 = tr8(buf + IMG_V + off_v(r0, 1) + 8 * p, buf + IMG_V + off_v(r1, 1) + 8 * p);
            S0 = __builtin_amdgcn_mfma_f32_16x16x32_bf16(a, b0, S0, 0, 0, 0);
            S1 = __builtin_amdgcn_mfma_f32_16x16x32_bf16(a, b1, S1, 0, 0, 0);
        }
        u32x2 w0, w1; w0.x = pk2(S0[0], S0[1]); w0.y = pk2(S0[2], S0[3]); w1.x = pk2(S1[0], S1[1]); w1.y = pk2(S1[2], S1[3]);
        *(LAS u32x2*)(ST + off_b(l15, 2 * w + (g >> 1)) + 8 * (g & 1)) = w0;
        *(LAS u32x2*)(ST + off_b(16 + l15, 2 * w + (g >> 1)) + 8 * (g & 1)) = w1; }
    GS_BAR();
    { const int vt = w & 1, ct = w >> 1; f32x4 o = (f32x4){0.f, 0.f, 0.f, 0.f};
#pragma unroll
        for (int sK = 0; sK < 4; ++sK) {
            const bf16x8 a = *(const LAS bf16x8*)(ST + off_b(16 * vt + l15, 4 * sK + g));
            const bf16x8 bq = *(const LAS bf16x8*)(buf + IMG_Q + off_b(16 * ct + l15, 4 * sK + g));
            o = __builtin_amdgcn_mfma_f32_16x16x32_bf16(a, bq, o, 0, 0, 0);
        }
        u32x2 wo; wo.x = pk2(o[0], o[1]); wo.y = pk2(o[2], o[3]);
        *(u32x2*)(Orow0 + (size_t)(16 * ct + l15) * D + 16 * vt + 4 * g) = wo; }
    GS_BAR();
}
}
__device__ __forceinline__ void gla_scan_mfma(LAS unsigned char* lds, const bf16_t* Qg, const bf16_t* KD, const bf16_t* V, const float* etot, bf16_t* O, int vcu, int G) {
    using namespace gscan;
    const int tid = opaque_tid(), lane = tid & 63, w = __builtin_amdgcn_readfirstlane(tid >> 6);
    for (int u = vcu; u < NB * 4 * 8; u += G) {
        const int b = u >> 5, h = (u >> 3) & 3, vs = u & 7;
        f32x4 S0 = (f32x4){0.f, 0.f, 0.f, 0.f}, S1 = (f32x4){0.f, 0.f, 0.f, 0.f};
        Pre pa, pb; pa.v = (u32x4){0u, 0u, 0u, 0u}; pb.v = pa.v; pa.e = 0.f; pb.e = 0.f;
        gload(pa, Qg, KD, V, etot, b, h, vs, 0, tid); gload(pb, Qg, KD, V, etot, b, h, vs, 1, tid);
        lwrite(pa, lds, tid); lwrite(pb, lds + BUFB, tid);
        gload(pa, Qg, KD, V, etot, b, h, vs, 2, tid); gload(pb, Qg, KD, V, etot, b, h, vs, 3, tid);
        GS_BAR();
        bf16_t* Ob = O + ((size_t)b * SEQ) * D + h * 256 + vs * 32;
        for (int n = 0; n < 64; n += 2) {
            chunk(lds, lds, S0, S1, Ob + (size_t)n * 64 * D, w, lane);
            if (n + 2 < 64) { lwrite(pa, lds, tid); if (n + 4 < 64) gload(pa, Qg, KD, V, etot, b, h, vs, n + 4, tid); }
            chunk(lds, lds + BUFB, S0, S1, Ob + (size_t)(n + 1) * 64 * D, w, lane);
            if (n + 3 < 64) { lwrite(pb, lds + BUFB, tid); if (n + 5 < 64) gload(pb, Qg, KD, V, etot, b, h, vs, n + 5, tid); }
        }
        GS_BAR();
    }
}

__device__ __forceinline__ void gla_gn_phase(const bf16_t* O, const bf16_t* R, const float* gn, bf16_t* A2, int vcu, int G) {
    const int tid = opaque_tid(), lane = tid & 63, wave = tid >> 6;
    f32x4 g[4];
#pragma unroll
    for (int j = 0; j < 4; ++j) g[j] = *(const f32x4*)(gn + 16 * lane + 4 * j);
    for (int row = vcu * NWAVES + wave; row < NTOK; row += G * NWAVES) {
        const u32x4 o0 = *(const u32x4*)(O + (size_t)row * D + 16 * lane), o1 = *(const u32x4*)(O + (size_t)row * D + 16 * lane + 8);
        const u32x4 r0 = *(const u32x4*)(R + (size_t)row * D + 16 * lane), r1 = *(const u32x4*)(R + (size_t)row * D + 16 * lane + 8);
        float ov[16], rv[16];
        const unsigned ow[8] = {o0.x, o0.y, o0.z, o0.w, o1.x, o1.y, o1.z, o1.w}, rw[8] = {r0.x, r0.y, r0.z, r0.w, r1.x, r1.y, r1.z, r1.w};
        float ss = 0.f;
#pragma unroll
        for (int i = 0; i < 8; ++i) { ov[2 * i] = bf_lo(ow[i]); ov[2 * i + 1] = bf_hi(ow[i]); rv[2 * i] = bf_lo(rw[i]); rv[2 * i + 1] = bf_hi(rw[i]); ss += ov[2 * i] * ov[2 * i] + ov[2 * i + 1] * ov[2 * i + 1]; }
        ss += __shfl_xor(ss, 1); ss += __shfl_xor(ss, 2); ss += __shfl_xor(ss, 4); ss += __shfl_xor(ss, 8);
        const float rs = __builtin_amdgcn_rsqf(ss * (1.0f / 256.0f) + EPS);
        u32x4 w0, w1;
        w0.x = pk2(ov[0] * rs * g[0][0] * rv[0], ov[1] * rs * g[0][1] * rv[1]); w0.y = pk2(ov[2] * rs * g[0][2] * rv[2], ov[3] * rs * g[0][3] * rv[3]);
        w0.z = pk2(ov[4] * rs * g[1][0] * rv[4], ov[5] * rs * g[1][1] * rv[5]); w0.w = pk2(ov[6] * rs * g[1][2] * rv[6], ov[7] * rs * g[1][3] * rv[7]);
        w1.x = pk2(ov[8] * rs * g[2][0] * rv[8], ov[9] * rs * g[2][1] * rv[9]); w1.y = pk2(ov[10] * rs * g[2][2] * rv[10], ov[11] * rs * g[2][3] * rv[11]);
        w1.z = pk2(ov[12] * rs * g[3][0] * rv[12], ov[13] * rs * g[3][1] * rv[13]); w1.w = pk2(ov[14] * rs * g[3][2] * rv[14], ov[15] * rs * g[3][3] * rv[15]);
        *(u32x4*)(A2 + (size_t)row * D + 16 * lane) = w0; *(u32x4*)(A2 + (size_t)row * D + 16 * lane + 8) = w1;
    }
}

template <int J> __device__ __forceinline__ void conv_step(f32x2 (&ac)[16], const f32x2 (&wv2)[CONVW], unsigned packed) {
    const f32x2 uu = (f32x2){bf_lo(packed), bf_hi(packed)};
#pragma unroll
    for (int ro = 0; ro < 16; ++ro) { constexpr int dummy = 0; (void)dummy; const int w = J - ro; if (w >= 0 && w <= 30) ac[ro] = ac[ro] + wv2[w] * uu; }
}
__device__ __forceinline__ void conv_phase(LAS unsigned char* lds, const bf16_t* U, const float* dw, const float* dwb, const float* lng, const float* lnb, bf16_t* A2, int vcu, int G) {
    const int tid = opaque_tid(), lane = tid & 63, wave = __builtin_amdgcn_readfirstlane(tid >> 6);
    LAS float* PART = (LAS float*)lds;
    LAS float* STAT = PART + 512;
    f32x2 wv2[CONVW];
#pragma unroll
    for (int w = 0; w < CONVW; ++w) wv2[w] = *(const f32x2*)(dw + w * D + 2 * tid);
    const f32x2 bia = *(const f32x2*)(dwb + 2 * tid), gam = *(const f32x2*)(lng + 2 * tid), bet = *(const f32x2*)(lnb + 2 * tid);
    for (int u = vcu; u < NB * (SEQ / 128); u += G) {
        const int b = u / (SEQ / 128), t0 = (u % (SEQ / 128)) * 128;
        const bf16_t* ub = U + ((size_t)b * SEQ) * D + 2 * tid;
        unsigned inp[46], nx[16];
#pragma unroll
        for (int j = 0; j < 30; ++j) { const int sfr = t0 - 30 + j; inp[j] = (sfr >= 0) ? *(const unsigned*)(ub + (size_t)sfr * D) : 0u; }
#pragma unroll
        for (int j = 0; j < 16; ++j) nx[j] = *(const unsigned*)(ub + (size_t)(t0 + j) * D);
#pragma unroll 1
        for (int og = 0; og < 8; ++og) {
#pragma unroll
            for (int j = 0; j < 16; ++j) inp[30 + j] = nx[j];
            if (og < 7) {
#pragma unroll
                for (int j = 0; j < 16; ++j) nx[j] = *(const unsigned*)(ub + (size_t)(t0 + 16 * (og + 1) + j) * D); }
            f32x2 ac[16];
#pragma unroll
            for (int r = 0; r < 16; ++r) ac[r] = bia;
#define CS(J) conv_step<J>(ac, wv2, inp[J]);
            CS(0) CS(1) CS(2) CS(3) CS(4) CS(5) CS(6) CS(7) CS(8) CS(9) CS(10) CS(11) CS(12) CS(13) CS(14) CS(15) CS(16) CS(17) CS(18) CS(19) CS(20) CS(21) CS(22) CS(23) CS(24) CS(25) CS(26) CS(27) CS(28) CS(29) CS(30) CS(31) CS(32) CS(33) CS(34) CS(35) CS(36) CS(37) CS(38) CS(39) CS(40) CS(41) CS(42) CS(43) CS(44) CS(45)
#undef CS
#pragma unroll
            for (int j = 0; j < 30; ++j) inp[j] = inp[j + 16];
            float a0[16], a1[16];
#pragma unroll
            for (int r = 0; r < 16; ++r) { a0[r] = ac[r][0]; a1[r] = ac[r][1]; }
            { float st[16];
#pragma unroll
                for (int r = 0; r < 16; ++r) st[r] = a0[r] + a1[r];
                xreduce<16>(st, lane);
                if ((lane & 3) == 0) PART[wave * 32 + (lane >> 2)] = st[0];
#pragma unroll
                for (int r = 0; r < 16; ++r) st[r] = a0[r] * a0[r] + a1[r] * a1[r];
                xreduce<16>(st, lane);
                if ((lane & 3) == 0) PART[wave * 32 + 16 + (lane >> 2)] = st[0]; }
            __syncthreads();
            if (tid < 16) { float s1 = 0.f, s2 = 0.f;
#pragma unroll
                for (int w8 = 0; w8 < 8; ++w8) { s1 += PART[w8 * 32 + tid]; s2 += PART[w8 * 32 + 16 + tid]; }
                const float mean = s1 * (1.0f / D); const float var = fmaxf(s2 * (1.0f / D) - mean * mean, 0.f);
                STAT[2 * tid] = mean; STAT[2 * tid + 1] = __builtin_amdgcn_rsqf(var + EPS); }
            __syncthreads();
#pragma unroll
            for (int r = 0; r < 16; ++r) { const float mean = STAT[2 * r], rs = STAT[2 * r + 1];
                const float y0 = (a0[r] - mean) * rs * gam[0] + bet[0], y1 = (a1[r] - mean) * rs * gam[1] + bet[1];
                *(unsigned*)(A2 + ((size_t)b * SEQ + t0 + 16 * og + r) * D + 2 * tid) = pk2(fast_silu(y0), fast_silu(y1)); }
            __syncthreads();
        }
    }
}

__device__ __forceinline__ void fox_attn_naive(LAS unsigned char* lds, const bf16_t* Q, const bf16_t* Kb, const bf16_t* V, const bf16_t* OG, const float* lf, bf16_t* A2, int vcu, int G) {
    const int tid = opaque_tid(), ql = tid >> 1, hf = tid & 1;
    LAS float* CUM = (LAS float*)lds;
    LAS float* Ks = (LAS float*)(lds + 16384);
    LAS float* Vs = (LAS float*)(lds + 32768);
    LAS float* SCN = (LAS float*)(lds + 49152);
    for (int pu = vcu; pu < NB * 16 * 8; pu += G) {
        const int bh = pu >> 3, b = bh >> 4, h = bh & 15, pr = pu & 7;
        { float loc[8]; float s = 0.f;
#pragma unroll
            for (int i = 0; i < 8; ++i) { s += lf[((size_t)b * SEQ + 8 * tid + i) * 16 + h]; loc[i] = s; }
            __syncthreads();
            SCN[tid] = s; __syncthreads();
            for (int off = 1; off < NTHR; off <<= 1) { const float t = (tid >= off) ? SCN[tid - off] : 0.f; __syncthreads(); SCN[tid] += t; __syncthreads(); }
            const float base = (tid > 0) ? SCN[tid - 1] : 0.f;
#pragma unroll
            for (int i = 0; i < 8; ++i) CUM[8 * tid + i] = (base + loc[i]) * LOG2E;
            __syncthreads(); }
        for (int half = 0; half < 2; ++half) {
            const int qt = half ? 15 - pr : pr; const int qi = qt * 256 + ql; const size_t qrow = (size_t)b * SEQ + qi;
            float q[32], o[32];
#pragma unroll
            for (int c = 0; c < 4; ++c) { const u32x4 w = *(const u32x4*)(Q + qrow * D + h * 64 + hf * 32 + c * 8);
                q[8 * c] = bf_lo(w.x); q[8 * c + 1] = bf_hi(w.x); q[8 * c + 2] = bf_lo(w.y); q[8 * c + 3] = bf_hi(w.y); q[8 * c + 4] = bf_lo(w.z); q[8 * c + 5] = bf_hi(w.z); q[8 * c + 6] = bf_lo(w.w); q[8 * c + 7] = bf_hi(w.w); }
#pragma unroll
            for (int d = 0; d < 32; ++d) o[d] = 0.f;
            float mx = -3.0e38f, l = 0.f; const float cq = CUM[qi];
            const int ntile = (qt * 256 + 256) / 64;
            for (int kt = 0; kt < ntile; ++kt) {
                __syncthreads();
                { const int r = tid >> 3, c = tid & 7; const size_t krow = (size_t)b * SEQ + kt * 64 + r;
                    const u32x4 kw = *(const u32x4*)(Kb + krow * D + h * 64 + c * 8), vw = *(const u32x4*)(V + krow * D + h * 64 + c * 8);
                    *(LAS f32x4*)(Ks + r * 64 + c * 8) = (f32x4){bf_lo(kw.x), bf_hi(kw.x), bf_lo(kw.y), bf_hi(kw.y)}; *(LAS f32x4*)(Ks + r * 64 + c * 8 + 4) = (f32x4){bf_lo(kw.z), bf_hi(kw.z), bf_lo(kw.w), bf_hi(kw.w)};
                    *(LAS f32x4*)(Vs + r * 64 + c * 8) = (f32x4){bf_lo(vw.x), bf_hi(vw.x), bf_lo(vw.y), bf_hi(vw.y)}; *(LAS f32x4*)(Vs + r * 64 + c * 8 + 4) = (f32x4){bf_lo(vw.z), bf_hi(vw.z), bf_lo(vw.w), bf_hi(vw.w)}; }
                __syncthreads();
#pragma unroll 1
                for (int j = 0; j < 64; ++j) {
                    const int kj = kt * 64 + j;
                    float acc = 0.f;
#pragma unroll
                    for (int d4 = 0; d4 < 8; ++d4) { const f32x4 kv = *(const LAS f32x4*)(Ks + j * 64 + hf * 32 + d4 * 4); acc += q[4 * d4] * kv[0] + q[4 * d4 + 1] * kv[1] + q[4 * d4 + 2] * kv[2] + q[4 * d4 + 3] * kv[3]; }
                    acc += __shfl_xor(acc, 1);
                    acc += cq - CUM[kj];
                    if (kj <= qi) {
                        const float mn = fmaxf(mx, acc), sc = __builtin_amdgcn_exp2f(mx - mn), p = __builtin_amdgcn_exp2f(acc - mn); mx = mn; l = l * sc + p;
#pragma unroll
                        for (int d4 = 0; d4 < 8; ++d4) { const f32x4 vv = *(const LAS f32x4*)(Vs + j * 64 + hf * 32 + d4 * 4);
                            o[4 * d4] = o[4 * d4] * sc + p * vv[0]; o[4 * d4 + 1] = o[4 * d4 + 1] * sc + p * vv[1]; o[4 * d4 + 2] = o[4 * d4 + 2] * sc + p * vv[2]; o[4 * d4 + 3] = o[4 * d4 + 3] * sc + p * vv[3]; }
                    }
                }
            }
            const float il = 1.0f / l;
#pragma unroll
            for (int c = 0; c < 4; ++c) { const u32x4 gw = *(const u32x4*)(OG + qrow * D + h * 64 + hf * 32 + c * 8); u32x4 w;
                w.x = pk2(o[8 * c] * il * bf_lo(gw.x), o[8 * c + 1] * il * bf_hi(gw.x)); w.y = pk2(o[8 * c + 2] * il * bf_lo(gw.y), o[8 * c + 3] * il * bf_hi(gw.y));
                w.z = pk2(o[8 * c + 4] * il * bf_lo(gw.z), o[8 * c + 5] * il * bf_hi(gw.z)); w.w = pk2(o[8 * c + 6] * il * bf_lo(gw.w), o[8 * c + 7] * il * bf_hi(gw.w));
                *(u32x4*)(A2 + qrow * D + h * 64 + hf * 32 + c * 8) = w; }
        }
        __syncthreads();
    }
}

#include <hip/hip_bf16.h>
namespace attn_body {
using bf16=__hip_bfloat16;
using bf16x8=__attribute__((ext_vector_type(8)))short;
using s16x4=__attribute__((ext_vector_type(4)))short;
using f32x16=__attribute__((ext_vector_type(16)))float;
using u32x4=__attribute__((ext_vector_type(4)))unsigned;
constexpr int BATCH=8,NHEAD=16,SEQ=4096,D=64,DM=NHEAD*D;
constexpr int NW=8,QBLK=32,QB=QBLK*NW,KVBLK=64,NQB=SEQ/QB;
constexpr int ATTN_PITCH=DM, ATTN_UNIT_ROWS=QB;
__device__ __forceinline__ int crow(int r,int hi){return (r&3)+8*(r>>2)+4*hi;}
#define SBAR() __builtin_amdgcn_sched_barrier(0)
__device__ __forceinline__ void cmask(f32x16&p0,f32x16&p1,int jb,int qrel,int hi){
  const float NEG=-INFINITY; int kb=64*jb+4*hi;
  #pragma unroll
  for(int r=0;r<16;++r){int kv=kb+(r&3)+8*(r>>2); if(kv>qrel)p0[r]=NEG; if(kv+32>qrel)p1[r]=NEG;}
}

constexpr int NSLOT=3, SLOTB=8192;
constexpr int LDS_K=0, LDS_V=NSLOT*SLOTB, LDS_WS=2*NSLOT*SLOTB, LDS_OST=LDS_WS+NW*64*4, LDS_CUM=LDS_OST+NW*4096, LDS_BYTES=LDS_CUM+SEQ*4;
constexpr float C2=0.125f*1.4426950408889634f;
__device__ __forceinline__ void glds16(const void*gsrc,unsigned lds_dst){unsigned keep;
  asm volatile("s_mov_b32 %0, m0\n\ts_mov_b32 m0, %2\n\ts_nop 0\n\tglobal_load_lds_dwordx4 %1, off\n\ts_mov_b32 m0, %0":"=&s"(keep):"v"(gsrc),"s"(lds_dst):"memory");}
__device__ __forceinline__ float max3f(float a,float b,float c){float r;asm("v_max3_f32 %0, %1, %2, %3":"=v"(r):"v"(a),"v"(b),"v"(c));return r;}
__device__ __forceinline__ float max2f(float a,float b){float r;asm("v_max_f32_e32 %0, %1, %2":"=v"(r):"v"(a),"v"(b));return r;}
__device__ __forceinline__ float fadd_s(float a,float b){float r;asm("v_add_f32_e32 %0, %1, %2":"=v"(r):"v"(a),"v"(b));return r;}
__device__ __forceinline__ float fsub_s(float a,float b){float r;asm("v_sub_f32_e32 %0, %1, %2":"=v"(r):"v"(a),"v"(b));return r;}
typedef float f32x2_t __attribute__((ext_vector_type(2))); typedef float f32x4_t __attribute__((ext_vector_type(4))); typedef __bf16 bf16x2_t __attribute__((ext_vector_type(2)));
__device__ __forceinline__ unsigned cvtpk_s(float lo,float hi){f32x2_t v={lo,hi};bf16x2_t b=__builtin_convertvector(v,bf16x2_t);return __builtin_bit_cast(unsigned,b);}
#define WAIT_BAR(N) asm volatile("s_waitcnt vmcnt(" #N ") lgkmcnt(0)\n\ts_barrier":::"memory")

__device__ __forceinline__ void qkt(f32x16&p0,f32x16&p1,const char*Kslot,const bf16x8*qr,const f32x16&negm,int r32,int hi){
  const char*kb=Kslot+hi*1024+r32*16;
  #pragma unroll
  for(int d0=0;d0<4;++d0){
    const bf16x8 b0=*reinterpret_cast<const bf16x8*>(kb+d0*2048);
    const bf16x8 b1=*reinterpret_cast<const bf16x8*>(kb+d0*2048+512);
    if(d0==0){p0=__builtin_amdgcn_mfma_f32_32x32x16_bf16(b0,qr[0],negm,0,0,0);p1=__builtin_amdgcn_mfma_f32_32x32x16_bf16(b1,qr[0],negm,0,0,0);}
    else{p0=__builtin_amdgcn_mfma_f32_32x32x16_bf16(b0,qr[d0],p0,0,0,0);p1=__builtin_amdgcn_mfma_f32_32x32x16_bf16(b1,qr[d0],p1,0,0,0);}}
}
typedef __attribute__((address_space(3))) const char* lds_cptr;
typedef short v4i16_t __attribute__((ext_vector_type(4)));
__device__ __forceinline__ void kload8(bf16x8*kf,lds_cptr kp){
  kf[0]=*(const __attribute__((address_space(3))) bf16x8*)(kp);      kf[1]=*(const __attribute__((address_space(3))) bf16x8*)(kp+512);
  kf[2]=*(const __attribute__((address_space(3))) bf16x8*)(kp+2048); kf[3]=*(const __attribute__((address_space(3))) bf16x8*)(kp+2560);
  kf[4]=*(const __attribute__((address_space(3))) bf16x8*)(kp+4096); kf[5]=*(const __attribute__((address_space(3))) bf16x8*)(kp+4608);
  kf[6]=*(const __attribute__((address_space(3))) bf16x8*)(kp+6144); kf[7]=*(const __attribute__((address_space(3))) bf16x8*)(kp+6656);
}
__device__ __forceinline__ void kload2(bf16x8*kf,lds_cptr kp,int j){ kf[2*j]=*(const __attribute__((address_space(3))) bf16x8*)(kp+j*2048); kf[2*j+1]=*(const __attribute__((address_space(3))) bf16x8*)(kp+j*2048+512); }
__device__ __forceinline__ s16x4 vtr(lds_cptr p){ return __builtin_bit_cast(s16x4,__builtin_amdgcn_ds_read_tr16_b64_v4i16((__attribute__((address_space(3))) v4i16_t*)p)); }
__device__ __forceinline__ float rowmax(const f32x16&p0,const f32x16&p1){
  float a=max3f(p0[0],p0[1],p1[0]),b=max3f(p0[2],p0[3],p1[1]);a=max3f(a,p1[2],p1[3]);
  #pragma unroll
  for(int r=4;r<16;r+=4){a=max3f(a,p0[r],p0[r+1]);b=max3f(b,p0[r+2],p0[r+3]);a=max3f(a,p1[r],p1[r+1]);b=max3f(b,p1[r+2],p1[r+3]);}
  const float m=max2f(a,b);
  auto rr=__builtin_amdgcn_permlane32_swap(__float_as_uint(m),__float_as_uint(m),false,false);
  return max2f(__uint_as_float(rr[0]),__uint_as_float(rr[1]));
}
__device__ __forceinline__ void pv(f32x16*o,int vb,bf16x8 pa0,bf16x8 pa1,bf16x8 pa2,bf16x8 pa3){
  #pragma unroll
  for(int d0=0;d0<2;++d0){s16x4 lo[4],hi[4];
    #pragma unroll
    for(int ks=0;ks<4;++ks){
      asm volatile("ds_read_b64_tr_b16 %0,%1 offset:%c2":"=&v"(lo[ks]):"v"(vb),"i"(d0*4096+ks*1024):"memory");
      asm volatile("ds_read_b64_tr_b16 %0,%1 offset:%c2":"=&v"(hi[ks]):"v"(vb),"i"(d0*4096+ks*1024+512):"memory");}
    asm volatile("s_waitcnt lgkmcnt(0)":::"memory");SBAR();
    #define PK(k) (bf16x8){lo[k][0],lo[k][1],lo[k][2],lo[k][3],hi[k][0],hi[k][1],hi[k][2],hi[k][3]}
    o[d0]=__builtin_amdgcn_mfma_f32_32x32x16_bf16(pa0,PK(0),o[d0],0,0,0);
    o[d0]=__builtin_amdgcn_mfma_f32_32x32x16_bf16(pa1,PK(1),o[d0],0,0,0);
    o[d0]=__builtin_amdgcn_mfma_f32_32x32x16_bf16(pa2,PK(2),o[d0],0,0,0);
    o[d0]=__builtin_amdgcn_mfma_f32_32x32x16_bf16(pa3,PK(3),o[d0],0,0,0);
    #undef PK
  }
}

#ifndef ATTN_STORE16
#define ATTN_STORE16(p,v) (*(u32x4*)(p)=(v))
#endif
constexpr float MFLOOR=-24.0f;
template<int THRL> __device__ __forceinline__ void attn_unit(int b,int h,int qb,int ts,const bf16*Q,const bf16*__restrict__ K,const bf16*__restrict__ V,const bf16*__restrict__ OG,bf16*O,char*shm){
  int tid=threadIdx.x; asm volatile("":"+v"(tid));
  const int lane=tid&63,r32=lane&31,hi=lane>>5; const int wid=__builtin_amdgcn_readfirstlane(tid>>6);
  const long rowbase=(long)b*SEQ; const int q0=qb*QB;
  const bf16*Qw=Q+(rowbase+q0+wid*QBLK)*DM+h*D;
  const bf16*Kh=K+(rowbase+(long)ts*KVBLK)*DM+h*D,*Vh=V+(rowbase+(long)ts*KVBLK)*DM+h*D;
  const lds_cptr shm3=(lds_cptr)shm;
  const unsigned lds0=(unsigned)(uintptr_t)shm;
  float*wsf=(float*)(shm+LDS_WS)+wid*64;
  const bf16*ksrc=Kh+(long)lane*DM+wid*8;
  const bf16*vsrc=Vh+(long)(16*(wid&3)+(lane>>2))*DM+(wid>>2)*32+(lane&3)*8;
  const unsigned kdst=lds0+LDS_K+wid*1024, vdst=lds0+LDS_V+wid*1024;
  #define DMA_K(t,slot) glds16(ksrc+(long)(t)*KVBLK*DM,(unsigned)__builtin_amdgcn_readfirstlane(kdst+(slot)))
  #define DMA_V(t,slot) glds16(vsrc+(long)(t)*KVBLK*DM,(unsigned)__builtin_amdgcn_readfirstlane(vdst+(slot)))
  const int vb0=(int)(lds0+LDS_V)+((lane>>4)&1)*32+(lane&3)*8+(4*hi+((lane&15)>>2))*64;
  const char*Kbase=shm+LDS_K; bf16x8 kf[8];
  const lds_cptr kp0=shm3+LDS_K+hi*1024+r32*16; const lds_cptr vp0=shm3+LDS_V+((lane>>4)&1)*32+(lane&3)*8+(4*hi+((lane&15)>>2))*64;
  const int NT=(q0+QB)/KVBLK-ts;
  DMA_K(0,0);DMA_V(0,0);DMA_K(1,SLOTB);
  bf16x8 qr[4];
  #pragma unroll
  for(int d0=0;d0<4;++d0)qr[d0]=*reinterpret_cast<const bf16x8*>(&Qw[(long)r32*DM+d0*16+hi*8]);
  const int qrel=wid*QBLK+r32;
  const __attribute__((address_space(3))) float* cum3=(const __attribute__((address_space(3))) float*)(shm3+LDS_CUM);
  const float cqv=cum3[q0+qrel];
  float mhat=0.f,l_reg=0.f;f32x16 o[2];o[0]=f32x16{};o[1]=f32x16{};f32x16 negm;
  _Pragma("unroll") for(int r=0;r<16;++r)negm[r]=cqv; asm volatile("":"+v"(negm));
  #define FBIAS(P0,P1,t) do{ const __attribute__((address_space(3))) float* cp_=cum3+((t)+ts)*KVBLK+4*hi; \
    _Pragma("unroll") for(int g_=0;g_<4;++g_){ const f32x4_t a_=*(const __attribute__((address_space(3))) f32x4_t*)(cp_+8*g_), b_=*(const __attribute__((address_space(3))) f32x4_t*)(cp_+32+8*g_); \
      P0[4*g_]-=a_[0];P0[4*g_+1]-=a_[1];P0[4*g_+2]-=a_[2];P0[4*g_+3]-=a_[3]; P1[4*g_]-=b_[0];P1[4*g_+1]-=b_[1];P1[4*g_+2]-=b_[2];P1[4*g_+3]-=b_[3]; } }while(0)
  #define CMASK(P0,P1,t) do{int jb_=(t)-(NT-4); if(jb_>=0)cmask(P0,P1,jb_,qrel,hi);}while(0)
  bool resc=false;
  #define START(P0,P1) do{ const float rm=rowmax(P0,P1); resc=false; \
    { const float dl=max2f(rm,MFLOOR); mhat=fadd_s(mhat,dl); \
      _Pragma("unroll") for(int r=0;r<16;++r){P0[r]=fsub_s(P0[r],dl);P1[r]=fsub_s(P1[r],dl);} \
      _Pragma("unroll") for(int r=0;r<16;++r)negm[r]=cqv-mhat; asm volatile("":"+v"(negm)); } \
    _Pragma("unroll") for(int r=0;r<16;++r)P0[r]=__builtin_amdgcn_exp2f(P0[r]); }while(0)
  #define RESC() do{ if(resc){ asm volatile("s_waitcnt lgkmcnt(0)":::"memory"); \
      _Pragma("unroll") for(int d_=0;d_<2;++d_) _Pragma("unroll") for(int r=0;r<16;++r)o[d_][r]*=wsf[crow(r,hi)]; } }while(0)
  f32x16 pA0,pA1,pB0,pB1;
  int sl_prev=0,sl_cur=0,sl_next=SLOTB;
  #define ROT() do{sl_prev=sl_cur;sl_cur=sl_next;sl_next=(sl_next==(NSLOT-1)*SLOTB)?0:sl_next+SLOTB;}while(0)
  DMA_K(2,2*SLOTB);
  WAIT_BAR(3);
  qkt(pA0,pA1,Kbase,qr,negm,r32,hi);asm volatile("s_nop 15\n\ts_nop 7":"+v"(pA0),"+v"(pA1));FBIAS(pA0,pA1,0);CMASK(pA0,pA1,0);
  START(pA0,pA1);
  _Pragma("unroll") for(int r=0;r<16;++r)pA1[r]=__builtin_amdgcn_exp2f(pA1[r]);
  WAIT_BAR(0);
  DMA_K(3,0);DMA_V(1,SLOTB);
  ROT();
  kload8(kf,kp0+sl_cur);
  WAIT_BAR(2);
  s16x4 vlo[8],vhi[8]; u32x4 pw0,pw1,pw2,pw3;
  #define PKW(P,B) cvtpk_s(P[B],P[B+1])
  #define PAF(k) __builtin_bit_cast(bf16x8,pw##k)
  #define VFR(i) (bf16x8){vlo[i][0],vlo[i][1],vlo[i][2],vlo[i][3],vhi[i][0],vhi[i][1],vhi[i][2],vhi[i][3]}
  #define PIN(x) asm volatile("":"+v"(x))
  #define MX3(a,b,c) __builtin_fmaxf(__builtin_fmaxf((a),(b)),(c))
  #define GAPA(MF,A0,A1,A2,A3,W0,W1,PW) do{ MF; sacc+=A0; sacc+=A1; sacc+=A2; sacc+=A3; PIN(sacc); W0; W1; PIN(PW); SBAR(); }while(0)
  #define EX(v) __builtin_amdgcn_exp2f(v)
  #define GAPB(MF,X,B) do{ MF; X[B]=EX(X[B]); X[B+1]=EX(X[B+1]); X[B+2]=EX(X[B+2]); X[B+3]=EX(X[B+3]); PIN(X); SBAR(); }while(0)
  #define VRD(i) do{ vlo[i]=vtr(vp_+(((i)>>2)*4096+((i)&3)*1024)); vhi[i]=vtr(vp_+(((i)>>2)*4096+((i)&3)*1024+512)); }while(0)
  #define KRD(G,j) do{ if(G){ kload2(kf,kp0+sl_next,j); SBAR(); } }while(0)
  #define STEP(C0,C1,P0,P1,t,GK,GV,GL) do{ SBAR(); \
    const lds_cptr vp_=vp0+sl_prev; \
    VRD(0); SBAR(); float sacc=(P0[0]+P0[1]); \
    GAPA(C0=__builtin_amdgcn_mfma_f32_32x32x16_bf16(kf[0],qr[0],negm,0,0,0), P0[2],P0[3],P0[4],P0[5],     pw0[0]=PKW(P0,0), pw0[1]=PKW(P0,2), pw0); \
    VRD(4); SBAR(); GAPA(C1=__builtin_amdgcn_mfma_f32_32x32x16_bf16(kf[1],qr[0],negm,0,0,0), P0[6],P0[7],P0[8],P0[9],     pw0[2]=PKW(P0,4), pw0[3]=PKW(P0,6), pw0); \
    VRD(1); SBAR(); GAPA(C0=__builtin_amdgcn_mfma_f32_32x32x16_bf16(kf[2],qr[1],C0,0,0,0),   P0[10],P0[11],P0[12],P0[13], pw1[0]=PKW(P0,8), pw1[1]=PKW(P0,10), pw1); \
    VRD(5); SBAR(); GAPA(C1=__builtin_amdgcn_mfma_f32_32x32x16_bf16(kf[3],qr[1],C1,0,0,0),   P0[14],P0[15],P1[0],P1[1],   pw1[2]=PKW(P0,12),pw1[3]=PKW(P0,14), pw1); \
    VRD(2); SBAR(); GAPA(C0=__builtin_amdgcn_mfma_f32_32x32x16_bf16(kf[4],qr[2],C0,0,0,0),   P1[2],P1[3],P1[4],P1[5],     pw2[0]=PKW(P1,0), pw2[1]=PKW(P1,2), pw2); \
    VRD(6); SBAR(); GAPA(C1=__builtin_amdgcn_mfma_f32_32x32x16_bf16(kf[5],qr[2],C1,0,0,0),   P1[6],P1[7],P1[8],P1[9],     pw2[2]=PKW(P1,4), pw2[3]=PKW(P1,6), pw2); \
    VRD(3); SBAR(); GAPA(C0=__builtin_amdgcn_mfma_f32_32x32x16_bf16(kf[6],qr[3],C0,0,0,0),   P1[10],P1[11],P1[12],P1[13], pw3[0]=PKW(P1,8), pw3[1]=PKW(P1,10), pw3); \
    VRD(7); SBAR(); GAPA(C1=__builtin_amdgcn_mfma_f32_32x32x16_bf16(kf[7],qr[3],C1,0,0,0),   P1[14],P1[15],0.f,0.f,       pw3[2]=PKW(P1,12),pw3[3]=PKW(P1,14), pw3); \
    l_reg+=sacc; \
    if(GK){DMA_K((t)+3,sl_cur);} if(GV){DMA_V((t)+1,sl_next);} \
    FBIAS(C0,C1,t); CMASK(C0,C1,t); \
    { float a=MX3(C0[0],C0[1],C1[0]),b=MX3(C0[2],C0[3],C1[1]); a=MX3(a,C1[2],C1[3]); \
      _Pragma("unroll") for(int r=4;r<16;r+=4){a=MX3(a,C0[r],C0[r+1]);b=MX3(b,C0[r+2],C0[r+3]);a=MX3(a,C1[r],C1[r+1]);b=MX3(b,C1[r+2],C1[r+3]);} \
      float rm=__builtin_fmaxf(a,b); { auto rr=__builtin_amdgcn_permlane32_swap(__float_as_uint(rm),__float_as_uint(rm),false,false); rm=__builtin_fmaxf(__uint_as_float(rr[0]),__uint_as_float(rr[1])); } \
      resc=false; \
      if(__builtin_expect(__any(rm>(float)THRL),0)){ const float dl=__builtin_fmaxf(rm,0.f); mhat+=dl; \
        _Pragma("unroll") for(int r=0;r<16;++r){C0[r]-=dl;C1[r]-=dl;} \
        _Pragma("unroll") for(int r=0;r<16;++r)negm[r]=cqv-mhat; asm volatile("":"+v"(negm)); \
        const float f=__builtin_amdgcn_exp2f(-dl); l_reg*=f; if(hi==0)wsf[r32]=f; resc=true; } } \
    SBAR(); \
    GAPB(o[0]=__builtin_amdgcn_mfma_f32_32x32x16_bf16(PAF(0),VFR(0),o[0],0,0,0), C0,0); \
    GAPB(o[1]=__builtin_amdgcn_mfma_f32_32x32x16_bf16(PAF(0),VFR(4),o[1],0,0,0), C0,4); \
    KRD(GL,0); GAPB(o[0]=__builtin_amdgcn_mfma_f32_32x32x16_bf16(PAF(1),VFR(1),o[0],0,0,0), C0,8); \
    KRD(GL,1); GAPB(o[1]=__builtin_amdgcn_mfma_f32_32x32x16_bf16(PAF(1),VFR(5),o[1],0,0,0), C0,12); \
    KRD(GL,2); GAPB(o[0]=__builtin_amdgcn_mfma_f32_32x32x16_bf16(PAF(2),VFR(2),o[0],0,0,0), C1,0); \
    KRD(GL,3); GAPB(o[1]=__builtin_amdgcn_mfma_f32_32x32x16_bf16(PAF(2),VFR(6),o[1],0,0,0), C1,4); \
    GAPB(o[0]=__builtin_amdgcn_mfma_f32_32x32x16_bf16(PAF(3),VFR(3),o[0],0,0,0), C1,8); \
    GAPB(o[1]=__builtin_amdgcn_mfma_f32_32x32x16_bf16(PAF(3),VFR(7),o[1],0,0,0), C1,12); \
    }while(0)
  int t=1;
  #undef CMASK
  #define CMASK(P0,P1,t) do{}while(0)
  for(;t+5<NT;t+=2){
    STEP(pB0,pB1,pA0,pA1,t,true,true,true);     WAIT_BAR(2); RESC(); ROT();
    STEP(pA0,pA1,pB0,pB1,t+1,true,true,true);   WAIT_BAR(2); RESC(); ROT();
  }
  #undef CMASK
  #define CMASK(P0,P1,t) do{int jb_=(t)-(NT-4); if(jb_>=0)cmask(P0,P1,jb_,qrel,hi);}while(0)
  #define ENDW(tt) do{ if((tt)+3<NT){WAIT_BAR(2);} else if((tt)+2<NT){WAIT_BAR(1);} else {WAIT_BAR(0);} }while(0)
  for(;t+1<NT;t+=2){
    STEP(pB0,pB1,pA0,pA1,t,(t+3<NT),(t+1<NT),(t+1<NT));       ENDW(t);   RESC(); ROT();
    STEP(pA0,pA1,pB0,pB1,t+1,(t+4<NT),(t+2<NT),(t+2<NT));     ENDW(t+1); RESC(); ROT();
  }
  STEP(pB0,pB1,pA0,pA1,NT-1,false,false,false); RESC();
  { float sacc=pB0[0]+pB0[1]; _Pragma("unroll") for(int r=2;r<16;++r)sacc+=pB0[r]; _Pragma("unroll") for(int r=0;r<16;++r)sacc+=pB1[r]; l_reg+=sacc;
    pw0=(u32x4){PKW(pB0,0),PKW(pB0,2),PKW(pB0,4),PKW(pB0,6)};pw1=(u32x4){PKW(pB0,8),PKW(pB0,10),PKW(pB0,12),PKW(pB0,14)};pw2=(u32x4){PKW(pB1,0),PKW(pB1,2),PKW(pB1,4),PKW(pB1,6)};pw3=(u32x4){PKW(pB1,8),PKW(pB1,10),PKW(pB1,12),PKW(pB1,14)};
    SBAR(); pv(o,vb0+sl_cur,PAF(0),PAF(1),PAF(2),PAF(3)); }
  #undef PKW
  #undef PAF
  #undef VFR
  #undef PIN
  #undef MX3
  #undef GAPA
  #undef GAPB
  #undef EX
  #undef VRD
  #undef KRD
  #undef STEP
  #undef ENDW
  {auto rr=__builtin_amdgcn_permlane32_swap(__float_as_uint(l_reg),__float_as_uint(l_reg),false,false);l_reg=__uint_as_float(rr[0])+__uint_as_float(rr[1]);}
  if(hi==0)wsf[32+r32]=l_reg;asm volatile("s_waitcnt lgkmcnt(0)":::"memory");
  float rli[16];
  #pragma unroll
  for(int r=0;r<16;++r)rli[r]=__builtin_amdgcn_rcpf(wsf[32+crow(r,hi)]);
  bf16*Ow=O+(rowbase+q0+wid*QBLK)*DM+h*D;
  { bf16*stg=(bf16*)(shm+LDS_OST)+wid*2048;
    #pragma unroll
    for(int r=0;r<16;++r){const int orow=crow(r,hi);
      #pragma unroll
      for(int d0=0;d0<2;++d0)stg[orow*64+d0*32+r32]=__float2bfloat16(o[d0][r]*rli[r]);}
    asm volatile("s_waitcnt lgkmcnt(0)":::"memory");
    const bf16*Gw=OG+(rowbase+q0+wid*QBLK)*DM+h*D;
    #pragma unroll
    for(int i=0;i<4;++i){const int row=i*8+(lane>>3),ch=lane&7; const u32x4 v=*(const u32x4*)(stg+row*64+ch*8); const u32x4 g=*(const u32x4*)(Gw+(long)row*DM+ch*8); u32x4 w;
      _Pragma("unroll") for(int e=0;e<4;++e){ const float lo=__uint_as_float(v[e]<<16)*__uint_as_float(g[e]<<16), hi2=__uint_as_float(v[e]&0xffff0000u)*__uint_as_float(g[e]&0xffff0000u); w[e]=cvtpk_s(lo,hi2); }
      ATTN_STORE16(Ow+(long)row*DM+ch*8,w);} }
  asm volatile("s_waitcnt lgkmcnt(0)\n\ts_barrier":::"memory");
  #undef DMA_K
  #undef DMA_V
  #undef CMASK
  #undef FBIAS
  #undef START
  #undef RESC
  #undef ROT
}
constexpr int ATTN_LDS_BYTES=LDS_BYTES;
struct AttnTensors { const bf16* Q; const bf16* K; const bf16* V; const bf16* G; bf16* O; };
struct AttnUnit { int bh; int qb; };
struct StaticOrder {
  int vcu;
  __device__ __forceinline__ explicit StaticOrder(int grid,int block):vcu((block%8)*(grid/8)+block/8){}
  __device__ __forceinline__ bool next(int i,AttnUnit&u)const{ if(i>=8)return false; const int s=2*(i>>1)+(vcu&1); u.bh=vcu>>1; u.qb=(i&1)?15-s:s; return true; }
  __device__ __forceinline__ void a_ready(const AttnUnit&)const{}
  __device__ __forceinline__ void done(const AttnUnit&)const{}
};
template<class Sched,int THRL=8> __device__ __forceinline__ void attn_phase(char*lds,const AttnTensors&T,const Sched&S){
  AttnUnit u;
  for(int i=0;S.next(i,u);++i){ S.a_ready(u); attn_unit<THRL>(u.bh/NHEAD,u.bh%NHEAD,u.qb,0,T.Q,T.K,T.V,T.G,T.O,lds); S.done(u); }
}
#undef SBAR
#undef WAIT_BAR
}

__device__ __forceinline__ void fox_cum_phase(LAS unsigned char* lds, const float* lf, float* cumg, int G) {
    const int tid = opaque_tid();
    LAS float* SCN = (LAS float*)lds;
    for (int bh = blockIdx.x; bh < NB * 16; bh += G) {
        const int b = bh >> 4, h = bh & 15;
        float loc[8]; float s = 0.f;
#pragma unroll
        for (int i = 0; i < 8; ++i) { s += lf[((size_t)b * SEQ + 8 * tid + i) * 16 + h]; loc[i] = s; }
        __syncthreads();
        SCN[tid] = s; __syncthreads();
        for (int off = 1; off < NTHR; off <<= 1) { const float t = (tid >= off) ? SCN[tid - off] : 0.f; __syncthreads(); SCN[tid] += t; __syncthreads(); }
        const float base = (tid > 0) ? SCN[tid - 1] : 0.f;
        f32x4 o0, o1;
#pragma unroll
        for (int i = 0; i < 4; ++i) { o0[i] = (base + loc[i]) * LOG2E; o1[i] = (base + loc[4 + i]) * LOG2E; }
        *(f32x4*)(cumg + (size_t)bh * SEQ + 8 * tid) = o0; *(f32x4*)(cumg + (size_t)bh * SEQ + 8 * tid + 4) = o1;
    }
    __syncthreads();
}
__device__ __forceinline__ void fox_attn_phase(unsigned char* ldsg, LAS unsigned char* lds, const float* qg, const float* kg) {
    LAS float* CUM = (LAS float*)(lds + attn_body::LDS_CUM);
    LAS int* BC = (LAS int*)(lds + LDS_TAB);
    float gq = 0.f, gk = 0.f;
    for (int i = 0; i < 64; ++i) { gq = fmaxf(gq, fabsf(qg[i])); gk = fmaxf(gk, fabsf(kg[i])); }
    if (opaque_tid() == 0) ((LAS float*)BC)[2] = 2.0f * 64.0f * attn_body::C2 * gq * gk + 48.0f;
    __syncthreads();
#define Tskip (((const LAS float*)BC)[2])
    int cur_bh = -1;
    for (;;) {
        const int tid = opaque_tid();
        unsigned char* const wsb = karg_ws();
        const float* cumg = (const float*)(wsb + WS_CUMG);
        if (tid == 0) BC[0] = (int)atomicAdd((unsigned*)(wsb + WS_CTL) + CW_ATTQ, 1u);
        __syncthreads();
        const int u = __builtin_amdgcn_readfirstlane(BC[0]);
        if (u >= NB * 16 * 16) break;
        const int qb = 15 - (u >> 7), bh = u & 127;
        if (bh != cur_bh) { cur_bh = bh;
            *(LAS f32x4*)(CUM + 8 * tid) = *(const f32x4*)(cumg + (size_t)bh * SEQ + 8 * tid); *(LAS f32x4*)(CUM + 8 * tid + 4) = *(const f32x4*)(cumg + (size_t)bh * SEQ + 8 * tid + 4); }
        __syncthreads();
        if (tid < 64) { const int ntf = 4 * qb + 4; const bool dead = (tid < ntf) && (CUM[qb * 256] - CUM[64 * tid + 63] < -Tskip);
            const unsigned long long m = __ballot(dead);
            if (tid == 0) { int ts = __popcll(m) & ~1; ts = ts > ntf - 4 ? ntf - 4 : ts; BC[1] = ts; } }
        __syncthreads();
        const int ts = __builtin_amdgcn_readfirstlane(BC[1]);
        unsigned char* const sb = wsb + WS_SCR;
        attn_body::attn_unit<8>(bh >> 4, bh & 15, qb, ts, (const attn_body::bf16*)(sb + S_FQ), (const attn_body::bf16*)(sb + S_FK), (const attn_body::bf16*)(sb + S_FV), (const attn_body::bf16*)(sb + S_FG), (attn_body::bf16*)(sb + S_A2), (char*)ldsg);
    }
#undef Tskip
}

constexpr int PH_PER_LAYER = 8, N_PHASES = 1 + DEPTH * PH_PER_LAYER + 1;

__device__ __forceinline__ void moe_tab(LAS unsigned char* lds, const unsigned* cnt) {
    LAS int* TAB = (LAS int*)(lds + LDS_TAB);
    if (threadIdx.x == 0) { int s = 0; for (int e = 0; e < NE; ++e) { const int c = (int)cnt[e]; TAB[e] = s; TAB[16 + e] = c; s += (c + 255) >> 8; } TAB[8] = s; }
    __syncthreads();
}

__global__ void __launch_bounds__(NTHR, 2) mk_fwd(Args args) {
#define bWS (karg_ws())
#define bCTL ((unsigned*)(bWS + WS_CTL))
#define bMOD ((float*)(bWS + WS_MOD))
#define bX ((bf16_t*)(bWS + WS_X))
#define bH ((bf16_t*)(bWS + WS_H))
#define bY ((bf16_t*)(bWS + WS_Y))
#define bTOK ((int*)(bWS + WS_TOK))
#define bTINFO ((u32x4*)(bWS + WS_TINFO))
#define bLF ((float*)(bWS + WS_LF))
#define bSCR (bWS + WS_SCR)
#define bA2 ((bf16_t*)(bSCR + S_A2))
    extern __shared__ __attribute__((aligned(16))) unsigned char lds_raw[];
    LAS unsigned char* lds = (LAS unsigned char*)lds_raw;
    const int tid = threadIdx.x, G = gridDim.x;
    const int vcu = (G % 8 == 0) ? ((int)blockIdx.x % 8) * (G / 8) + (int)blockIdx.x / 8 : (int)blockIdx.x;
    if (tid < 8) ((volatile LAS unsigned*)(lds + LDS_MISC))[tid] = 0u;
    __syncthreads();
#if MK_N_LAUNCHES == 1
    XcdBarrier bar = xcd_barrier_post(bCTL + CW_BAR, (volatile LAS unsigned*)(lds + LDS_MISC));
#define SEAM() xcd_barrier(bar)
#else
#define SEAM() do { } while (0)
#endif
    const int lo = args.ph_lo, hi = args.ph_hi;
#define IN(k) (lo <= (k) && (k) < hi)
#define BOTH(k) (IN(k) && IN((k) + 1))

    if (IN(0)) for (int rep = 0; rep < NREP(0); ++rep) { phase_prologue(lds, args, vcu, G); if (BOTH(0)) SEAM(); }

    for (int L = 0; L < DEPTH; ++L) {
        const int pb = 1 + PH_PER_LAYER * L, mixer = L % 3, mj = L / 3, fj = L >> 1; const bool moe = (L & 1) != 0, prev_moe = (L > 0) && (((L - 1) & 1) != 0);
#define modL (bMOD + (size_t)L * NB * MOD_W)
#define modP (bMOD + (size_t)(L > 0 ? L - 1 : 0) * NB * MOD_W)
#define xin_first ((L == 0) ? karg_in(I_X) : (const float*)bX)
        if (IN(pb + 0)) for (int rep = 0; rep < NREP(pb + 0); ++rep) {
            NormArgs na{}; na.xin = xin_first; na.xout = (float*)bX; na.H = bH; na.sc = modL + D; na.sh = modL; na.combine = prev_moe; na.cscale = (float)(int)(ABLATE != 2 * (L - 1) + 1); na.Y = bY; na.tinfo = bTINFO; na.g2p = modP + 5 * D; na.cntp = bCTL + CW_CNT + 64 * ((L - 1) >> 1);
            if (mixer == 0) { na.wx = karg_in(I_GLA_WIN) + (size_t)mj * D * GLA_IN + 3072; na.wx_pitch = GLA_IN; na.w2 = karg_in(I_GLA_WG2) + (size_t)mj * 16 * 512; na.bvec = karg_in(I_GLA_BG) + mj * 512;
                na.Dk = (float*)(bSCR + S_DK); na.dref = (float*)(bSCR + S_DR); na.etot = (float*)(bSCR + S_ET); if (L == 0) norm_mfma2<1, true>(lds, na, opq(G)); else norm_mfma2<1, false>(lds, na, opq(G)); }
            else if (mixer == 1) { norm_phase<0>(lds, na, opq(G)); }
            else { na.wx = karg_in(I_FOX_WIN) + 3072; na.wx_pitch = FOX_IN; na.bvec = karg_in(I_FOX_BF); na.lf = bLF; norm_mfma2<2>(lds, na, opq(G)); }
            if (BOTH(pb + 0)) SEAM();
        }
        if (IN(pb + 1)) for (int rep = 0; rep < NREP(pb + 1); ++rep) {
            if (mixer == 0) {
                pg8::DenseSched S{NTOK / 256, 3072 / 256, opq(G), opq((int)blockIdx.x), 2 * D, (const char*)(bWS + W_GLA_IN + mj * SZ_GLA_IN)};
                pg8::EpiGlaIn E{(bf16_t*)(bSCR + S_QG), (bf16_t*)(bSCR + S_KD), (bf16_t*)(bSCR + S_V), (bf16_t*)(bSCR + S_R), (const float*)(bSCR + S_DK), (const float*)(bSCR + S_DR)};
                pg8::gemm_phase(lds, (const char*)bH, S, E);
            } else if (mixer == 1) {
                pg8::DenseSched S{NTOK / 256, 2048 / 256, opq(G), opq((int)blockIdx.x), 2 * D, (const char*)(bWS + W_CONV_IN)};
                pg8::EpiGated<1> E{(bf16_t*)bSCR, D, karg_in(I_CONV_BIN), 1024, 1.0f, 1.0f};
                pg8::gemm_phase(lds, (const char*)bH, S, E);
            } else {
                if (rep == 0) fox_cum_phase(lds, bLF, (float*)(bWS + WS_CUMG), opq(G));
                pg8::DenseSched S{NTOK / 256, 4096 / 256, opq(G), opq((int)blockIdx.x), 2 * D, (const char*)(bWS + W_FOX_IN)};
                pg8::EpiFoxIn E{(bf16_t*)(bSCR + S_FQ), (bf16_t*)(bSCR + S_FK), (bf16_t*)(bSCR + S_FV), (bf16_t*)(bSCR + S_FG), karg_in(I_FOX_QN), karg_in(I_FOX_KN)};
                pg8::gemm_phase(lds, (const char*)bH, S, E);
            }
            if (BOTH(pb + 1)) SEAM();
        }
        if (IN(pb + 2)) for (int rep = 0; rep < NREP(pb + 2); ++rep) {
            if (mixer == 0) gla_scan_mfma(lds, (const bf16_t*)(bSCR + S_QG), (const bf16_t*)(bSCR + S_KD), (const bf16_t*)(bSCR + S_V), (const float*)(bSCR + S_ET), (bf16_t*)(bSCR + S_O), opq(vcu), opq(G));
            else if (mixer == 1) conv_phase(lds, (const bf16_t*)bSCR, karg_in(I_CONV_DW), karg_in(I_CONV_DWB), karg_in(I_CONV_LNG), karg_in(I_CONV_LNB), bA2, opq(vcu), opq(G));
            else fox_attn_phase(lds_raw, lds, karg_in(I_FOX_QN), karg_in(I_FOX_KN));
            if (BOTH(pb + 2)) SEAM();
        }
        if (IN(pb + 3)) for (int rep = 0; rep < NREP(pb + 3); ++rep) {
            if (mixer == 0) { gla_gn_phase((const bf16_t*)(bSCR + S_O), (const bf16_t*)(bSCR + S_R), karg_in(I_GLA_GN) + mj * D, bA2, opq(vcu), opq(G)); if (BOTH(pb + 3)) SEAM(); }
        }
        if (IN(pb + 4)) for (int rep = 0; rep < NREP(pb + 4); ++rep) {
            const float* wsrc = nullptr; const float* bias = nullptr; size_t woff = 0;
            if (mixer == 0) woff = W_GLA_OUT + mj * SZ_SQ; else if (mixer == 1) { woff = W_CONV_OUT; bias = karg_in(I_CONV_BOUT); } else woff = W_FOX_OUT;
            (void)wsrc;
            pg8::DenseSched S{NTOK / 256, D / 256, opq(G), opq((int)blockIdx.x), 2 * D, (const char*)(bWS + woff)};
            pg8::EpiOut E{(L == 0) ? karg_in(I_X) : (const float*)nullptr, bX, bX, modL + 2 * D, bias, (float)(int)(ABLATE != 2 * L)};
            pg8::gemm_phase(lds, (const char*)bA2, S, E);
            if (BOTH(pb + 4)) SEAM();
        }
        if (IN(pb + 5)) for (int rep = 0; rep < NREP(pb + 5); ++rep) {
            NormArgs na{}; na.xin = (const float*)bX; na.xout = (float*)bX; na.H = bH; na.sc = modL + 4 * D; na.sh = modL + 3 * D; na.combine = false;
            if (!moe) { na.wx_pitch = FFN_FP8 ? -1 : 0; norm_phase<0>(lds, na, opq(G)); if (DUP_NORM == 1) { __syncthreads(); norm_phase<0>(lds, na, opq(G)); } }
            else { na.wx = karg_in(I_MOE_R) + (size_t)fj * D * NE; na.wx_pitch = NE; na.tok = bTOK; na.tinfo_out = bTINFO; na.cnt = bCTL + CW_CNT + 64 * fj; norm_mfma2<3>(lds, na, opq(G)); }
            if (BOTH(pb + 5)) SEAM();
        }
        if (IN(pb + 6)) for (int rep = 0; rep < NREP(pb + 6); ++rep) {
            if (!moe) {
                pg8::DenseSched S{NTOK / 256, 2 * DFF / 256, opq(G), opq((int)blockIdx.x), FFN_FP8 ? D : 2 * D, (const char*)(bWS + W_FFN13 + fj * SZ_FFN13)};
                pg8::EpiGated<0> E{(bf16_t*)bSCR, DFF, nullptr, DFF, FFN_FP8 ? 1.0f / F8_W13 : 1.0f, 1.0f};
                pg8::gemm_phase<pg8::EpiGated<0>, pg8::DenseSched, FFN_FP8 != 0>(lds, (const char*)bH, S, E);
            } else {
                moe_tab(lds, bCTL + CW_CNT + 64 * fj);
                const LAS int* TAB = (const LAS int*)(lds + LDS_TAB);
                pg8::MoeSched S{TAB[8], 2 * DFE / 256, opq(G), opq((int)blockIdx.x), MOE_FP8 ? D : 2 * D, (const char*)(bWS + W_MOE13 + (size_t)fj * 8 * MOE13_STRIDE), MOE13_STRIDE, bTOK, TAB};
                pg8::EpiGated<0, MOE_FP8 != 0> E{(bf16_t*)bSCR, DFE, nullptr, DFE, MOE_FP8 ? 1.0f / F8_W13 : 1.0f, F8_HID};
                pg8::gemm_phase<pg8::EpiGated<0, MOE_FP8 != 0>, pg8::MoeSched, MOE_FP8 != 0>(lds, (const char*)bH, S, E);
            }
            if (BOTH(pb + 6)) SEAM();
        }
        if (IN(pb + 7)) for (int rep = 0; rep < NREP(pb + 7); ++rep) {
            if (!moe) {
                pg8::DenseSched S{NTOK / 256, D / 256, opq(G), opq((int)blockIdx.x), 2 * DFF, (const char*)(bWS + W_FFN2 + fj * SZ_FFN2)};
                pg8::EpiOut E{nullptr, bX, bX, modL + 5 * D, nullptr, (float)(int)(ABLATE != 2 * L + 1)};
                pg8::gemm_phase(lds, (const char*)bSCR, S, E);
            } else {
                moe_tab(lds, bCTL + CW_CNT + 64 * fj);
                const LAS int* TAB = (const LAS int*)(lds + LDS_TAB);
                pg8::MoeSched S{TAB[8], D / 256, opq(G), opq((int)blockIdx.x), MOE_FP8 ? DFE : 2 * DFE, (const char*)(bWS + W_MOE2 + (size_t)fj * 8 * MOE2_STRIDE), MOE2_STRIDE, nullptr, TAB};
                pg8::EpiBf16 E{bY, D, MOE_FP8 ? 1.0f / (F8_HID * F8_W2) : 1.0f};
                pg8::gemm_phase<pg8::EpiBf16, pg8::MoeSched, MOE_FP8 != 0>(lds, (const char*)bSCR, S, E);
            }
            if (BOTH(pb + 7)) SEAM();
        }
    }
    if (IN(N_PHASES - 1)) {
        NormArgs na{}; na.xin = (const float*)bX; na.xout = (float*)bX; na.combine = true; na.cscale = (ABLATE == 7) ? 0.f : 1.f; na.Y = bY; na.tinfo = bTINFO; na.g2p = bMOD + (size_t)3 * NB * MOD_W + 5 * D; na.cntp = bCTL + CW_CNT + 64 * 1;
        na.gamma = karg_in(I_NORMF); na.out = args.out;
        norm_phase<4>(lds, na, G);
        if (DUP_NORM == 4) { __syncthreads(); norm_phase<4>(lds, na, G); }
    }
#undef IN
#undef BOTH
#undef SEAM
#undef bWS
#undef bCTL
#undef bMOD
#undef bX
#undef bH
#undef bY
#undef bTOK
#undef bTINFO
#undef bLF
#undef bSCR
#undef bA2
#undef modL
#undef modP
#undef xin_first
}


#ifdef DBG_CHECK
constexpr int CW_DBG = 20000;
__global__ void dbg_check_router(const float* X, const float* mod  , const float* router, const u32x4* tinfo, const int* tok, unsigned* flags) {
    const int row = blockIdx.x * blockDim.x + threadIdx.x; if (row >= NTOK) return;
    const int b = row / SEQ; const float* x = X + (size_t)row * D; const float* sc = mod + (size_t)b * MOD_W + 4 * D; const float* sh = mod + (size_t)b * MOD_W + 3 * D;
    float ss = 0.f; for (int k = 0; k < D; ++k) ss += x[k] * x[k];
    const float rstd = 1.0f / sqrtf(ss / D + EPS);
    float lg[8]; for (int n = 0; n < 8; ++n) lg[n] = 0.f;
    for (int k = 0; k < D; ++k) { const float h = x[k] * rstd * (1.0f + sc[k]) + sh[k]; for (int n = 0; n < 8; ++n) lg[n] += h * router[k * 8 + n]; }
    int e0 = 0; for (int n = 1; n < 8; ++n) if (lg[n] > lg[e0]) e0 = n;
    int e1 = -1; for (int n = 0; n < 8; ++n) if (n != e0 && (e1 < 0 || lg[n] > lg[e1])) e1 = n;
    float l2 = -1e30f; for (int n = 0; n < 8; ++n) if (n != e0 && n != e1 && lg[n] > l2) l2 = lg[n];
    const float g0 = 1.0f / (1.0f + expf(lg[e1] - lg[e0]));
    const u32x4 ti = tinfo[row]; const int k0 = ti.x >> 15, k1 = ti.y >> 15;
    const bool safe = (lg[e0] - lg[e1] > 1e-3f) && (lg[e1] - l2 > 1e-3f);
    if (safe && (k0 != e0 || k1 != e1)) atomicAdd(flags + 0, 1u);
    if (safe && fabsf(__uint_as_float(ti.z) - g0) > 2e-3f) atomicAdd(flags + 1, 1u);
    if (safe && fabsf(__uint_as_float(ti.w) - (1.0f - g0)) > 2e-3f) atomicAdd(flags + 1, 1u);
    if (tok[ti.x] != row || tok[ti.y] != row) atomicAdd(flags + 2, 1u);
}
#ifndef DBG_FLAG
#define DBG_FLAG 0
#endif
__global__ void dbg_report(const unsigned* flags, float* out) {
    if (threadIdx.x == 0 && blockIdx.x == 0) out[0] = 50.0f + (float)flags[DBG_FLAG];
}
#endif
extern "C" void kernel_launch(void* const* d_in, const int* in_sizes, int n_in, void* d_out, int out_size, void* d_ws, size_t ws_size, hipStream_t stream) {
    static int grid = 0;
    if (grid == 0) {
        if (n_in != 28 || in_sizes[0] != NTOK * D || out_size != NTOK * D || ws_size < WS_END) {
            fprintf(stderr, "kernel_launch: unexpected shapes (n_in %d, in0 %d, out %d, ws %zu, need %zu); nothing launched\n", n_in, n_in > 0 ? in_sizes[0] : -1, out_size, ws_size, (size_t)WS_END); grid = -1; return; }
        int dev = 0, cus = 0, per_cu = 0;
        if (hipGetDevice(&dev) != hipSuccess || hipDeviceGetAttribute(&cus, hipDeviceAttributeMultiprocessorCount, dev) != hipSuccess) { grid = -1; return; }
        if (hipFuncSetAttribute((const void*)mk_fwd, hipFuncAttributeMaxDynamicSharedMemorySize, LDS_BYTES) != hipSuccess) { fprintf(stderr, "kernel_launch: hipFuncSetAttribute failed\n"); grid = -1; return; }
        if (hipOccupancyMaxActiveBlocksPerMultiprocessor(&per_cu, (const void*)mk_fwd, NTHR, LDS_BYTES) != hipSuccess || per_cu < 1)
            fprintf(stderr, "kernel_launch: note: occupancy query reports %d workgroups per CU\n", per_cu);
        (void)hipGetLastError();
        grid = cus;
    }
    if (grid < 0) return;
    if (hipMemsetAsync((char*)d_ws + WS_CTL, 0, CTL_ZERO_BYTES, stream) != hipSuccess) return;
    Args a{};
    for (int i = 0; i < 28; ++i) a.in[i] = (const float*)d_in[i];
    a.out = (float*)d_out; a.ws = (unsigned char*)d_ws;
#if MK_N_LAUNCHES == 1
    a.ph_lo = 0; a.ph_hi = N_PHASES;
    hipLaunchKernelGGL(mk_fwd, dim3(grid), dim3(NTHR), LDS_BYTES, stream, a);
#else
    for (int p = 0; p < N_PHASES; ++p) {
        const int L = (p - 1) / PH_PER_LAYER, slot = (p - 1) % PH_PER_LAYER;
        if (p >= 1 && p < N_PHASES - 1 && slot == 3 && (L % 3) != 0) continue;
        a.ph_lo = p; a.ph_hi = p + 1;
        hipLaunchKernelGGL(mk_fwd, dim3(grid), dim3(NTHR), LDS_BYTES, stream, a);
#ifdef DBG_CHECK
        if (p >= 1 && p < N_PHASES - 1 && slot == 5 && (L & 1)) {
            unsigned char* ws = (unsigned char*)d_ws;
            hipLaunchKernelGGL(dbg_check_router, dim3(NTOK / 256), dim3(256), 0, stream, (const float*)(ws + WS_X), (const float*)(ws + WS_MOD) + (size_t)L * NB * MOD_W, a.in[I_MOE_R] + (size_t)(L >> 1) * D * NE,
                               (const u32x4*)(ws + WS_TINFO), (const int*)(ws + WS_TOK), (unsigned*)(ws + WS_CTL) + CW_DBG + 4 * (L >> 1));
        }
#endif
    }
#ifdef DBG_CHECK
    hipLaunchKernelGGL(dbg_report, dim3(1), dim3(64), 0, stream, (const unsigned*)((unsigned char*)d_ws + WS_CTL) + CW_DBG, (float*)d_out);
#endif
#endif
}
```

```cpp
#include <hip/hip_runtime.h>
#include <cstdio>
#include <cstdint>
#include <utility>

#ifndef MK_N_LAUNCHES
#define MK_N_LAUNCHES 1
#endif
#ifndef DUP_PH
#define DUP_PH -1
#endif
#define NREP(p) ((DUP_PH == (p)) ? 2 : 1)
#ifndef DUP_NORM
#define DUP_NORM 0
#endif
#ifndef MOE_FP8
#define MOE_FP8 1
#endif
#ifndef FFN_FP8
#ifndef CONV_FP8
#define CONV_FP8 1
#endif
#define FFN_FP8 1
#endif
#ifndef ABLATE
#define ABLATE -1
#endif

#define LAS __attribute__((address_space(3)))
#define GAS __attribute__((address_space(1)))
typedef unsigned short bf16_t;
typedef short bf16x8 __attribute__((ext_vector_type(8)));
typedef float f32x4 __attribute__((ext_vector_type(4)));
typedef float f32x2 __attribute__((ext_vector_type(2)));
typedef unsigned u32x4 __attribute__((ext_vector_type(4)));
typedef unsigned u32x2 __attribute__((ext_vector_type(2)));
typedef __bf16 bf16x2_t __attribute__((ext_vector_type(2)));

constexpr int NB = 8, SEQ = 4096, D = 1024, NTOK = NB * SEQ, DEPTH = 4;
constexpr int GLA_IN = 3088, FOX_IN = 4112, DFF = 2816, DFE = 3584, NE = 8, MOD_W = 6 * D;
constexpr int CONVW = 31;
constexpr float EPS = 1e-6f;
constexpr float LOG2E = 1.4426950408889634f;
constexpr float QSCALE = 0.125f * LOG2E;
constexpr int NTHR = 512, NWAVES = 8;
constexpr int MOE_CAP = NTOK;
constexpr int MOE_MAXT = NTOK * 2 / 256 + NE;

constexpr size_t MiB = 1u << 20;
constexpr size_t WS_CTL = 0, CTL_ZERO_BYTES = 128 * 1024;
constexpr size_t WS_MOD = 1 * MiB;
constexpr size_t WS_W = 2 * MiB;
constexpr size_t SZ_GLA_IN = (size_t)3072 * D * 2, SZ_SQ = (size_t)D * D * 2, SZ_CONV_IN = (size_t)2048 * D * 2, SZ_FOX_IN = (size_t)4096 * D * 2;
constexpr size_t SZ_FFN13 = (size_t)2 * DFF * D * 2, SZ_FFN2 = (size_t)D * DFF * 2, SZ_MOE13 = (size_t)2 * DFE * D * 2, SZ_MOE2 = (size_t)D * DFE * 2;
constexpr size_t W_GLA_IN = WS_W, W_GLA_OUT = W_GLA_IN + 2 * SZ_GLA_IN, W_CONV_IN = W_GLA_OUT + 2 * SZ_SQ, W_CONV_OUT = W_CONV_IN + SZ_CONV_IN;
constexpr size_t W_FOX_IN = W_CONV_OUT + SZ_SQ, W_FOX_OUT = W_FOX_IN + SZ_FOX_IN, W_FFN13 = W_FOX_OUT + SZ_SQ, W_FFN2 = W_FFN13 + 2 * SZ_FFN13;
constexpr size_t W_MOE13 = W_FFN2 + 2 * SZ_FFN2, W_MOE2 = W_MOE13 + 16 * SZ_MOE13, W_END = W_MOE2 + 16 * SZ_MOE2;
constexpr size_t MOE13_STRIDE = MOE_FP8 ? SZ_MOE13 / 2 : SZ_MOE13, MOE2_STRIDE = MOE_FP8 ? SZ_MOE2 / 2 : SZ_MOE2;
constexpr size_t WS_X = (W_END + MiB - 1) / MiB * MiB;
constexpr size_t WS_H = WS_X + (size_t)NTOK * D * 4;
constexpr size_t WS_Y = WS_H + (size_t)NTOK * D * 2;
constexpr size_t WS_TOK = WS_Y + (size_t)MOE_MAXT * 256 * D * 2;
constexpr size_t WS_TINFO = WS_TOK + (size_t)NE * MOE_CAP * 4;
constexpr size_t WS_LF = WS_TINFO + (size_t)NTOK * 16;
constexpr size_t WS_CUMG = WS_LF + (size_t)NTOK * 16 * 4;
constexpr size_t WS_SCR = WS_CUMG + (size_t)NB * 16 * SEQ * 4;
constexpr size_t SCR_BYTES = (size_t)MOE_MAXT * 256 * DFE * 2;
constexpr size_t WS_END = WS_SCR + SCR_BYTES;
constexpr size_t S_QG = 0, S_KD = S_QG + (size_t)NTOK * 512 * 2, S_V = S_KD + (size_t)NTOK * 512 * 2, S_R = S_V + (size_t)NTOK * D * 2;
constexpr size_t S_DK = S_R + (size_t)NTOK * D * 2, S_ET = S_DK + (size_t)NTOK * 512 * 4, S_DR = S_ET + (size_t)512 * 512 * 4, S_O = S_DR + (size_t)512 * 8 * 512 * 4, S_A2 = S_O + (size_t)NTOK * D * 2;
static_assert(S_A2 + (size_t)NTOK * D * 2 <= SCR_BYTES, "GLA scratch");
constexpr size_t S_FQ = 0, S_FK = (size_t)NTOK * D * 2, S_FV = 2 * S_FK, S_FG = 3 * S_FK;
static_assert(4 * S_FK <= S_A2, "fox scratch");
constexpr int CW_BAR = 4096;
constexpr int CW_ATTQ = 16384 + 512;
constexpr int CW_CNT = 16384;

__device__ __forceinline__ int opaque_tid() { int t = threadIdx.x; asm volatile("" : "+v"(t)); return t; }
#define FENCE() do { asm volatile("" ::: "memory"); __builtin_amdgcn_sched_barrier(0); } while (0)
__device__ __forceinline__ unsigned pk2(float lo, float hi) { f32x2 v = {lo, hi}; bf16x2_t b = __builtin_convertvector(v, bf16x2_t); return __builtin_bit_cast(unsigned, b); }
constexpr float F8_W13 = 32.0f, F8_HID = 4.0f, F8_W2 = 64.0f;
__device__ __forceinline__ float f8clamp(float x) { return __builtin_amdgcn_fmed3f(x, -448.0f, 448.0f); }
__device__ __forceinline__ unsigned pk4_fp8(float a, float b, float c, float d) { int w = __builtin_amdgcn_cvt_pk_fp8_f32(f8clamp(a), f8clamp(b), 0, false); w = __builtin_amdgcn_cvt_pk_fp8_f32(f8clamp(c), f8clamp(d), w, true); return (unsigned)w; }
__device__ __forceinline__ float bf_lo(unsigned w) { return __uint_as_float(w << 16); }
__device__ __forceinline__ float bf_hi(unsigned w) { return __uint_as_float(w & 0xffff0000u); }
__device__ __forceinline__ float wave_sum(float v) {
    asm volatile("s_nop 1\n\t"
                 "v_add_f32_dpp %0, %0, %0 quad_perm:[1,0,3,2] row_mask:0xf bank_mask:0xf\n\ts_nop 1\n\t"
                 "v_add_f32_dpp %0, %0, %0 quad_perm:[2,3,0,1] row_mask:0xf bank_mask:0xf\n\ts_nop 1\n\t"
                 "v_add_f32_dpp %0, %0, %0 row_half_mirror row_mask:0xf bank_mask:0xf\n\ts_nop 1\n\t"
                 "v_add_f32_dpp %0, %0, %0 row_mirror row_mask:0xf bank_mask:0xf\n\ts_nop 1\n\t"
                 "v_add_f32_dpp %0, %0, %0 row_bcast:15 row_mask:0xa bank_mask:0xf\n\ts_nop 1\n\t"
                 "v_add_f32_dpp %0, %0, %0 row_bcast:31 row_mask:0xc bank_mask:0xf\n\ts_nop 1" : "+v"(v));
    return __uint_as_float((unsigned)__builtin_amdgcn_readlane((int)__float_as_uint(v), 63));
}
template <int N> __device__ __forceinline__ void xreduce(float (&v)[N], int lane) {
    constexpr int LG = (N == 64) ? 6 : (N == 32) ? 5 : (N == 16) ? 4 : (N == 8) ? 3 : 0;
    static_assert(LG > 0, "xreduce N");
#pragma unroll
    for (int s = 0; s < LG; ++s) {
        const int off = 32 >> s, n = N >> (s + 1);
        const bool hi = (lane & off) != 0;
#pragma unroll
        for (int i = 0; i < n; ++i) { float lo_v = v[i], hi_v = v[i + n]; asm volatile("" : "+v"(lo_v), "+v"(hi_v));
            const float keep = hi ? hi_v : lo_v; const float send = hi ? lo_v : hi_v; v[i] = keep + __shfl_xor(send, off); }
    }
#pragma unroll
    for (int off = (32 >> LG); off >= 1; off >>= 1) v[0] += __shfl_xor(v[0], off);
}
__device__ __forceinline__ float fast_sigmoid(float x) { return __builtin_amdgcn_rcpf(1.0f + __expf(-x)); }
__device__ __forceinline__ float fast_silu(float x) { return x * fast_sigmoid(x); }
__device__ __forceinline__ float log_sigmoid(float z) { return fminf(z, 0.f) - 0.6931471805599453f * __builtin_amdgcn_logf(1.0f + __builtin_amdgcn_exp2f(-LOG2E * fabsf(z))); }

#define XB_TMO      128
#define XB_XCNT(j)  (256  + 64 * (j))
#define XB_XSUB(j)  (1280 + 64 * (j))
#define XB_XGEN(j)  (2304 + 64 * (j))
#define XB_TOP      3328
#define XB_TOPGEN   3392
#define XCD_BAR_WORDS 3456
#define XB_SPIN_CAP (1u << 22)
__device__ __forceinline__ unsigned xb_ld(unsigned* p)              { return __hip_atomic_load(p, __ATOMIC_RELAXED, __HIP_MEMORY_SCOPE_AGENT); }
__device__ __forceinline__ unsigned xb_add(unsigned* p, unsigned v) { return __hip_atomic_fetch_add(p, v, __ATOMIC_RELAXED, __HIP_MEMORY_SCOPE_AGENT); }
__device__ __forceinline__ unsigned xb_xcc_id() { return (unsigned)__builtin_amdgcn_s_getreg((3 << 11) | 20) & 0xFu; }
#define XB_SPIN(cond, bar) do { unsigned _sp = 0; while (cond) { __builtin_amdgcn_s_sleep(1); \
    if ((++_sp & 255u) == 0u) { if (xb_ld(&(bar)[XB_TMO])) break; if (_sp > XB_SPIN_CAP) { atomicAdd(&(bar)[XB_TMO], 1u); break; } } } } while (0)
struct XcdBarrier { unsigned* bar; unsigned x; volatile LAS unsigned* st; };
__device__ __forceinline__ XcdBarrier xcd_barrier_post(unsigned* bar, volatile LAS unsigned* st) {
    XcdBarrier b; b.bar = bar; b.x = xb_xcc_id(); b.st = st;
    if (threadIdx.x == 0) (void)xb_add(&bar[XB_XCNT(b.x)], 1u);
    return b;
}
__device__ __forceinline__ void xcd_barrier_complete(unsigned* bar, unsigned x, unsigned& nloc, unsigned& nx) {
    const unsigned G = gridDim.x * gridDim.y * gridDim.z;
    unsigned sum, cnt, mine, sp = 0u;
    for (;;) {
        sum = 0u; cnt = 0u; mine = 0u;
#pragma unroll
        for (unsigned j = 0; j < 16; ++j) { const unsigned c = xb_ld(&bar[XB_XCNT(j)]); sum += c; cnt += (c > 0u) ? 1u : 0u; mine = (j == x) ? c : mine; }
        if (sum == G) break;
        __builtin_amdgcn_s_sleep(1);
        if ((++sp & 255u) == 0u) { if (xb_ld(&bar[XB_TMO])) break; if (sp > XB_SPIN_CAP) { atomicAdd(&bar[XB_TMO], 1u); break; } }
    }
    nloc = mine > 0u ? mine : 1u; nx = cnt > 0u ? cnt : 1u;
}
__device__ __forceinline__ void xcd_barrier(const XcdBarrier& b) {
    asm volatile("s_waitcnt vmcnt(0)" ::: "memory");
    __syncthreads();
    if (threadIdx.x == 0) {
        unsigned* bar = b.bar; unsigned bx = b.x;
        asm volatile("" : "+s"(bar), "+s"(bx));
        __builtin_amdgcn_s_waitcnt(0);
        unsigned nloc = b.st[0], nx = b.st[1];
        if (nloc == 0u) { xcd_barrier_complete(bar, bx, nloc, nx); b.st[0] = nloc; b.st[1] = nx; }
        const unsigned old = xb_add(&bar[XB_XSUB(bx)], 1u);
        const unsigned gen = old / nloc;
        if (old + 1u == (gen + 1u) * nloc) {
            __builtin_amdgcn_fence(__ATOMIC_RELEASE, "agent");
            asm volatile("s_waitcnt vmcnt(0)" ::: "memory");
            const unsigned og = xb_add(&bar[XB_TOP], 1u);
            const unsigned tg = og / nx;
            if (og + 1u == (tg + 1u) * nx) xb_add(&bar[XB_TOPGEN], 1u);
            else XB_SPIN(xb_ld(&bar[XB_TOPGEN]) == tg, bar);
            __builtin_amdgcn_fence(__ATOMIC_ACQUIRE, "agent");
            xb_add(&bar[XB_XGEN(bx)], 1u);
            asm volatile("s_waitcnt vmcnt(0)" ::: "memory");
        } else {
            XB_SPIN(xb_ld(&bar[XB_XGEN(bx)]) == gen, bar);
            __builtin_amdgcn_fence(__ATOMIC_ACQUIRE, "agent");
            asm volatile("s_waitcnt vmcnt(0)" ::: "memory");
        }
    }
    __syncthreads();
}

namespace pg8 {
constexpr int BM = 256, BK = 64, HALF = 128, HTB = HALF * BK * 2, STAGE_BYTES = 8 * HTB, NXCD = 8, WGM = 8;
__host__ __device__ __forceinline__ int lds_byte(int r, int c) { const int st = (r >> 4) * 2 + (c >> 5), rr = r & 15, cc = c & 31, ob = rr * 64 + cc * 2; return st * 1024 + (ob ^ (((ob >> 9) & 1) << 5)); }
__host__ __device__ __forceinline__ void stage_rc(int b, int& R, int& C) { const int st = b / 1024, sb = b % 1024, swz = sb ^ (((sb >> 9) & 1) << 5); R = (st >> 1) * 16 + swz / 64; C = (st & 1) * 32 + (swz % 64) / 2; }
__host__ __device__ __forceinline__ int perm32(int rho) { const int n = rho >> 4, i = rho & 15; return 8 * (i >> 2) + 4 * n + (i & 3); }
struct Unit { int pm, pn, e; };

__device__ __forceinline__ bool order_next(int i, int G, int c, int nM, int nN, int& pm, int& pn) {
    const int nwg = nM * nN; const long L = (long)i * G + c; if (L >= nwg) return false;
    int wgid = (int)L; { const int q = nwg / NXCD, r = nwg % NXCD, xcd = wgid % NXCD, off = wgid / NXCD; wgid = (xcd < r ? xcd * (q + 1) : r * (q + 1) + (xcd - r) * q) + off; }
    const int nig = WGM * nN, gid = wgid / nig, fm = gid * WGM, gsz = (nM - fm) < WGM ? (nM - fm) : WGM;
    pm = fm + ((wgid % nig) % gsz); pn = (wgid % nig) / gsz; return true;
}
struct DenseSched {
    int nM, nN, G, c, KB; const char* Bt;
    __device__ __forceinline__ bool next(int i, Unit& u) const { u.e = 0; return order_next(i, G, c, nM, nN, u.pm, u.pn); }
    __device__ __forceinline__ int row(const Unit& u, int lr) const { return u.pm * BM + lr; }
    __device__ __forceinline__ const char* b_tile(const Unit& u) const { return Bt + (size_t)u.pn * BM * KB; }
};
struct MoeSched {
    int nM, nN, G, c, KB; const char* Bt; size_t estride; const int* tok; const LAS int* tab;
    __device__ __forceinline__ bool next(int i, Unit& u) const {
        if (!order_next(i, G, c, nM, nN, u.pm, u.pn)) return false;
        int e = 0;
#pragma unroll
        for (int j = 1; j < NE; ++j) e = (u.pm >= tab[j]) ? j : e;
        u.e = e; return true;
    }
    __device__ __forceinline__ int row(const Unit& u, int lr) const {
        if (tok == nullptr) return u.pm * BM + lr;
        const int pos = (u.pm - tab[u.e]) * BM + lr;
        return pos < tab[16 + u.e] ? tok[u.e * MOE_CAP + pos] : 0;
    }
    __device__ __forceinline__ const char* b_tile(const Unit& u) const { return Bt + (size_t)u.e * estride + (size_t)u.pn * BM * KB; }
};

typedef int v8i32 __attribute__((ext_vector_type(8)));
__device__ __forceinline__ const char* uni_ptr(const char* p) { const unsigned long long v = (unsigned long long)p; const unsigned lo = (unsigned)__builtin_amdgcn_readfirstlane((int)(unsigned)v), hi = (unsigned)__builtin_amdgcn_readfirstlane((int)(unsigned)(v >> 32)); return (const char*)(((unsigned long long)hi << 32) | lo); }
__device__ __forceinline__ v8i32 cat8(bf16x8 lo, bf16x8 hi) { const u32x4 a = __builtin_bit_cast(u32x4, lo), b = __builtin_bit_cast(u32x4, hi); return (v8i32){(int)a.x, (int)a.y, (int)a.z, (int)a.w, (int)b.x, (int)b.y, (int)b.z, (int)b.w}; }
template <class Epi, class Sched, bool FP8 = false>
__device__ __forceinline__ void gemm_phase(LAS unsigned char* lds, const char* Abase, const Sched& S, const Epi& E) {
    const int tid = opaque_tid(), wid = __builtin_amdgcn_readfirstlane(tid >> 6), lane = tid & 63, wr = wid >> 2, wc = wid & 3, fr = lane & 15, fq = lane >> 4;
    const int KB = S.KB, nt = KB / (BK * 2);
    int Rp[2], Cp[2]; unsigned voffB[2];
#pragma unroll
    for (int i = 0; i < 2; ++i) { int R, C; stage_rc(tid * 16 + i * 8192, R, C); Rp[i] = R; Cp[i] = C; const int Rb = Epi::PERM ? ((R & ~31) + perm32(R & 31)) : R; voffB[i] = (unsigned)(Rb * KB + C * 2); }
    const size_t kstep = (size_t)(BK * 2);
    const size_t hstep = (size_t)HALF * KB;
    const unsigned ldsw = (unsigned)wid * 1024u;
    const unsigned lds0 = (unsigned)__builtin_amdgcn_readfirstlane((int)((unsigned)(size_t)lds + ldsw));
    const int aoff = lds_byte(wr * 64 + fr, fq * 8), boff = lds_byte(wc * 32 + fr, fq * 8);
#define PG8_SA(b, h) (((b) * 2 + (h)) * HTB)
#define PG8_SB(b, h) ((4 + (b) * 2 + (h)) * HTB)
#define PG8_GLDS(sbase, voff32, ldsdst) do { unsigned _keep; asm volatile("s_mov_b32 %0, m0\n\ts_mov_b32 m0, %3\n\ts_nop 0\n\tglobal_load_lds_dwordx4 %1, %2\n\ts_mov_b32 m0, %0" \
        : "=&s"(_keep) : "v"(voff32), "s"(sbase), "s"(ldsdst) : "memory"); } while (0)
#define PG8_STAGE(bufoff, gbase, voff) do { const char* _sb = uni_ptr((const char*)(gbase)); _Pragma("unroll") for (int _i = 0; _i < 2; ++_i) \
        PG8_GLDS(_sb, (voff)[_i], lds0 + (unsigned)((bufoff) + _i * 8192)); } while (0)
#define PG8_STAGEA(bufoff, ra2, koff) do { const char* _sb = uni_ptr(Abase + (size_t)(koff)); _Pragma("unroll") for (int _i = 0; _i < 2; ++_i) \
        PG8_GLDS(_sb, (ra2)[_i], lds0 + (unsigned)((bufoff) + _i * 8192)); } while (0)
#define PG8_LDA(dst, b, h) do { _Pragma("unroll") for (int m = 0; m < 4; ++m) _Pragma("unroll") for (int k = 0; k < 2; ++k) dst[m][k] = *(const LAS bf16x8*)(lds + PG8_SA(b, h) + aoff + m * 2048 + k * 1024); } while (0)
#define PG8_LDB(dst, b, h) do { _Pragma("unroll") for (int n = 0; n < 2; ++n) _Pragma("unroll") for (int k = 0; k < 2; ++k) dst[n][k] = *(const LAS bf16x8*)(lds + PG8_SB(b, h) + boff + n * 2048 + k * 1024); } while (0)
#define PG8_MMA(ai, bj, At, Bt) do { __builtin_amdgcn_s_setprio(1); _Pragma("unroll") for (int m = 0; m < 4; ++m) _Pragma("unroll") for (int n = 0; n < 2; ++n) { \
        if constexpr (FP8) { const v8i32 _b8 = cat8(Bt[n][0], Bt[n][1]), _a8 = cat8(At[m][0], At[m][1]); \
            asm volatile("v_mfma_scale_f32_16x16x128_f8f6f4 %0, %1, %2, %0, %3, %3 op_sel_hi:[0,0,0]" : "+v"(acc[ai][bj][m][n]) : "v"(_b8), "v"(_a8), "v"(f8one)); } \
        else { _Pragma("unroll") for (int k = 0; k < 2; ++k) acc[ai][bj][m][n] = __builtin_amdgcn_mfma_f32_16x16x32_bf16(Bt[n][k], At[m][k], acc[ai][bj][m][n], 0, 0, 0); } } \
        __builtin_amdgcn_s_setprio(0); } while (0)
#define PG8_WAIT_V(n) asm volatile("s_waitcnt vmcnt(" #n ")" ::: "memory")
#define PG8_WAIT_L(n) asm volatile("s_waitcnt lgkmcnt(" #n ")" ::: "memory")
#define PG8_BAR __builtin_amdgcn_s_barrier()
#define PG8_SCHED __builtin_amdgcn_sched_barrier(0)
#define PG8_ROWS(u, ra) do { _Pragma("unroll") for (int _h = 0; _h < 2; ++_h) _Pragma("unroll") for (int _i = 0; _i < 2; ++_i) \
        ra[_h][_i] = (unsigned)(S.row(u, _h * HALF + Rp[_i]) * KB + Cp[_i] * 2); } while (0)
    unsigned f8one = 0x7F7F7F7Fu; asm volatile("" : "+v"(f8one));
    Unit cur, nxt; int ui = 0;
    if (!S.next(0, cur)) return;
    bool has_next = S.next(1, nxt);
    unsigned ra_cur[2][2], ra_nxt[2][2];
    PG8_ROWS(cur, ra_cur);
    if (has_next) { PG8_ROWS(nxt, ra_nxt); } else {
#pragma unroll
        for (int h = 0; h < 2; ++h) { ra_nxt[h][0] = ra_cur[h][0]; ra_nxt[h][1] = ra_cur[h][1]; } }
    f32x4 acc[2][2][4][2];
#pragma unroll
    for (int a = 0; a < 2; ++a)
#pragma unroll
        for (int b = 0; b < 2; ++b)
#pragma unroll
            for (int m = 0; m < 4; ++m)
#pragma unroll
                for (int n = 0; n < 2; ++n) acc[a][b][m][n] = (f32x4){0.f, 0.f, 0.f, 0.f};
    bf16x8 At[4][2], B0[2][2], B1[2][2];
    const char* cB = S.b_tile(cur);
    PG8_STAGE(PG8_SB(0, 0), cB, voffB); PG8_STAGE(PG8_SB(0, 1), cB + hstep, voffB); PG8_STAGEA(PG8_SA(0, 0), ra_cur[0], 0); PG8_STAGEA(PG8_SA(0, 1), ra_cur[1], 0);
    if (wr == 1) PG8_BAR;
    PG8_WAIT_V(2); PG8_BAR;
    PG8_STAGE(PG8_SB(1, 0), cB + kstep, voffB); PG8_STAGEA(PG8_SA(1, 0), ra_cur[0], kstep); PG8_STAGE(PG8_SB(1, 1), cB + hstep + kstep, voffB);
    PG8_WAIT_V(6); PG8_BAR;
    for (;;) {
        const char* nB = has_next ? S.b_tile(nxt) : cB;
        for (int t = 0; t < nt; t += 2) {
            const bool last = (t == nt - 2);
            const size_t k1 = (size_t)(t + 1) * kstep;
            const size_t k2 = last ? (size_t)0 : (size_t)(t + 2) * kstep; const char* b2 = last ? nB : cB + (size_t)(t + 2) * kstep;
            const size_t k3 = k2 + kstep; const char* b3 = b2 + kstep;
            unsigned r2[2][2];
#pragma unroll
            for (int h = 0; h < 2; ++h) { r2[h][0] = last ? ra_nxt[h][0] : ra_cur[h][0]; r2[h][1] = last ? ra_nxt[h][1] : ra_cur[h][1]; }
            PG8_LDB(B0, 0, 0); PG8_LDB(B1, 0, 1); PG8_SCHED; PG8_LDA(At, 0, 0); PG8_STAGEA(PG8_SA(1, 1), ra_cur[1], k1);
            PG8_WAIT_V(8); PG8_WAIT_L(0); PG8_BAR; PG8_MMA(0, 0, At, B0); PG8_MMA(0, 1, At, B1); PG8_BAR; PG8_SCHED;
            PG8_LDA(At, 0, 1); PG8_STAGE(PG8_SB(0, 0), b2, voffB); PG8_STAGE(PG8_SB(0, 1), b2 + hstep, voffB); PG8_STAGEA(PG8_SA(0, 0), r2[0], k2);
            PG8_WAIT_V(8); PG8_WAIT_L(0); PG8_BAR; PG8_MMA(1, 0, At, B0); PG8_MMA(1, 1, At, B1); PG8_BAR; PG8_SCHED;
            PG8_LDB(B0, 1, 0); PG8_LDB(B1, 1, 1); PG8_SCHED; PG8_LDA(At, 1, 0); PG8_STAGEA(PG8_SA(0, 1), r2[1], k2);
            PG8_WAIT_V(8); PG8_WAIT_L(0); PG8_BAR; PG8_MMA(0, 0, At, B0); PG8_MMA(0, 1, At, B1); PG8_BAR; PG8_SCHED;
            PG8_LDA(At, 1, 1); PG8_STAGE(PG8_SB(1, 0), b3, voffB); PG8_STAGE(PG8_SB(1, 1), b3 + hstep, voffB); PG8_STAGEA(PG8_SA(1, 0), r2[0], k3);
            PG8_WAIT_V(8); PG8_WAIT_L(0); PG8_BAR; PG8_MMA(1, 0, At, B0); PG8_MMA(1, 1, At, B1); PG8_BAR; PG8_SCHED;
        }
        if (wr == 0) PG8_BAR;
        if constexpr (FP8) asm volatile("s_nop 15\n\ts_nop 7" ::: "memory");
        Unit nx2; const bool hn2 = has_next && S.next(ui + 2, nx2); int rr2[2][2];
        if (hn2) {
#pragma unroll
            for (int h = 0; h < 2; ++h) { rr2[h][0] = S.row(nx2, h * HALF + Rp[0]); rr2[h][1] = S.row(nx2, h * HALF + Rp[1]); } }
        asm volatile("" ::: "memory");
        E(acc, cur, wr, wc, fr, fq);
        if (!has_next) break;
#pragma unroll
        for (int a = 0; a < 2; ++a)
#pragma unroll
            for (int b = 0; b < 2; ++b)
#pragma unroll
                for (int m = 0; m < 4; ++m)
#pragma unroll
                    for (int n = 0; n < 2; ++n) acc[a][b][m][n] = (f32x4){0.f, 0.f, 0.f, 0.f};
        cur = nxt; cB = nB; ++ui;
#pragma unroll
        for (int h = 0; h < 2; ++h) { ra_cur[h][0] = ra_nxt[h][0]; ra_cur[h][1] = ra_nxt[h][1]; }
        has_next = hn2; nxt = nx2;
        if (has_next) {
#pragma unroll
            for (int h = 0; h < 2; ++h) { ra_nxt[h][0] = (unsigned)(rr2[h][0] * KB + Cp[0] * 2); ra_nxt[h][1] = (unsigned)(rr2[h][1] * KB + Cp[1] * 2); } }
        if (wr == 1) PG8_BAR;
    }
    PG8_WAIT_V(0);
    PG8_BAR;
#undef PG8_SA
#undef PG8_SB
#undef PG8_STAGE
#undef PG8_STAGEA
#undef PG8_LDA
#undef PG8_LDB
#undef PG8_MMA
#undef PG8_WAIT_V
#undef PG8_WAIT_L
#undef PG8_BAR
#undef PG8_SCHED
#undef PG8_ROWS
}

typedef const f32x4 (&AccRef)[2][2][4][2];
struct EpiOut {
    static constexpr bool PERM = true;
    const float* xin32; const bf16_t* xin; bf16_t* xout; const float* gate; const float* bias; float gscale;
    __device__ __forceinline__ void operator()(AccRef acc, const Unit& u, int wr, int wc, int fr, int fq) const {
        const int row0 = u.pm * BM + wr * 64 + fr, col0 = u.pn * BM + wc * 32 + 8 * fq, b = (u.pm * BM) / SEQ;
        f32x4 gv[2][2], bv[2][2];
#pragma unroll
        for (int bj = 0; bj < 2; ++bj)
#pragma unroll
            for (int n = 0; n < 2; ++n) { gv[bj][n] = *(const f32x4*)(gate + (size_t)b * MOD_W + col0 + bj * HALF + n * 4) * gscale;
                bv[bj][n] = bias ? *(const f32x4*)(bias + col0 + bj * HALF + n * 4) : (f32x4){0.f, 0.f, 0.f, 0.f}; }
        if (xin32 != nullptr) {
#pragma unroll
            for (int ai = 0; ai < 2; ++ai)
#pragma unroll
                for (int m = 0; m < 4; ++m) { const size_t off = (size_t)(row0 + ai * HALF + m * 16) * D + col0;
#pragma unroll
                    for (int bj = 0; bj < 2; ++bj) { const f32x4 x0 = *(const f32x4*)(xin32 + off + bj * HALF), x1 = *(const f32x4*)(xin32 + off + bj * HALF + 4);
                        const f32x4 v0 = x0 + gv[bj][0] * (acc[ai][bj][m][0] + bv[bj][0]), v1 = x1 + gv[bj][1] * (acc[ai][bj][m][1] + bv[bj][1]);
                        u32x4 w; w.x = pk2(v0[0], v0[1]); w.y = pk2(v0[2], v0[3]); w.z = pk2(v1[0], v1[1]); w.w = pk2(v1[2], v1[3]);
                        *(u32x4*)(xout + off + bj * HALF) = w; }
                    asm volatile("" ::: "memory"); }
        } else {
#pragma unroll
            for (int ai = 0; ai < 2; ++ai)
#pragma unroll
                for (int m = 0; m < 4; ++m) { const size_t off = (size_t)(row0 + ai * HALF + m * 16) * D + col0;
#pragma unroll
                    for (int bj = 0; bj < 2; ++bj) { const u32x4 xw = *(const u32x4*)(xin + off + bj * HALF);
                        const f32x4 x0 = {bf_lo(xw.x), bf_hi(xw.x), bf_lo(xw.y), bf_hi(xw.y)}, x1 = {bf_lo(xw.z), bf_hi(xw.z), bf_lo(xw.w), bf_hi(xw.w)};
                        const f32x4 v0 = x0 + gv[bj][0] * (acc[ai][bj][m][0] + bv[bj][0]), v1 = x1 + gv[bj][1] * (acc[ai][bj][m][1] + bv[bj][1]);
                        u32x4 w; w.x = pk2(v0[0], v0[1]); w.y = pk2(v0[2], v0[3]); w.z = pk2(v1[0], v1[1]); w.w = pk2(v1[2], v1[3]);
                        *(u32x4*)(xout + off + bj * HALF) = w; }
                    asm volatile("" ::: "memory"); }
        }
    }
};
template <int MODE, bool F8OUT = false> struct EpiGated {
    static constexpr bool PERM = true;
    bf16_t* O; int ldc; const float* bias; int hid; float ascale, oscale;
    __device__ __forceinline__ void operator()(AccRef acc, const Unit& u, int wr, int wc, int fr, int fq) const {
        const int row0 = u.pm * BM + wr * 64 + fr, col0 = u.pn * HALF + wc * 32 + 8 * fq;
        f32x4 ba[2], bb[2];
#pragma unroll
        for (int n = 0; n < 2; ++n) { ba[n] = (MODE == 1) ? *(const f32x4*)(bias + col0 + 4 * n) : (f32x4){0.f, 0.f, 0.f, 0.f}; bb[n] = (MODE == 1) ? *(const f32x4*)(bias + hid + col0 + 4 * n) : (f32x4){0.f, 0.f, 0.f, 0.f}; }
#pragma unroll
        for (int ai = 0; ai < 2; ++ai)
#pragma unroll
            for (int m = 0; m < 4; ++m) { bf16_t* rowp = O + (size_t)(row0 + ai * HALF + m * 16) * ldc + col0; float o[8];
#pragma unroll
                for (int n = 0; n < 2; ++n) {
                    if constexpr (MODE == 0) {
                        const f32x4 A4 = acc[ai][0][m][n], U4 = acc[ai][1][m][n]; const float c1 = -LOG2E * ascale, kk = 1.0f / (ascale * ascale * (F8OUT ? oscale : 1.0f));
                        const f32x4 t = A4 * c1; f32x4 e;
#pragma unroll
                        for (int i = 0; i < 4; ++i) e[i] = __builtin_amdgcn_exp2f(t[i]);
                        const f32x4 d = e * kk + kk; f32x4 r;
#pragma unroll
                        for (int i = 0; i < 4; ++i) r[i] = __builtin_amdgcn_rcpf(d[i]);
                        const f32x4 ov = (A4 * U4) * r;
#pragma unroll
                        for (int i = 0; i < 4; ++i) o[4 * n + i] = ov[i];
                        continue; }
                    const f32x4 a = acc[ai][0][m][n] * ascale + ba[n], g = acc[ai][1][m][n] * ascale + bb[n];
                    const f32x4 t = ((MODE == 0) ? a : g) * (-LOG2E); f32x4 e;
#pragma unroll
                    for (int i = 0; i < 4; ++i) e[i] = __builtin_amdgcn_exp2f(t[i]);
                    const f32x4 d = e + 1.0f; f32x4 r;
#pragma unroll
                    for (int i = 0; i < 4; ++i) r[i] = __builtin_amdgcn_rcpf(d[i]);
                    const f32x4 ov = (a * r) * ((MODE == 0) ? g : (f32x4){1.f, 1.f, 1.f, 1.f}) * (F8OUT ? oscale : 1.0f);
#pragma unroll
                    for (int i = 0; i < 4; ++i) o[4 * n + i] = ov[i]; }
                if constexpr (F8OUT) { u32x2 w; w.x = pk4_fp8(o[0], o[1], o[2], o[3]); w.y = pk4_fp8(o[4], o[5], o[6], o[7]);
                    *(u32x2*)((unsigned char*)O + (size_t)(row0 + ai * HALF + m * 16) * ldc + col0) = w; }
                else { u32x4 w; w.x = pk2(o[0], o[1]); w.y = pk2(o[2], o[3]); w.z = pk2(o[4], o[5]); w.w = pk2(o[6], o[7]);
                    *(u32x4*)rowp = w; } }
    }
};
struct EpiBf16 {
    static constexpr bool PERM = true;
    bf16_t* O; int ldc; float scale;
    __device__ __forceinline__ void operator()(AccRef acc, const Unit& u, int wr, int wc, int fr, int fq) const {
        const int row0 = u.pm * BM + wr * 64 + fr, col0 = u.pn * BM + wc * 32 + 8 * fq;
#pragma unroll
        for (int ai = 0; ai < 2; ++ai)
#pragma unroll
            for (int m = 0; m < 4; ++m) { bf16_t* rowp = O + (size_t)(row0 + ai * HALF + m * 16) * ldc + col0;
#pragma unroll
                for (int bj = 0; bj < 2; ++bj) { const f32x4 v0 = acc[ai][bj][m][0] * scale, v1 = acc[ai][bj][m][1] * scale;
                    u32x4 w; w.x = pk2(v0[0], v0[1]); w.y = pk2(v0[2], v0[3]); w.z = pk2(v1[0], v1[1]); w.w = pk2(v1[2], v1[3]);
                    *(u32x4*)(rowp + bj * HALF) = w; } }
    }
};
struct EpiGlaIn {
    static constexpr bool PERM = true;
    bf16_t *Q, *KD, *V, *R; const float* Dk; const float* dref;
    __device__ __forceinline__ void operator()(AccRef acc, const Unit& u, int wr, int wc, int fr, int fq) const {
        const int row0 = u.pm * BM + wr * 64 + fr, cw = wc * 32 + 8 * fq;
        const int type = (u.pn < 2) ? 0 : (u.pn < 4) ? 1 : (u.pn < 8) ? 2 : 3;
        const int tcol = (type == 0) ? u.pn * BM : (type == 1) ? (u.pn - 2) * BM : (type == 2) ? (u.pn - 4) * BM : (u.pn - 8) * BM;
        bf16_t* base = (type == 0) ? Q : (type == 1) ? KD : (type == 2) ? V : R; const int ldc = (type < 2) ? 512 : D;
#pragma unroll
        for (int ai = 0; ai < 2; ++ai)
#pragma unroll
            for (int m = 0; m < 4; ++m) { const int row = row0 + ai * HALF + m * 16;
#pragma unroll
                for (int bj = 0; bj < 2; ++bj) { const int col = tcol + bj * HALF + cw; f32x4 v0 = acc[ai][bj][m][0], v1 = acc[ai][bj][m][1];
                    if (type == 0) { v0 = v0 * 0.08838834764831845f; v1 = v1 * 0.08838834764831845f; }
                    else if (type == 1) { const float* rp = dref + (size_t)(row >> 4) * 512 + col;
                        const u32x4 cw = *(const u32x4*)((const bf16_t*)Dk + (size_t)row * 512 + col); const f32x4 c0 = (f32x4){bf_lo(cw.x), bf_hi(cw.x), bf_lo(cw.y), bf_hi(cw.y)}, c1 = (f32x4){bf_lo(cw.z), bf_hi(cw.z), bf_lo(cw.w), bf_hi(cw.w)}, r0 = *(const f32x4*)rp, r1 = *(const f32x4*)(rp + 4);
#pragma unroll
                        for (int i = 0; i < 4; ++i) { v0[i] *= __expf(r0[i] - c0[i]); v1[i] *= __expf(r1[i] - c1[i]); } }
                    else if (type == 3) {
#pragma unroll
                        for (int i = 0; i < 4; ++i) { v0[i] = fast_silu(v0[i]); v1[i] = fast_silu(v1[i]); } }
                    u32x4 w; w.x = pk2(v0[0], v0[1]); w.y = pk2(v0[2], v0[3]); w.z = pk2(v1[0], v1[1]); w.w = pk2(v1[2], v1[3]);
                    *(u32x4*)(base + (size_t)row * ldc + col) = w; } }
    }
};
struct EpiFoxIn {
    static constexpr bool PERM = true;
    bf16_t *Q, *Kb, *V, *G; const float *qg, *kg;
    __device__ __forceinline__ void operator()(AccRef acc, const Unit& u, int wr, int wc, int fr, int fq) const {
        const int row0 = u.pm * BM + wr * 64 + fr, type = u.pn >> 2;
        bf16_t* base = (type == 0) ? Q : (type == 1) ? Kb : (type == 2) ? V : G;
        const int colw = (u.pn & 3) * BM + 64 * wc + 8 * fq;
        f32x4 gn[2][2];
#pragma unroll
        for (int bj = 0; bj < 2; ++bj)
#pragma unroll
            for (int n = 0; n < 2; ++n) { const f32x4 gq = *(const f32x4*)(qg + 32 * bj + 8 * fq + 4 * n) * QSCALE, gk = *(const f32x4*)(kg + 32 * bj + 8 * fq + 4 * n);
                gn[bj][n] = (type == 0) ? gq : gk; }
#pragma unroll
        for (int ai = 0; ai < 2; ++ai)
#pragma unroll
            for (int m = 0; m < 4; ++m) { const int row = row0 + ai * HALF + m * 16; float rs = 1.f;
                if (type < 2) { float ss = 0.f;
#pragma unroll
                    for (int bj = 0; bj < 2; ++bj)
#pragma unroll
                        for (int n = 0; n < 2; ++n) { const f32x4 x = acc[ai][bj][m][n]; ss += (x[0] * x[0] + x[1] * x[1]) + (x[2] * x[2] + x[3] * x[3]); }
                    ss += __shfl_xor(ss, 16); ss += __shfl_xor(ss, 32);
                    rs = __builtin_amdgcn_rsqf(ss * (1.0f / 64.0f) + EPS); }
#pragma unroll
                for (int bj = 0; bj < 2; ++bj) { f32x4 v0 = acc[ai][bj][m][0], v1 = acc[ai][bj][m][1];
                    if (type < 2) { v0 = v0 * rs * gn[bj][0]; v1 = v1 * rs * gn[bj][1]; }
                    else if (type == 3) {
#pragma unroll
                        for (int i = 0; i < 4; ++i) { v0[i] = fast_sigmoid(v0[i]); v1[i] = fast_sigmoid(v1[i]); } }
                    u32x4 w; w.x = pk2(v0[0], v0[1]); w.y = pk2(v0[2], v0[3]); w.z = pk2(v1[0], v1[1]); w.w = pk2(v1[2], v1[3]);
                    *(u32x4*)(base + (size_t)row * D + colw + 32 * bj) = w; } }
    }
};
}

constexpr int RING_BYTES = 131072;
constexpr int LDS_TAB = 135168;
constexpr int LDS_MISC = LDS_TAB + 256;
constexpr int LDS_BYTES = 147456;

struct Args { const float* in[28]; float* out; unsigned char* ws; int ph_lo, ph_hi; };
enum { I_X = 0, I_C, I_ADA_W, I_ADA_B, I_GLA_WIN, I_GLA_WG2, I_GLA_BG, I_GLA_GN, I_GLA_WOUT, I_CONV_WIN, I_CONV_BIN, I_CONV_DW, I_CONV_DWB, I_CONV_LNG, I_CONV_LNB, I_CONV_WOUT, I_CONV_BOUT,
       I_FOX_WIN, I_FOX_BF, I_FOX_QN, I_FOX_KN, I_FOX_WOUT, I_FFN_W13, I_FFN_W2, I_MOE_R, I_MOE_W13, I_MOE_W2, I_NORMF };

__device__ __forceinline__ const float* karg_in(int i) {
    asm volatile("" : "+s"(i));
    const __attribute__((address_space(4))) char* ka = (const __attribute__((address_space(4))) char*)__builtin_amdgcn_kernarg_segment_ptr();
    return *(const float* const __attribute__((address_space(4)))*)(ka + 8 * i);
}
__device__ __forceinline__ int opq(int x) { asm volatile("" : "+s"(x)); return x; }
__device__ __forceinline__ unsigned char* karg_ws() {
    int i = 29; asm volatile("" : "+s"(i));
    const __attribute__((address_space(4))) char* ka = (const __attribute__((address_space(4))) char*)__builtin_amdgcn_kernarg_segment_ptr();
    return *(unsigned char* const __attribute__((address_space(4)))*)(ka + 8 * i);
}
template <int MODE, bool F8 = false>
__device__ __forceinline__ void tr_item(const float* W, int K, int pitch, int ncols, bf16_t* WT, LAS float* scr, int item, int lane, int hid, float f8scale = 1.0f) {
    constexpr int KD = F8 ? 128 : 64;
    const int nblk = ncols / 32, kb = item / nblk, nb = item % nblk, k0 = KD * kb, L0 = 32 * nb;
    int src0 = L0, dst0 = L0;
    if (MODE == 1) { if (L0 < hid) dst0 = 256 * (L0 / 128) + (L0 % 128); else { const int n = L0 - hid; dst0 = 256 * (n / 128) + 128 + (n % 128); } }
    if (MODE == 2) { src0 = (L0 < 3072) ? L0 : L0 + 16; const int tile = L0 / 256, within = L0 % 256, wc = within / 64, bj = (within % 64) / 32; dst0 = tile * 256 + 128 * bj + 32 * wc; }
#pragma unroll 8
    for (int i = 0; i < KD / 2; ++i) { const int kk = 2 * i + (lane >> 5); scr[kk * 33 + (lane & 31)] = W[(size_t)(k0 + kk) * pitch + src0 + (lane & 31)]; }
    asm volatile("s_waitcnt lgkmcnt(0)" ::: "memory");
    const int c = lane & 7;
#pragma unroll
    for (int j = 0; j < 4; ++j) { const int n = (lane >> 3) + 8 * j; const LAS float* s = scr + ((KD / 8) * c) * 33 + n;
        if constexpr (F8) { u32x4 o; o.x = pk4_fp8(s[0 * 33] * f8scale, s[1 * 33] * f8scale, s[2 * 33] * f8scale, s[3 * 33] * f8scale); o.y = pk4_fp8(s[4 * 33] * f8scale, s[5 * 33] * f8scale, s[6 * 33] * f8scale, s[7 * 33] * f8scale);
            o.z = pk4_fp8(s[8 * 33] * f8scale, s[9 * 33] * f8scale, s[10 * 33] * f8scale, s[11 * 33] * f8scale); o.w = pk4_fp8(s[12 * 33] * f8scale, s[13 * 33] * f8scale, s[14 * 33] * f8scale, s[15 * 33] * f8scale);
            *(u32x4*)((unsigned char*)WT + (size_t)(dst0 + n) * K + k0 + 16 * c) = o; }
        else { u32x4 o; o.x = pk2(s[0 * 33], s[1 * 33]); o.y = pk2(s[2 * 33], s[3 * 33]); o.z = pk2(s[4 * 33], s[5 * 33]); o.w = pk2(s[6 * 33], s[7 * 33]);
            *(u32x4*)(WT + (size_t)(dst0 + n) * K + k0 + 8 * c) = o; } }
    asm volatile("s_waitcnt lgkmcnt(0)" ::: "memory");
}

__device__ __forceinline__ void phase_prologue(LAS unsigned char* lds, const Args& a, int vcu, int G) {
    const int tid = opaque_tid(), lane = tid & 63, wave = __builtin_amdgcn_readfirstlane(tid >> 6);
    unsigned char* ws = a.ws;
    LAS float* cond = (LAS float*)lds;
    LAS float* part = (LAS float*)(lds + 32768);
    for (int i = tid; i < NB * D; i += NTHR) { const int b = i / D, k = i % D; const float v = karg_in(I_C)[i]; cond[k * 8 + b] = v * fast_sigmoid(v); }
    __syncthreads();
    float* mod = (float*)(ws + WS_MOD);
    for (int task = blockIdx.x; task < DEPTH * MOD_W / 32; task += G) {
        const int J0 = task * 32, L = J0 / MOD_W, j0 = J0 % MOD_W, col = lane & 31, kp = lane >> 5;
        const float* w = karg_in(I_ADA_W) + (size_t)L * D * MOD_W + j0 + col;
        float acc[8];
#pragma unroll
        for (int b = 0; b < 8; ++b) acc[b] = 0.f;
#pragma unroll 8
        for (int i = 0; i < 64; ++i) { const int k = wave * 128 + 2 * i + kp; const float wv = w[(size_t)k * MOD_W];
            const f32x4 c0 = *(const LAS f32x4*)(cond + k * 8), c1 = *(const LAS f32x4*)(cond + k * 8 + 4);
            acc[0] += wv * c0[0]; acc[1] += wv * c0[1]; acc[2] += wv * c0[2]; acc[3] += wv * c0[3]; acc[4] += wv * c1[0]; acc[5] += wv * c1[1]; acc[6] += wv * c1[2]; acc[7] += wv * c1[3]; }
#pragma unroll
        for (int b = 0; b < 8; ++b) acc[b] += __shfl_xor(acc[b], 32);
        if (kp == 0) {
#pragma unroll
            for (int b = 0; b < 8; ++b) part[(wave * 8 + b) * 32 + col] = acc[b]; }
        __syncthreads();
        if (tid < 256) { const int b = tid >> 5, cc = tid & 31; float s = karg_in(I_ADA_B)[L * MOD_W + j0 + cc];
#pragma unroll
            for (int w8 = 0; w8 < 8; ++w8) s += part[(w8 * 8 + b) * 32 + cc];
            mod[((size_t)L * NB + b) * MOD_W + j0 + cc] = s; }
        __syncthreads();
    }
    LAS float* scr = (LAS float*)(lds + wave * 16896);
    const int gw = vcu * NWAVES + wave, NGW = G * NWAVES;
    constexpr int IT_GLA_IN = (D / 64) * (3072 / 32), IT_SQ = (D / 64) * (D / 32), IT_CONV_IN = (D / (CONV_FP8 ? 128 : 64)) * (2048 / 32), IT_FOX_IN = (D / 64) * (4096 / 32);
    constexpr int IT_FFN13 = (D / (FFN_FP8 ? 128 : 64)) * (2 * DFF / 32), IT_FFN2 = (DFF / 64) * (D / 32), IT_MOE13 = (D / (MOE_FP8 ? 128 : 64)) * (2 * DFE / 32), IT_MOE2 = (DFE / (MOE_FP8 ? 128 : 64)) * (D / 32);
    constexpr int NITEMS = 2 * IT_GLA_IN + 2 * IT_SQ + IT_CONV_IN + IT_SQ + IT_FOX_IN + IT_SQ + 2 * IT_FFN13 + 2 * IT_FFN2 + 16 * IT_MOE13 + 16 * IT_MOE2;
    for (int it = gw; it < NITEMS; it += NGW) {
        int r = it;
        if (r < 2 * IT_GLA_IN) { const int j = r / IT_GLA_IN; r %= IT_GLA_IN; tr_item<0>(karg_in(I_GLA_WIN) + (size_t)j * D * GLA_IN, D, GLA_IN, 3072, (bf16_t*)(ws + W_GLA_IN + j * SZ_GLA_IN), scr, r, lane, 0); continue; } r -= 2 * IT_GLA_IN;
        if (r < 2 * IT_SQ) { const int j = r / IT_SQ; r %= IT_SQ; tr_item<0>(karg_in(I_GLA_WOUT) + (size_t)j * D * D, D, D, D, (bf16_t*)(ws + W_GLA_OUT + j * SZ_SQ), scr, r, lane, 0); continue; } r -= 2 * IT_SQ;
        if (r < IT_CONV_IN) { tr_item<1, CONV_FP8 != 0>(karg_in(I_CONV_WIN), D, 2048, 2048, (bf16_t*)(ws + W_CONV_IN), scr, r, lane, 1024, F8_W13); continue; } r -= IT_CONV_IN;
        if (r < IT_SQ) { tr_item<0>(karg_in(I_CONV_WOUT), D, D, D, (bf16_t*)(ws + W_CONV_OUT), scr, r, lane, 0); continue; } r -= IT_SQ;
        if (r < IT_FOX_IN) { tr_item<2>(karg_in(I_FOX_WIN), D, FOX_IN, 4096, (bf16_t*)(ws + W_FOX_IN), scr, r, lane, 0); continue; } r -= IT_FOX_IN;
        if (r < IT_SQ) { tr_item<0>(karg_in(I_FOX_WOUT), D, D, D, (bf16_t*)(ws + W_FOX_OUT), scr, r, lane, 0); continue; } r -= IT_SQ;
        if (r < 2 * IT_FFN13) { const int j = r / IT_FFN13; r %= IT_FFN13; tr_item<1, FFN_FP8 != 0>(karg_in(I_FFN_W13) + (size_t)j * D * 2 * DFF, D, 2 * DFF, 2 * DFF, (bf16_t*)(ws + W_FFN13 + j * SZ_FFN13), scr, r, lane, DFF, F8_W13); continue; } r -= 2 * IT_FFN13;
        if (r < 2 * IT_FFN2) { const int j = r / IT_FFN2; r %= IT_FFN2; tr_item<0>(karg_in(I_FFN_W2) + (size_t)j * DFF * D, DFF, D, D, (bf16_t*)(ws + W_FFN2 + j * SZ_FFN2), scr, r, lane, 0); continue; } r -= 2 * IT_FFN2;
        if (r < 16 * IT_MOE13) { const int j = r / IT_MOE13; r %= IT_MOE13; tr_item<1, MOE_FP8 != 0>(karg_in(I_MOE_W13) + (size_t)j * D * 2 * DFE, D, 2 * DFE, 2 * DFE, (bf16_t*)(ws + W_MOE13 + j * MOE13_STRIDE), scr, r, lane, DFE, F8_W13); continue; } r -= 16 * IT_MOE13;
        { const int j = r / IT_MOE2; r %= IT_MOE2; tr_item<0, MOE_FP8 != 0>(karg_in(I_MOE_W2) + (size_t)j * DFE * D, DFE, D, D, (bf16_t*)(ws + W_MOE2 + j * MOE2_STRIDE), scr, r, lane, 0, F8_W2); }
    }
}

struct NormArgs {
    const float* xin; float* xout; bf16_t* H; const float* sc; const float* sh;
    int combine; const bf16_t* Y; const u32x4* tinfo; const float* g2p; const unsigned* cntp;
    const float* wx; int wx_pitch; float cscale;
    const float* w2; const float* bvec;
    float* Dk; float* dref; float* etot; float* lf;
    int* tok; u32x4* tinfo_out; unsigned* cnt;
    const float* gamma; float* out;
};
template <int VAR>
__device__ __forceinline__ void norm_phase(LAS unsigned char* lds, const NormArgs& a, int G) {
    const int tid = opaque_tid(), lane = tid & 63, wave = __builtin_amdgcn_readfirstlane(tid >> 6);
    constexpr int NX = (VAR == 1 || VAR == 2) ? 16 : (VAR == 3) ? 8 : 0;
    LAS float* WX = (LAS float*)lds;
    LAS float* W2 = (LAS float*)(lds + 65536);
    LAS float* BG = (LAS float*)(lds + 98304);
    LAS float* TOTW = (LAS float*)(lds + 100352);
    LAS int* SEL_E = (LAS int*)(lds + 65536);
    LAS float* SEL_G = (LAS float*)(lds + 65536 + 512);
    LAS int* BASE = (LAS int*)(lds + 65536 + 1024);
    LAS int* TAB = (LAS int*)(lds + LDS_TAB);
    if constexpr (NX > 0) {
        for (int idx = tid; idx < D * NX; idx += NTHR) { const int k = idx / NX, n = idx % NX; const float v = a.wx[(size_t)k * a.wx_pitch + n];
            const int l = (k & 255) >> 2, j = k >> 8, i = k & 3; WX[((((j * 4 + i) * (NX / 4) + (n >> 2)) * 64 + l) << 2) + (n & 3)] = v; }
    }
    if (VAR == 1) { for (int idx = tid; idx < 16 * 512; idx += NTHR) W2[idx] = a.w2[idx]; for (int idx = tid; idx < 512; idx += NTHR) BG[idx] = a.bvec[idx]; }
    if (a.combine && tid == 0) { int s = 0; for (int e = 0; e < NE; ++e) { TAB[e] = s; s += ((int)a.cntp[e] + 255) >> 8; } TAB[8] = s; }
    __syncthreads();
    for (int g = blockIdx.x; g < NTOK / 64; g += G) {
        const int b = g / (SEQ / 64);
        f32x4 scv[4], shv[4], g2v[4], gmv[4];
#pragma unroll
        for (int j = 0; j < 4; ++j) {
            if (VAR != 4) { scv[j] = *(const f32x4*)(a.sc + (size_t)b * MOD_W + 4 * lane + 256 * j) + 1.0f; shv[j] = *(const f32x4*)(a.sh + (size_t)b * MOD_W + 4 * lane + 256 * j); }
            else gmv[j] = *(const f32x4*)(a.gamma + 4 * lane + 256 * j);
            if (a.combine) g2v[j] = *(const f32x4*)(a.g2p + (size_t)b * MOD_W + 4 * lane + 256 * j) * a.cscale; }
        float run[8];
        if (VAR == 1) {
#pragma unroll
            for (int c = 0; c < 8; ++c) run[c] = 0.f; }
        const bf16_t* xin16 = (const bf16_t*)a.xin; bf16_t* xout16 = (bf16_t*)a.xout;
        u32x2 xn[4];
#pragma unroll
        for (int j = 0; j < 4; ++j) xn[j] = *(const u32x2*)(xin16 + (size_t)(g * 64 + wave * 8) * D + 4 * lane + 256 * j);
#pragma unroll 1
        for (int r = 0; r < 8; ++r) {
            const int row = g * 64 + wave * 8 + r;
            f32x4 x[4];
#pragma unroll
            for (int j = 0; j < 4; ++j) x[j] = (f32x4){bf_lo(xn[j].x), bf_hi(xn[j].x), bf_lo(xn[j].y), bf_hi(xn[j].y)};
            if (r < 7) {
#pragma unroll
                for (int j = 0; j < 4; ++j) xn[j] = *(const u32x2*)(xin16 + (size_t)(row + 1) * D + 4 * lane + 256 * j); }
            if (a.combine) {
                const u32x4 ti = a.tinfo[row];
                const int e0 = ti.x >> 15, e1 = ti.y >> 15; const size_t r0 = (size_t)TAB[e0] * 256 + (ti.x & 32767u), r1 = (size_t)TAB[e1] * 256 + (ti.y & 32767u);
                const float ga = __uint_as_float(ti.z), gb = __uint_as_float(ti.w);
#pragma unroll
                for (int j = 0; j < 4; ++j) { const u32x2 y0 = *(const u32x2*)(a.Y + r0 * D + 4 * lane + 256 * j), y1 = *(const u32x2*)(a.Y + r1 * D + 4 * lane + 256 * j);
                    f32x4 m; m[0] = ga * bf_lo(y0.x) + gb * bf_lo(y1.x); m[1] = ga * bf_hi(y0.x) + gb * bf_hi(y1.x); m[2] = ga * bf_lo(y0.y) + gb * bf_lo(y1.y); m[3] = ga * bf_hi(y0.y) + gb * bf_hi(y1.y);
                    x[j] = x[j] + g2v[j] * m; if (VAR != 4) { u32x2 xw; xw.x = pk2(x[j][0], x[j][1]); xw.y = pk2(x[j][2], x[j][3]); *(u32x2*)(xout16 + (size_t)row * D + 4 * lane + 256 * j) = xw; } }
            }
            float ss = 0.f;
#pragma unroll
            for (int j = 0; j < 4; ++j) ss += (x[j][0] * x[j][0] + x[j][1] * x[j][1]) + (x[j][2] * x[j][2] + x[j][3] * x[j][3]);
            const float rstd = __builtin_amdgcn_rsqf(wave_sum(ss) * (1.0f / D) + EPS);
            if (VAR == 4) {
#pragma unroll
                for (int j = 0; j < 4; ++j) *(f32x4*)(a.out + (size_t)row * D + 4 * lane + 256 * j) = x[j] * rstd * gmv[j];
                continue;
            }
            f32x4 h[4];
#pragma unroll
            for (int j = 0; j < 4; ++j) { h[j] = x[j] * rstd * scv[j] + shv[j];
                if ((VAR == 3 && MOE_FP8) || (VAR == 0 && a.wx_pitch < 0)) {        *(unsigned*)((unsigned char*)a.H + (size_t)row * D + 4 * lane + 256 * j) = pk4_fp8(h[j][0], h[j][1], h[j][2], h[j][3]); }
                else { u32x2 w; w.x = pk2(h[j][0], h[j][1]); w.y = pk2(h[j][2], h[j][3]); *(u32x2*)(a.H + (size_t)row * D + 4 * lane + 256 * j) = w; } }
            if constexpr (NX > 0) {
                float p[NX];
#pragma unroll
                for (int n = 0; n < NX; ++n) p[n] = 0.f;
#pragma unroll
                for (int j = 0; j < 4; ++j)
#pragma unroll
                    for (int i = 0; i < 4; ++i)
                    {
#pragma unroll
                        for (int n4 = 0; n4 < NX / 4; ++n4) { const f32x4 w = *(const LAS f32x4*)(WX + ((((j * 4 + i) * (NX / 4) + n4) * 64 + lane) << 2));
                            p[4 * n4 + 0] += h[j][i] * w[0]; p[4 * n4 + 1] += h[j][i] * w[1]; p[4 * n4 + 2] += h[j][i] * w[2]; p[4 * n4 + 3] += h[j][i] * w[3]; }
                        if (i & 1) { if constexpr (NX == 16) asm volatile("" : "+v"(p[0]), "+v"(p[1]), "+v"(p[2]), "+v"(p[3]), "+v"(p[4]), "+v"(p[5]), "+v"(p[6]), "+v"(p[7]), "+v"(p[8]), "+v"(p[9]), "+v"(p[10]), "+v"(p[11]), "+v"(p[12]), "+v"(p[13]), "+v"(p[14]), "+v"(p[15]) :: "memory");
                            else asm volatile("" : "+v"(p[0]), "+v"(p[1]), "+v"(p[2]), "+v"(p[3]), "+v"(p[4]), "+v"(p[5]), "+v"(p[6]), "+v"(p[7]) :: "memory");
                            __builtin_amdgcn_sched_barrier(0); } }
                xreduce<NX>(p, lane);
                const float red = p[0];
                if (VAR == 1) {
                    float gl[16];
#pragma unroll
                    for (int n = 0; n < 16; ++n) gl[n] = __uint_as_float(__builtin_amdgcn_readlane(__float_as_uint(red), 4 * n));
#pragma unroll
                    for (int jj = 0; jj < 2; ++jj) { f32x4 z = *(const LAS f32x4*)(BG + 256 * jj + 4 * lane);
#pragma unroll
                        for (int n = 0; n < 16; ++n) { z = z + gl[n] * *(const LAS f32x4*)(W2 + n * 512 + 256 * jj + 4 * lane); if ((n & 3) == 3) { asm volatile("" : "+v"(z) :: "memory"); __builtin_amdgcn_sched_barrier(0); } }
#pragma unroll
                        for (int i = 0; i < 4; ++i) run[4 * jj + i] += log_sigmoid(z[i]) * (1.0f / 16.0f);
                        *(f32x4*)(a.Dk + (size_t)row * 512 + 256 * jj + 4 * lane) = (f32x4){run[4 * jj], run[4 * jj + 1], run[4 * jj + 2], run[4 * jj + 3]}; }
                }
                if (VAR == 2) { if ((lane & 3) == 0) { const int n = lane >> 2; a.lf[(size_t)row * 16 + n] = log_sigmoid(red + a.bvec[n]); } }
                if (VAR == 3) {
                    float lg[8];
#pragma unroll
                    for (int n = 0; n < 8; ++n) lg[n] = __uint_as_float(__builtin_amdgcn_readlane(__float_as_uint(red), 8 * n));
                    int e0 = 0; float l0 = lg[0];
#pragma unroll
                    for (int n = 1; n < 8; ++n) if (lg[n] > l0) { l0 = lg[n]; e0 = n; }
                    int e1 = -1; float l1 = -3.0e38f;
#pragma unroll
                    for (int n = 0; n < 8; ++n) if (n != e0 && lg[n] > l1) { l1 = lg[n]; e1 = n; }
                    const float g0 = 1.0f / (1.0f + __expf(l1 - l0));
                    if (lane == 0) { const int lr = wave * 8 + r; SEL_E[lr * 2] = e0; SEL_E[lr * 2 + 1] = e1; SEL_G[lr * 2] = g0; SEL_G[lr * 2 + 1] = 1.0f - g0; }
                }
            }
            FENCE();
        }
        if (VAR == 1) {
#pragma unroll
            for (int jj = 0; jj < 2; ++jj) { f32x4 t; t[0] = run[4 * jj]; t[1] = run[4 * jj + 1]; t[2] = run[4 * jj + 2]; t[3] = run[4 * jj + 3]; *(LAS f32x4*)(TOTW + wave * 512 + 256 * jj + 4 * lane) = t; }
            __syncthreads();
#pragma unroll
            for (int jj = 0; jj < 2; ++jj) { f32x4 off = (f32x4){0.f, 0.f, 0.f, 0.f}, tot = (f32x4){0.f, 0.f, 0.f, 0.f};
#pragma unroll
                for (int w8 = 0; w8 < 8; ++w8) { const f32x4 t = *(const LAS f32x4*)(TOTW + w8 * 512 + 256 * jj + 4 * lane); tot = tot + t; if (w8 < wave) off = off + t; }
                *(f32x4*)(a.dref + ((size_t)g * 8 + wave) * 512 + 256 * jj + 4 * lane) = tot - off;
                if (wave == 0) { f32x4 e;
#pragma unroll
                    for (int i = 0; i < 4; ++i) e[i] = __expf(tot[i]);
                    *(f32x4*)(a.etot + (size_t)g * 512 + 256 * jj + 4 * lane) = e; } }
            __syncthreads();
        }
        if (VAR == 3) {
            __syncthreads();
            if (tid < NE) { int c = 0; for (int q = 0; q < 128; ++q) c += (SEL_E[q] == tid) ? 1 : 0; BASE[tid] = c ? (int)atomicAdd(a.cnt + tid, (unsigned)c) : 0; }
            __syncthreads();
            if (tid < 128) { const int e = SEL_E[tid]; int pos = BASE[e]; for (int q = 0; q < tid; ++q) pos += (SEL_E[q] == e) ? 1 : 0;
                const int row = g * 64 + (tid >> 1); a.tok[e * MOE_CAP + pos] = row;
                unsigned* ti = (unsigned*)(a.tinfo_out + row); ti[tid & 1] = (unsigned)(e * MOE_CAP + pos); ti[2 + (tid & 1)] = __float_as_uint(SEL_G[tid]); }
            __syncthreads();
        }
    }
}


template <int VAR>
__device__ __forceinline__ void norm_mfma(LAS unsigned char* lds, const NormArgs& a, int G) {
    const int tid = opaque_tid(), lane = tid & 63, wave = __builtin_amdgcn_readfirstlane(tid >> 6), r = lane & 15, g = lane >> 4;
    constexpr int NXv = (VAR == 3) ? 8 : 16, WP = 1032;
    LAS bf16_t* WT = (LAS bf16_t*)lds; LAS bf16_t* WTL = (LAS bf16_t*)(lds + 33024);
    LAS float* SC = (LAS float*)(lds + 66048); LAS float* SH = SC + 1024; LAS float* G2 = SH + 1024;
    LAS bf16_t* W2T = (LAS bf16_t*)(lds + 78336); LAS float* BG = (LAS float*)(lds + 94720); LAS float* GL = (LAS float*)(lds + 96768); LAS float* TOT = (LAS float*)(lds + 105472);
    LAS float* LG = (LAS float*)(lds + 78336); LAS int* SEL_E = (LAS int*)(lds + 82432); LAS float* SEL_G = (LAS float*)(lds + 83456); LAS int* BASE = (LAS int*)(lds + 84480);
    LAS int* TAB = (LAS int*)(lds + LDS_TAB);
    for (int idx = tid; idx < D * 16; idx += NTHR) { const int k = idx >> 4, n = idx & 15; const float v = (n < NXv) ? a.wx[(size_t)k * a.wx_pitch + n] : 0.f;
        const unsigned hi = pk2(v, 0.f) & 0xffffu; WT[n * WP + k] = (bf16_t)hi;
        if (VAR == 3) WTL[n * WP + k] = (bf16_t)(pk2(v - __uint_as_float(hi << 16), 0.f) & 0xffffu); }
    if (VAR == 1) { for (int idx = tid; idx < 16 * 512; idx += NTHR) { const int rr = idx >> 9, col = idx & 511; W2T[col * 16 + rr] = (bf16_t)(pk2(a.w2[idx], 0.f) & 0xffffu); }
        for (int idx = tid; idx < 512; idx += NTHR) BG[idx] = a.bvec[idx]; }
    if (a.combine && tid == 0) { int sx = 0; for (int e = 0; e < NE; ++e) { TAB[e] = sx; sx += ((int)a.cntp[e] + 255) >> 8; } TAB[8] = sx; }
    for (int rb = blockIdx.x; rb < NTOK / 128; rb += G) {
        const int b = rb / (SEQ / 128), row = rb * 128 + wave * 16 + r;
        __syncthreads();
        for (int k = tid; k < D; k += NTHR) { SC[k] = a.sc[(size_t)b * MOD_W + k] + 1.0f; SH[k] = a.sh[(size_t)b * MOD_W + k]; if (a.combine) G2[k] = a.g2p[(size_t)b * MOD_W + k] * a.cscale; }
        __syncthreads();
        const float* xr = a.xin + (size_t)row * D + 8 * g; float* xw = a.xout + (size_t)row * D + 8 * g;
        float ss = 0.f;
        if (a.combine) {
            const u32x4 ti = a.tinfo[row];
            const size_t r0 = (size_t)TAB[ti.x >> 15] * 256 + (ti.x & 32767u), r1 = (size_t)TAB[ti.y >> 15] * 256 + (ti.y & 32767u);
            const float ga = __uint_as_float(ti.z), gb = __uint_as_float(ti.w);
            const bf16_t* y0p = a.Y + r0 * D + 8 * g; const bf16_t* y1p = a.Y + r1 * D + 8 * g;
#pragma unroll 4
            for (int sK = 0; sK < 32; ++sK) { f32x4 x0 = *(const f32x4*)(xr + 32 * sK), x1 = *(const f32x4*)(xr + 32 * sK + 4);
                const u32x4 y0 = *(const u32x4*)(y0p + 32 * sK), y1 = *(const u32x4*)(y1p + 32 * sK);
                const f32x4 g0 = *(const LAS f32x4*)(G2 + 32 * sK + 8 * g), g1 = *(const LAS f32x4*)(G2 + 32 * sK + 8 * g + 4);
                f32x4 m0, m1; m0[0] = ga * bf_lo(y0.x) + gb * bf_lo(y1.x); m0[1] = ga * bf_hi(y0.x) + gb * bf_hi(y1.x); m0[2] = ga * bf_lo(y0.y) + gb * bf_lo(y1.y); m0[3] = ga * bf_hi(y0.y) + gb * bf_hi(y1.y);
                m1[0] = ga * bf_lo(y0.z) + gb * bf_lo(y1.z); m1[1] = ga * bf_hi(y0.z) + gb * bf_hi(y1.z); m1[2] = ga * bf_lo(y0.w) + gb * bf_lo(y1.w); m1[3] = ga * bf_hi(y0.w) + gb * bf_hi(y1.w);
                x0 = x0 + g0 * m0; x1 = x1 + g1 * m1; *(f32x4*)(xw + 32 * sK) = x0; *(f32x4*)(xw + 32 * sK + 4) = x1;
                ss += (x0[0] * x0[0] + x0[1] * x0[1]) + (x0[2] * x0[2] + x0[3] * x0[3]) + (x1[0] * x1[0] + x1[1] * x1[1]) + (x1[2] * x1[2] + x1[3] * x1[3]); }
        } else {
#pragma unroll 8
            for (int sK = 0; sK < 32; ++sK) { const f32x4 x0 = *(const f32x4*)(xr + 32 * sK), x1 = *(const f32x4*)(xr + 32 * sK + 4);
                ss += (x0[0] * x0[0] + x0[1] * x0[1]) + (x0[2] * x0[2] + x0[3] * x0[3]) + (x1[0] * x1[0] + x1[1] * x1[1]) + (x1[2] * x1[2] + x1[3] * x1[3]); }
        }
        ss += __shfl_xor(ss, 16); ss += __shfl_xor(ss, 32);
        const float rstd = __builtin_amdgcn_rsqf(ss * (1.0f / D) + EPS);
        const float* x2 = (a.combine ? (const float*)a.xout : a.xin) + (size_t)row * D + 8 * g;
        f32x4 acc = (f32x4){0.f, 0.f, 0.f, 0.f};
#pragma unroll 4
        for (int sK = 0; sK < 32; ++sK) { const f32x4 x0 = *(const f32x4*)(x2 + 32 * sK), x1 = *(const f32x4*)(x2 + 32 * sK + 4);
            const f32x4 c0 = *(const LAS f32x4*)(SC + 32 * sK + 8 * g), c1 = *(const LAS f32x4*)(SC + 32 * sK + 8 * g + 4), s0 = *(const LAS f32x4*)(SH + 32 * sK + 8 * g), s1 = *(const LAS f32x4*)(SH + 32 * sK + 8 * g + 4);
            const f32x4 h0 = x0 * rstd * c0 + s0, h1 = x1 * rstd * c1 + s1;
            u32x4 hw; hw.x = pk2(h0[0], h0[1]); hw.y = pk2(h0[2], h0[3]); hw.z = pk2(h1[0], h1[1]); hw.w = pk2(h1[2], h1[3]);
            if (VAR == 3 && MOE_FP8) { u32x2 w8; w8.x = pk4_fp8(h0[0], h0[1], h0[2], h0[3]); w8.y = pk4_fp8(h1[0], h1[1], h1[2], h1[3]); *(u32x2*)((unsigned char*)a.H + (size_t)row * D + 32 * sK + 8 * g) = w8; }
            else *(u32x4*)(a.H + (size_t)row * D + 32 * sK + 8 * g) = hw;
            const bf16x8 af = __builtin_bit_cast(bf16x8, hw), bw = *(const LAS bf16x8*)(WT + r * WP + 32 * sK + 8 * g);
            acc = __builtin_amdgcn_mfma_f32_16x16x32_bf16(af, bw, acc, 0, 0, 0);
            if (VAR == 3) {
                u32x4 lw; lw.x = pk2(h0[0] - bf_lo(hw.x), h0[1] - bf_hi(hw.x)); lw.y = pk2(h0[2] - bf_lo(hw.y), h0[3] - bf_hi(hw.y)); lw.z = pk2(h1[0] - bf_lo(hw.z), h1[1] - bf_hi(hw.z)); lw.w = pk2(h1[2] - bf_lo(hw.w), h1[3] - bf_hi(hw.w));
                const bf16x8 bl = *(const LAS bf16x8*)(WTL + r * WP + 32 * sK + 8 * g);
                acc = __builtin_amdgcn_mfma_f32_16x16x32_bf16(__builtin_bit_cast(bf16x8, lw), bw, acc, 0, 0, 0);
                acc = __builtin_amdgcn_mfma_f32_16x16x32_bf16(af, bl, acc, 0, 0, 0); } }
        const int grow0 = rb * 128 + wave * 16;
        if (VAR == 2) {
            const float bfv = a.bvec[r];
#pragma unroll
            for (int i = 0; i < 4; ++i) a.lf[(size_t)(grow0 + 4 * g + i) * 16 + r] = log_sigmoid(acc[i] + bfv);
        }
        if (VAR == 3) {
            if (r < 8) {
#pragma unroll
                for (int i = 0; i < 4; ++i) LG[(wave * 16 + 4 * g + i) * 8 + r] = acc[i]; }
            asm volatile("s_waitcnt lgkmcnt(0)" ::: "memory");
            if (lane < 16) { const int lr = wave * 16 + lane; float lg[8];
                const f32x4 la = *(const LAS f32x4*)(LG + lr * 8), lb = *(const LAS f32x4*)(LG + lr * 8 + 4);
                lg[0] = la[0]; lg[1] = la[1]; lg[2] = la[2]; lg[3] = la[3]; lg[4] = lb[0]; lg[5] = lb[1]; lg[6] = lb[2]; lg[7] = lb[3];
                int e0 = 0; float l0 = lg[0];
#pragma unroll
                for (int n = 1; n < 8; ++n) { const bool up = lg[n] > l0; l0 = up ? lg[n] : l0; e0 = up ? n : e0; }
                int e1 = 0; float l1 = -3.0e38f;
#pragma unroll
                for (int n = 0; n < 8; ++n) { const bool up = (n != e0) && (lg[n] > l1); l1 = up ? lg[n] : l1; e1 = up ? n : e1; }
                const float g0 = 1.0f / (1.0f + __expf(l1 - l0));
                SEL_E[lr * 2] = e0; SEL_E[lr * 2 + 1] = e1; SEL_G[lr * 2] = g0; SEL_G[lr * 2 + 1] = 1.0f - g0; }
            __syncthreads();
            if (tid < NE) { int c = 0; for (int q = 0; q < 256; ++q) c += (SEL_E[q] == tid) ? 1 : 0; BASE[tid] = c ? (int)atomicAdd(a.cnt + tid, (unsigned)c) : 0; }
            __syncthreads();
            if (tid < 256) { const int e = SEL_E[tid]; int pos = BASE[e]; for (int q = 0; q < tid; ++q) pos += (SEL_E[q] == e) ? 1 : 0;
                const int trow = rb * 128 + (tid >> 1); a.tok[e * MOE_CAP + pos] = trow;
                unsigned* ti = (unsigned*)(a.tinfo_out + trow); ti[tid & 1] = (unsigned)(e * MOE_CAP + pos); ti[2 + (tid & 1)] = __float_as_uint(SEL_G[tid]); }
        }
        if (VAR == 1) {
            LAS float* GLw = GL + wave * (16 * 17);
#pragma unroll
            for (int i = 0; i < 4; ++i) GLw[(4 * g + i) * 17 + r] = acc[i];
            asm volatile("s_waitcnt lgkmcnt(0)" ::: "memory");
            bf16x8 bg8; { float t[8];
#pragma unroll
                for (int j = 0; j < 8; ++j) t[j] = (g < 2) ? GLw[r * 17 + 8 * (g & 1) + j] : 0.f;
                u32x4 tw; tw.x = pk2(t[0], t[1]); tw.y = pk2(t[2], t[3]); tw.z = pk2(t[4], t[5]); tw.w = pk2(t[6], t[7]); bg8 = __builtin_bit_cast(bf16x8, tw); }
#pragma unroll 2
            for (int cb = 0; cb < 32; ++cb) {
                u32x4 aw = *(const LAS u32x4*)(W2T + (16 * cb + r) * 16 + 8 * (g & 1)); if (g >= 2) aw = (u32x4){0u, 0u, 0u, 0u};
                const f32x4 z = __builtin_amdgcn_mfma_f32_16x16x32_bf16(__builtin_bit_cast(bf16x8, aw), bg8, (f32x4){0.f, 0.f, 0.f, 0.f}, 0, 0, 0);
                const f32x4 bgv = *(const LAS f32x4*)(BG + 16 * cb + 4 * g);
                f32x4 la;
#pragma unroll
                for (int i = 0; i < 4; ++i) la[i] = log_sigmoid(z[i] + bgv[i]) * (1.0f / 16.0f);
#pragma unroll
                for (int off = 1; off < 16; off <<= 1) {
#pragma unroll
                    for (int i = 0; i < 4; ++i) { const float t = __shfl_up(la[i], off, 16); la[i] += (r >= off) ? t : 0.f; } }
                *(f32x4*)(a.Dk + (size_t)row * 512 + 16 * cb + 4 * g) = la;
                if (r == 15) *(LAS f32x4*)(TOT + wave * 512 + 16 * cb + 4 * g) = la;
            }
            __syncthreads();
            const int w0 = wave & ~3;
#pragma unroll
            for (int j = 0; j < 8; ++j) { const int c = lane + 64 * j; float tot = 0.f, off = 0.f;
#pragma unroll
                for (int w4 = 0; w4 < 4; ++w4) { const float t = TOT[(w0 + w4) * 512 + c]; tot += t; off += (w0 + w4 < wave) ? t : 0.f; }
                a.dref[((size_t)rb * 8 + wave) * 512 + c] = tot - off;
                if ((wave & 3) == 0) a.etot[((size_t)rb * 2 + (wave >> 2)) * 512 + c] = __expf(tot); }
        }
    }
}


template <int VAR, bool XF32 = false>
__device__ __forceinline__ void norm_mfma2(LAS unsigned char* lds, const NormArgs& a, int G) {
    const int tid = opaque_tid(), lane = tid & 63, wave = __builtin_amdgcn_readfirstlane(tid >> 6), r = lane & 15, g = lane >> 4;
    constexpr int NXv = (VAR == 3) ? 8 : 16, WP = 1032;
    LAS bf16_t* WT = (LAS bf16_t*)lds; LAS bf16_t* WTL = (LAS bf16_t*)(lds + 33024);
    LAS float* SC = (LAS float*)(lds + 66048); LAS float* SH = SC + 1024; LAS float* G2 = SH + 1024;
    LAS bf16_t* W2T = (LAS bf16_t*)(lds + 78336); LAS float* BG = (LAS float*)(lds + 94720); LAS float* TOT = (LAS float*)(lds + 96768);
    LAS float* PS = (LAS float*)(lds + 113152);
    LAS float* PA = (LAS float*)(lds + 113664);
    LAS float* OUTS = (LAS float*)(lds + 121856);
    LAS int* SEL_E = (LAS int*)(lds + 123008); LAS float* SEL_G = (LAS float*)(lds + 124032); LAS int* BASE = (LAS int*)(lds + 125056);
    LAS int* TAB = (LAS int*)(lds + LDS_TAB);
    for (int idx = tid; idx < D * 16; idx += NTHR) { const int k = idx >> 4, n = idx & 15; const float v = (n < NXv) ? a.wx[(size_t)k * a.wx_pitch + n] : 0.f;
        const unsigned hi = pk2(v, 0.f) & 0xffffu; WT[n * WP + k] = (bf16_t)hi;
        if (VAR == 3) WTL[n * WP + k] = (bf16_t)(pk2(v - __uint_as_float(hi << 16), 0.f) & 0xffffu); }
    if (VAR == 1) { for (int idx = tid; idx < 16 * 512; idx += NTHR) { const int rr = idx >> 9, col = idx & 511; W2T[col * 16 + rr] = (bf16_t)(pk2(a.w2[idx], 0.f) & 0xffffu); }
        for (int idx = tid; idx < 512; idx += NTHR) BG[idx] = a.bvec[idx]; }
    if (a.combine && tid == 0) { int sx = 0; for (int e = 0; e < NE; ++e) { TAB[e] = sx; sx += ((int)a.cntp[e] + 255) >> 8; } TAB[8] = sx; }
    const int kw = 128 * wave + 8 * g;
    for (int rb = blockIdx.x; rb < NTOK / 128; rb += G) {
        const int b = rb / (SEQ / 128);
        __syncthreads();
        for (int k = tid; k < D; k += NTHR) { SC[k] = a.sc[(size_t)b * MOD_W + k] + 1.0f; SH[k] = a.sh[(size_t)b * MOD_W + k]; if (a.combine) G2[k] = a.g2p[(size_t)b * MOD_W + k] * a.cscale; }
        __syncthreads();
        f32x4 xa[4][2]; u32x4 xb[4];
#define NM2_LOAD(ROW) do { if constexpr (XF32) { const float* xr = a.xin + (size_t)(ROW) * D + kw; \
            _Pragma("unroll") for (int sK = 0; sK < 4; ++sK) { xa[sK][0] = *(const f32x4*)(xr + 32 * sK); xa[sK][1] = *(const f32x4*)(xr + 32 * sK + 4); } } \
        else { const bf16_t* xr = (const bf16_t*)a.xin + (size_t)(ROW) * D + kw; \
            _Pragma("unroll") for (int sK = 0; sK < 4; ++sK) xb[sK] = *(const u32x4*)(xr + 32 * sK); } } while (0)
        NM2_LOAD(rb * 128 + r);
#pragma unroll 1
        for (int gi = 0; gi < 8; ++gi) {
            const int row = rb * 128 + gi * 16 + r;
            f32x4 x[4][2];
#pragma unroll
            for (int sK = 0; sK < 4; ++sK) { if constexpr (XF32) { x[sK][0] = xa[sK][0]; x[sK][1] = xa[sK][1]; }
                else { x[sK][0] = (f32x4){bf_lo(xb[sK].x), bf_hi(xb[sK].x), bf_lo(xb[sK].y), bf_hi(xb[sK].y)}; x[sK][1] = (f32x4){bf_lo(xb[sK].z), bf_hi(xb[sK].z), bf_lo(xb[sK].w), bf_hi(xb[sK].w)}; } }
            if (gi < 7) NM2_LOAD(row + 16);
            if (a.combine) {
                const u32x4 ti = a.tinfo[row];
                const size_t r0 = (size_t)TAB[ti.x >> 15] * 256 + (ti.x & 32767u), r1 = (size_t)TAB[ti.y >> 15] * 256 + (ti.y & 32767u);
                const float ga = __uint_as_float(ti.z), gb = __uint_as_float(ti.w);
                const bf16_t* y0p = a.Y + r0 * D + kw; const bf16_t* y1p = a.Y + r1 * D + kw; bf16_t* xw = (bf16_t*)a.xout + (size_t)row * D + kw;
#pragma unroll
                for (int sK = 0; sK < 4; ++sK) { const u32x4 y0 = *(const u32x4*)(y0p + 32 * sK), y1 = *(const u32x4*)(y1p + 32 * sK);
                    const f32x4 g0 = *(const LAS f32x4*)(G2 + kw + 32 * sK), g1 = *(const LAS f32x4*)(G2 + kw + 32 * sK + 4);
                    f32x4 m0, m1; m0[0] = ga * bf_lo(y0.x) + gb * bf_lo(y1.x); m0[1] = ga * bf_hi(y0.x) + gb * bf_hi(y1.x); m0[2] = ga * bf_lo(y0.y) + gb * bf_lo(y1.y); m0[3] = ga * bf_hi(y0.y) + gb * bf_hi(y1.y);
                    m1[0] = ga * bf_lo(y0.z) + gb * bf_lo(y1.z); m1[1] = ga * bf_hi(y0.z) + gb * bf_hi(y1.z); m1[2] = ga * bf_lo(y0.w) + gb * bf_lo(y1.w); m1[3] = ga * bf_hi(y0.w) + gb * bf_hi(y1.w);
                    x[sK][0] = x[sK][0] + g0 * m0; x[sK][1] = x[sK][1] + g1 * m1;
                    u32x4 xs; xs.x = pk2(x[sK][0][0], x[sK][0][1]); xs.y = pk2(x[sK][0][2], x[sK][0][3]); xs.z = pk2(x[sK][1][0], x[sK][1][1]); xs.w = pk2(x[sK][1][2], x[sK][1][3]); *(u32x4*)(xw + 32 * sK) = xs; }
            }
            float ss = 0.f;
#pragma unroll
            for (int sK = 0; sK < 4; ++sK) { const f32x4 x0 = x[sK][0], x1 = x[sK][1];
                ss += (x0[0] * x0[0] + x0[1] * x0[1]) + (x0[2] * x0[2] + x0[3] * x0[3]) + (x1[0] * x1[0] + x1[1] * x1[1]) + (x1[2] * x1[2] + x1[3] * x1[3]); }
            ss += __shfl_xor(ss, 16); ss += __shfl_xor(ss, 32);
            if (g == 0) PS[wave * 16 + r] = ss;
            __syncthreads();
            float st = 0.f;
#pragma unroll
            for (int w8 = 0; w8 < 8; ++w8) st += PS[w8 * 16 + r];
            const float rstd = __builtin_amdgcn_rsqf(st * (1.0f / D) + EPS);
            f32x4 acc = (f32x4){0.f, 0.f, 0.f, 0.f};
#pragma unroll
            for (int sK = 0; sK < 4; ++sK) {
                const f32x4 c0 = *(const LAS f32x4*)(SC + kw + 32 * sK), c1 = *(const LAS f32x4*)(SC + kw + 32 * sK + 4), s0 = *(const LAS f32x4*)(SH + kw + 32 * sK), s1 = *(const LAS f32x4*)(SH + kw + 32 * sK + 4);
                const f32x4 h0 = x[sK][0] * rstd * c0 + s0, h1 = x[sK][1] * rstd * c1 + s1;
                u32x4 hw; hw.x = pk2(h0[0], h0[1]); hw.y = pk2(h0[2], h0[3]); hw.z = pk2(h1[0], h1[1]); hw.w = pk2(h1[2], h1[3]);
                if (VAR == 3 && MOE_FP8) { u32x2 w8; w8.x = pk4_fp8(h0[0], h0[1], h0[2], h0[3]); w8.y = pk4_fp8(h1[0], h1[1], h1[2], h1[3]); *(u32x2*)((unsigned char*)a.H + (size_t)row * D + kw + 32 * sK) = w8; }
                else *(u32x4*)(a.H + (size_t)row * D + kw + 32 * sK) = hw;
                const bf16x8 af = __builtin_bit_cast(bf16x8, hw), bw = *(const LAS bf16x8*)(WT + r * WP + kw + 32 * sK);
                acc = __builtin_amdgcn_mfma_f32_16x16x32_bf16(af, bw, acc, 0, 0, 0);
                if (VAR == 3) {
                    u32x4 lw; lw.x = pk2(h0[0] - bf_lo(hw.x), h0[1] - bf_hi(hw.x)); lw.y = pk2(h0[2] - bf_lo(hw.y), h0[3] - bf_hi(hw.y)); lw.z = pk2(h1[0] - bf_lo(hw.z), h1[1] - bf_hi(hw.z)); lw.w = pk2(h1[2] - bf_lo(hw.w), h1[3] - bf_hi(hw.w));
                    const bf16x8 bl = *(const LAS bf16x8*)(WTL + r * WP + kw + 32 * sK);
                    acc = __builtin_amdgcn_mfma_f32_16x16x32_bf16(__builtin_bit_cast(bf16x8, lw), bw, acc, 0, 0, 0);
                    acc = __builtin_amdgcn_mfma_f32_16x16x32_bf16(af, bl, acc, 0, 0, 0); } }
#pragma unroll
            for (int i = 0; i < 4; ++i) PA[(wave * 16 + 4 * g + i) * 16 + r] = acc[i];
            __syncthreads();
            if (tid < 256) { float o = 0.f;
#pragma unroll
                for (int w8 = 0; w8 < 8; ++w8) o += PA[w8 * 256 + tid];
                OUTS[(tid >> 4) * 17 + (tid & 15)] = o; }
            __syncthreads();
            const int grow0 = rb * 128 + gi * 16;
            if (VAR == 2) { if (tid < 256) { const int rr = tid >> 4, n = tid & 15; a.lf[(size_t)(grow0 + rr) * 16 + n] = log_sigmoid(OUTS[rr * 17 + n] + a.bvec[n]); } }
            if (VAR == 3) {
                if (tid < 16) { const int lr = gi * 16 + tid; float lg[8];
#pragma unroll
                    for (int n = 0; n < 8; ++n) lg[n] = OUTS[tid * 17 + n];
                    int e0 = 0; float l0 = lg[0];
#pragma unroll
                    for (int n = 1; n < 8; ++n) { const bool up = lg[n] > l0; l0 = up ? lg[n] : l0; e0 = up ? n : e0; }
                    int e1 = 0; float l1 = -3.0e38f;
#pragma unroll
                    for (int n = 0; n < 8; ++n) { const bool up = (n != e0) && (lg[n] > l1); l1 = up ? lg[n] : l1; e1 = up ? n : e1; }
                    const float g0 = 1.0f / (1.0f + __expf(l1 - l0));
                    SEL_E[lr * 2] = e0; SEL_E[lr * 2 + 1] = e1; SEL_G[lr * 2] = g0; SEL_G[lr * 2 + 1] = 1.0f - g0; } }
            if (VAR == 1) {
                bf16x8 bg8; { float t[8];
#pragma unroll
                    for (int j = 0; j < 8; ++j) t[j] = (g < 2) ? OUTS[r * 17 + 8 * (g & 1) + j] : 0.f;
                    u32x4 tw; tw.x = pk2(t[0], t[1]); tw.y = pk2(t[2], t[3]); tw.z = pk2(t[4], t[5]); tw.w = pk2(t[6], t[7]); bg8 = __builtin_bit_cast(bf16x8, tw); }
#pragma unroll
                for (int c4 = 0; c4 < 4; ++c4) { const int cb = 4 * wave + c4;
                    u32x4 aw = *(const LAS u32x4*)(W2T + (16 * cb + r) * 16 + 8 * (g & 1)); if (g >= 2) aw = (u32x4){0u, 0u, 0u, 0u};
                    const f32x4 z = __builtin_amdgcn_mfma_f32_16x16x32_bf16(__builtin_bit_cast(bf16x8, aw), bg8, (f32x4){0.f, 0.f, 0.f, 0.f}, 0, 0, 0);
                    const f32x4 bgv = *(const LAS f32x4*)(BG + 16 * cb + 4 * g);
                    f32x4 la;
#pragma unroll
                    for (int i = 0; i < 4; ++i) la[i] = log_sigmoid(z[i] + bgv[i]) * (1.0f / 16.0f);
                    { float a0 = la[0], a1 = la[1], a2 = la[2], a3 = la[3];
#define NM2_DPP(sh) "v_add_f32_dpp %0, %0, %0 row_shr:" #sh " row_mask:0xf bank_mask:0xf bound_ctrl:1\n\tv_add_f32_dpp %1, %1, %1 row_shr:" #sh " row_mask:0xf bank_mask:0xf bound_ctrl:1\n\t" \
                        "v_add_f32_dpp %2, %2, %2 row_shr:" #sh " row_mask:0xf bank_mask:0xf bound_ctrl:1\n\tv_add_f32_dpp %3, %3, %3 row_shr:" #sh " row_mask:0xf bank_mask:0xf bound_ctrl:1\n\t"
                        asm volatile("s_nop 1\n\t" NM2_DPP(1) NM2_DPP(2) NM2_DPP(4) NM2_DPP(8) "s_nop 1" : "+v"(a0), "+v"(a1), "+v"(a2), "+v"(a3));
#undef NM2_DPP
                        la[0] = a0; la[1] = a1; la[2] = a2; la[3] = a3; }
                    { u32x2 dw; dw.x = pk2(la[0], la[1]); dw.y = pk2(la[2], la[3]); *(u32x2*)((bf16_t*)a.Dk + (size_t)row * 512 + 16 * cb + 4 * g) = dw; }
                    if (r == 15) *(LAS f32x4*)(TOT + gi * 512 + 16 * cb + 4 * g) = la; } }
        }
        if (VAR == 1) {
            __syncthreads();
#pragma unroll
            for (int j = 0; j < 8; ++j) { const int idx = tid + NTHR * j, gi = idx >> 9, c = idx & 511, g0i = gi & ~3; float tot = 0.f, off = 0.f;
#pragma unroll
                for (int w4 = 0; w4 < 4; ++w4) { const float t = TOT[(g0i + w4) * 512 + c]; tot += t; off += (g0i + w4 < gi) ? t : 0.f; }
                a.dref[((size_t)rb * 8 + gi) * 512 + c] = tot - off;
                if ((gi & 3) == 0) a.etot[((size_t)rb * 2 + (gi >> 2)) * 512 + c] = __expf(tot); }
        }
        if (VAR == 3) {
            __syncthreads();
            if (tid < NE) { int c = 0; for (int q = 0; q < 256; ++q) c += (SEL_E[q] == tid) ? 1 : 0; BASE[tid] = c ? (int)atomicAdd(a.cnt + tid, (unsigned)c) : 0; }
            __syncthreads();
            if (tid < 256) { const int e = SEL_E[tid]; int pos = BASE[e]; for (int q = 0; q < tid; ++q) pos += (SEL_E[q] == e) ? 1 : 0;
                const int trow = rb * 128 + (tid >> 1); a.tok[e * MOE_CAP + pos] = trow;
                unsigned* ti = (unsigned*)(a.tinfo_out + trow); ti[tid & 1] = (unsigned)(e * MOE_CAP + pos); ti[2 + (tid & 1)] = __float_as_uint(SEL_G[tid]); }
        }
    }
}
#undef NM2_LOAD

__device__ __forceinline__ void gla_scan_phase(LAS unsigned char* lds, const bf16_t* Qg, const bf16_t* KD, const bf16_t* V, const float* etot, bf16_t* O, int vcu, int G) {
    const int tid = opaque_tid();
    constexpr int QP = 272;
    LAS unsigned char* Qs = lds; LAS unsigned char* Ks = lds + 64 * QP; LAS unsigned char* Vs = lds + 2 * 64 * QP;
    LAS float* Sl = (LAS float*)(lds + 2 * 64 * QP + 4096); LAS float* Et = Sl + 128 * 32;
    for (int u = vcu; u < NB * 4 * 8; u += G) {
        const int b = u >> 5, h = (u >> 3) & 3, vs = u & 7;
        const int kg = tid >> 5, v = tid & 31;
        const int oc = tid >> 3, ov = tid & 7;
        float S[8];
#pragma unroll
        for (int i = 0; i < 8; ++i) S[i] = 0.f;
        u32x4 pq[2], pk[2], pv; float pe = 0.f; pv = (u32x4){0u, 0u, 0u, 0u};
        auto fetch = [&](int n) {
            const size_t row0 = (size_t)b * SEQ + (size_t)n * 64;
#pragma unroll
            for (int i = 0; i < 2; ++i) { const int idx = tid + i * NTHR, r = idx >> 4, c = idx & 15;
                pq[i] = *(const u32x4*)(Qg + (row0 + r) * 512 + h * 128 + c * 8); pk[i] = *(const u32x4*)(KD + (row0 + r) * 512 + h * 128 + c * 8); }
            if (tid < 256) { const int r = tid >> 2, c = tid & 3; pv = *(const u32x4*)(V + (row0 + r) * D + h * 256 + vs * 32 + c * 8); }
            if (tid < 128) pe = etot[((size_t)b * 64 + n) * 512 + h * 128 + tid];
        };
        fetch(0);
        for (int n = 0; n < 64; ++n) {
#pragma unroll
            for (int i = 0; i < 2; ++i) { const int idx = tid + i * NTHR, r = idx >> 4, c = idx & 15; *(LAS u32x4*)(Qs + r * QP + c * 16) = pq[i]; *(LAS u32x4*)(Ks + r * QP + c * 16) = pk[i]; }
            if (tid < 256) { const int r = tid >> 2, c = tid & 3; *(LAS u32x4*)(Vs + r * 64 + c * 16) = pv; }
            if (tid < 128) Et[tid] = pe;
            __syncthreads();
            if (n + 1 < 64) fetch(n + 1);
#pragma unroll
            for (int i = 0; i < 8; ++i) S[i] *= Et[kg * 8 + i];
#pragma unroll 4
            for (int c = 0; c < 64; ++c) { const u32x4 kw = *(const LAS u32x4*)(Ks + c * QP + kg * 16); const float vv = __uint_as_float((unsigned)(*(const LAS unsigned short*)(Vs + c * 64 + v * 2)) << 16);
                S[0] += bf_lo(kw.x) * vv; S[1] += bf_hi(kw.x) * vv; S[2] += bf_lo(kw.y) * vv; S[3] += bf_hi(kw.y) * vv; S[4] += bf_lo(kw.z) * vv; S[5] += bf_hi(kw.z) * vv; S[6] += bf_lo(kw.w) * vv; S[7] += bf_hi(kw.w) * vv; }
#pragma unroll
            for (int i = 0; i < 8; ++i) Sl[(kg * 8 + i) * 32 + v] = S[i];
            __syncthreads();
            f32x4 o = (f32x4){0.f, 0.f, 0.f, 0.f};
#pragma unroll 2
            for (int k8 = 0; k8 < 16; ++k8) { const u32x4 qw = *(const LAS u32x4*)(Qs + oc * QP + k8 * 16);
                const float qf[8] = {bf_lo(qw.x), bf_hi(qw.x), bf_lo(qw.y), bf_hi(qw.y), bf_lo(qw.z), bf_hi(qw.z), bf_lo(qw.w), bf_hi(qw.w)};
#pragma unroll
                for (int i = 0; i < 8; ++i) o = o + qf[i] * *(const LAS f32x4*)(Sl + (k8 * 8 + i) * 32 + ov * 4); }
            u32x2 w; w.x = pk2(o[0], o[1]); w.y = pk2(o[2], o[3]);
            *(u32x2*)(O + ((size_t)b * SEQ + (size_t)n * 64 + oc) * D + h * 256 + vs * 32 + ov * 4) = w;
            __syncthreads();
        }
    }
}


namespace gscan {
typedef short v4i16_t __attribute__((ext_vector_type(4)));
__device__ __forceinline__ unsigned off_b(unsigned row, unsigned ch) { return 256u * row + 16u * (ch ^ (((row & 3u) << 2) | ((row >> 2) & 3u))); }
__device__ __forceinline__ unsigned off_v(unsigned row, unsigned half) { return 64u * row + 32u * (half ^ ((row >> 3) & 1u)); }
constexpr int IMG_Q = 0, IMG_K = 16384, IMG_V = 32768, IMG_E = 36864, BUFB = 37376, ST_OFF = 2 * BUFB;
__device__ __forceinline__ bf16x8 tr8(const LAS unsigned char* p0, const LAS unsigned char* p1) {
    const v4i16_t lo = __builtin_amdgcn_ds_read_tr16_b64_v4i16((LAS v4i16_t*)p0), hi = __builtin_amdgcn_ds_read_tr16_b64_v4i16((LAS v4i16_t*)p1);
    return (bf16x8){lo[0], lo[1], lo[2], lo[3], hi[0], hi[1], hi[2], hi[3]};
}
#define GS_BAR() do { asm volatile("s_waitcnt lgkmcnt(0)" ::: "memory"); __builtin_amdgcn_s_barrier(); asm volatile("" ::: "memory"); } while (0)
struct Pre { u32x4 q[2], k[2], v; float e; };
__device__ __forceinline__ void gload(Pre& r, const bf16_t* Qg, const bf16_t* KD, const bf16_t* V, const float* etot, int b, int h, int vs, int n, int tid) {
    const size_t row0 = (size_t)b * SEQ + (size_t)n * 64;
#pragma unroll
    for (int i = 0; i < 2; ++i) { const int idx = tid + i * NTHR, rr = idx >> 4, c = idx & 15;
        r.q[i] = *(const u32x4*)(Qg + (row0 + rr) * 512 + h * 128 + c * 8); r.k[i] = *(const u32x4*)(KD + (row0 + rr) * 512 + h * 128 + c * 8); }
    if (tid < 256) { const int rr = tid >> 2, c = tid & 3; r.v = *(const u32x4*)(V + (row0 + rr) * D + h * 256 + vs * 32 + c * 8); }
    if (tid < 128) r.e = etot[((size_t)b * 64 + n) * 512 + h * 128 + tid];
}
__device__ __forceinline__ void lwrite(const Pre& r, LAS unsigned char* buf, int tid) {
#pragma unroll
    for (int i = 0; i < 2; ++i) { const int idx = tid + i * NTHR, rr = idx >> 4, c = idx & 15; *(LAS u32x4*)(buf + IMG_Q + off_b(rr, c)) = r.q[i]; *(LAS u32x4*)(buf + IMG_K + off_b(rr, c)) = r.k[i]; }
    if (tid < 256) { const int rr = tid >> 2, c = tid & 3; *(LAS u32x4*)(buf + IMG_V + off_v(rr, c >> 1) + 16 * (c & 1)) = r.v; }
    if (tid < 128) *(LAS float*)(buf + IMG_E + 4 * tid) = r.e;
}
__device__ __forceinline__ void chunk(LAS unsigned char* lds, LAS unsigned char* buf, f32x4& S0, f32x4& S1, bf16_t* Orow0, int w, int lane) {
    const int g = lane >> 4, l15 = lane & 15, q = l15 >> 2, p = lane & 3;
    LAS unsigned char* ST = lds + ST_OFF;
    { const f32x4 et = *(const LAS f32x4*)(buf + IMG_E + 4 * (16 * w + 4 * g));
        S0 = S0 * et; S1 = S1 * et;
#pragma unroll
        for (int ks = 0; ks < 2; ++ks) {
            const unsigned r0 = 32 * ks + 8 * g + q, r1 = r0 + 4;
            const bf16x8 a = tr8(buf + IMG_K + off_b(r0, 2 * w + (p >> 1)) + 8 * (p & 1), buf + IMG_K + off_b(r1, 2 * w + (p >> 1)) + 8 * (p & 1));
            const bf16x8 b0 = tr8(buf + IMG_V + off_v(r0, 0) + 8 * p, buf + IMG_V + off_v(r1, 0) + 8 * p);
            const bf16x8 b1 = tr8(buf + IMG_V + off_v(r0, 1) + 8 * p, buf + IMG_V + off_v(r1, 1) + 8 * p);
            S0 = __builtin_amdgcn_mfma_f32_16x16x32_bf16(a, b0, S0, 0, 0, 0);
            S1 = __builtin_amdgcn_mfma_f32_16x16x32_bf16(a, b1, S1, 0, 0, 0);
        }
        u32x2 w0, w1; w0.x = pk2(S0[0], S0[1]); w0.y = pk2(S0[2], S0[3]); w1.x = pk2(S1[0], S1[1]); w1.y = pk2(S1[2], S1[3]);
        *(LAS u32x2*)(ST + off_b(l15, 2 * w + (g >> 1)) + 8 * (g & 1)) = w0;
        *(LAS u32x2*)(ST + off_b(16 + l15, 2 * w + (g >> 1)) + 8 * (g & 1)) = w1; }
    GS_BAR();
    { const int vt = w & 1, ct = w >> 1; f32x4 o = (f32x4){0.f, 0.f, 0.f, 0.f};
#pragma unroll
        for (int sK = 0; sK < 4; ++sK) {
            const bf16x8 a = *(const LAS bf16x8*)(ST + off_b(16 * vt + l15, 4 * sK + g));
            const bf16x8 bq = *(const LAS bf16x8*)(buf + IMG_Q + off_b(16 * ct + l15, 4 * sK + g));
            o = __builtin_amdgcn_mfma_f32_16x16x32_bf16(a, bq, o, 0, 0, 0);
        }
        u32x2 wo; wo.x = pk2(o[0], o[1]); wo.y = pk2(o[2], o[3]);
        *(u32x2*)(Orow0 + (size_t)(16 * ct + l15) * D + 16 * vt + 4 * g) = wo; }
    GS_BAR();
}
}
__device__ __forceinline__ void gla_scan_mfma(LAS unsigned char* lds, const bf16_t* Qg, const bf16_t* KD, const bf16_t* V, const float* etot, bf16_t* O, int vcu, int G) {
    using namespace gscan;
    const int tid = opaque_tid(), lane = tid & 63, w = __builtin_amdgcn_readfirstlane(tid >> 6);
    for (int u = vcu; u < NB * 4 * 8; u += G) {
        const int b = u >> 5, h = (u >> 3) & 3, vs = u & 7;
        f32x4 S0 = (f32x4){0.f, 0.f, 0.f, 0.f}, S1 = (f32x4){0.f, 0.f, 0.f, 0.f};
        Pre pa, pb; pa.v = (u32x4){0u, 0u, 0u, 0u}; pb.v = pa.v; pa.e = 0.f; pb.e = 0.f;
        gload(pa, Qg, KD, V, etot, b, h, vs, 0, tid); gload(pb, Qg, KD, V, etot, b, h, vs, 1, tid);
        lwrite(pa, lds, tid); lwrite(pb, lds + BUFB, tid);
        gload(pa, Qg, KD, V, etot, b, h, vs, 2, tid); gload(pb, Qg, KD, V, etot, b, h, vs, 3, tid);
        GS_BAR();
        bf16_t* Ob = O + ((size_t)b * SEQ) * D + h * 256 + vs * 32;
        for (int n = 0; n < 64; n += 2) {
            chunk(lds, lds, S0, S1, Ob + (size_t)n * 64 * D, w, lane);
            if (n + 2 < 64) { lwrite(pa, lds, tid); if (n + 4 < 64) gload(pa, Qg, KD, V, etot, b, h, vs, n + 4, tid); }
            chunk(lds, lds + BUFB, S0, S1, Ob + (size_t)(n + 1) * 64 * D, w, lane);
            if (n + 3 < 64) { lwrite(pb, lds + BUFB, tid); if (n + 5 < 64) gload(pb, Qg, KD, V, etot, b, h, vs, n + 5, tid); }
        }
        GS_BAR();
    }
}

__device__ __forceinline__ void gla_gn_phase(const bf16_t* O, const bf16_t* R, const float* gn, bf16_t* A2, int vcu, int G) {
    const int tid = opaque_tid(), lane = tid & 63, wave = tid >> 6;
    f32x4 g[4];
#pragma unroll
    for (int j = 0; j < 4; ++j) g[j] = *(const f32x4*)(gn + 16 * lane + 4 * j);
    for (int row = vcu * NWAVES + wave; row < NTOK; row += G * NWAVES) {
        const u32x4 o0 = *(const u32x4*)(O + (size_t)row * D + 16 * lane), o1 = *(const u32x4*)(O + (size_t)row * D + 16 * lane + 8);
        const u32x4 r0 = *(const u32x4*)(R + (size_t)row * D + 16 * lane), r1 = *(const u32x4*)(R + (size_t)row * D + 16 * lane + 8);
        float ov[16], rv[16];
        const unsigned ow[8] = {o0.x, o0.y, o0.z, o0.w, o1.x, o1.y, o1.z, o1.w}, rw[8] = {r0.x, r0.y, r0.z, r0.w, r1.x, r1.y, r1.z, r1.w};
        float ss = 0.f;
#pragma unroll
        for (int i = 0; i < 8; ++i) { ov[2 * i] = bf_lo(ow[i]); ov[2 * i + 1] = bf_hi(ow[i]); rv[2 * i] = bf_lo(rw[i]); rv[2 * i + 1] = bf_hi(rw[i]); ss += ov[2 * i] * ov[2 * i] + ov[2 * i + 1] * ov[2 * i + 1]; }
        ss += __shfl_xor(ss, 1); ss += __shfl_xor(ss, 2); ss += __shfl_xor(ss, 4); ss += __shfl_xor(ss, 8);
        const float rs = __builtin_amdgcn_rsqf(ss * (1.0f / 256.0f) + EPS);
        u32x4 w0, w1;
        w0.x = pk2(ov[0] * rs * g[0][0] * rv[0], ov[1] * rs * g[0][1] * rv[1]); w0.y = pk2(ov[2] * rs * g[0][2] * rv[2], ov[3] * rs * g[0][3] * rv[3]);
        w0.z = pk2(ov[4] * rs * g[1][0] * rv[4], ov[5] * rs * g[1][1] * rv[5]); w0.w = pk2(ov[6] * rs * g[1][2] * rv[6], ov[7] * rs * g[1][3] * rv[7]);
        w1.x = pk2(ov[8] * rs * g[2][0] * rv[8], ov[9] * rs * g[2][1] * rv[9]); w1.y = pk2(ov[10] * rs * g[2][2] * rv[10], ov[11] * rs * g[2][3] * rv[11]);
        w1.z = pk2(ov[12] * rs * g[3][0] * rv[12], ov[13] * rs * g[3][1] * rv[13]); w1.w = pk2(ov[14] * rs * g[3][2] * rv[14], ov[15] * rs * g[3][3] * rv[15]);
        *(u32x4*)(A2 + (size_t)row * D + 16 * lane) = w0; *(u32x4*)(A2 + (size_t)row * D + 16 * lane + 8) = w1;
    }
}

typedef _Float16 h16x2 __attribute__((ext_vector_type(2)));
__device__ __forceinline__ unsigned pkh2(float lo, float hi) { const f32x2 v = {lo, hi}; const h16x2 h = __builtin_convertvector(v, h16x2); return __builtin_bit_cast(unsigned, h); }
template <int J> __device__ __forceinline__ void conv_step(unsigned (&ac)[16], const unsigned (&wv2)[CONVW], unsigned packed) {
    const unsigned uu = pkh2(bf_lo(packed), bf_hi(packed));
#pragma unroll
    for (int ro = 0; ro < 16; ++ro) { constexpr int dummy = 0; (void)dummy; const int w = J - ro;
        if (w >= 0 && w <= 30) asm("v_pk_fma_f16 %0, %1, %2, %0" : "+v"(ac[ro]) : "v"(wv2[w]), "v"(uu)); }
}
__device__ __forceinline__ void conv_phase(LAS unsigned char* lds, const bf16_t* U, const float* dw, const float* dwb, const float* lng, const float* lnb, bf16_t* A2, int vcu, int G) {
    const int tid = opaque_tid(), lane = tid & 63, wave = __builtin_amdgcn_readfirstlane(tid >> 6);
    LAS float* PART = (LAS float*)lds;
    LAS float* STAT = PART + 512;
    unsigned wv2[CONVW];
#pragma unroll
    for (int w = 0; w < CONVW; ++w) { const f32x2 t = *(const f32x2*)(dw + w * D + 2 * tid); wv2[w] = pkh2(t[0], t[1]); }
    const f32x2 bia = *(const f32x2*)(dwb + 2 * tid), gam = *(const f32x2*)(lng + 2 * tid), bet = *(const f32x2*)(lnb + 2 * tid);
    for (int u = vcu; u < NB * (SEQ / 128); u += G) {
        const int b = u / (SEQ / 128), t0 = (u % (SEQ / 128)) * 128;
        const bf16_t* ub = U + ((size_t)b * SEQ) * D + 2 * tid;
        unsigned inp[46], nx[16];
#pragma unroll
        for (int j = 0; j < 30; ++j) { const int sfr = t0 - 30 + j; inp[j] = (sfr >= 0) ? *(const unsigned*)(ub + (size_t)sfr * D) : 0u; }
#pragma unroll
        for (int j = 0; j < 16; ++j) nx[j] = *(const unsigned*)(ub + (size_t)(t0 + j) * D);
#pragma unroll 1
        for (int og = 0; og < 8; ++og) {
#pragma unroll
            for (int j = 0; j < 16; ++j) inp[30 + j] = nx[j];
            if (og < 7) {
#pragma unroll
                for (int j = 0; j < 16; ++j) nx[j] = *(const unsigned*)(ub + (size_t)(t0 + 16 * (og + 1) + j) * D); }
            unsigned ac[16];
#pragma unroll
            for (int r = 0; r < 16; ++r) ac[r] = 0u;
#define CS(J) conv_step<J>(ac, wv2, inp[J]);
            CS(0) CS(1) CS(2) CS(3) CS(4) CS(5) CS(6) CS(7) CS(8) CS(9) CS(10) CS(11) CS(12) CS(13) CS(14) CS(15) CS(16) CS(17) CS(18) CS(19) CS(20) CS(21) CS(22) CS(23) CS(24) CS(25) CS(26) CS(27) CS(28) CS(29) CS(30) CS(31) CS(32) CS(33) CS(34) CS(35) CS(36) CS(37) CS(38) CS(39) CS(40) CS(41) CS(42) CS(43) CS(44) CS(45)
#undef CS
#pragma unroll
            for (int j = 0; j < 30; ++j) inp[j] = inp[j + 16];
            float a0[16], a1[16];
#pragma unroll
            for (int r = 0; r < 16; ++r) { const h16x2 h = __builtin_bit_cast(h16x2, ac[r]); a0[r] = (float)h[0] + bia[0]; a1[r] = (float)h[1] + bia[1]; }
            { float st[16];
#pragma unroll
                for (int r = 0; r < 16; ++r) st[r] = a0[r] + a1[r];
                xreduce<16>(st, lane);
                if ((lane & 3) == 0) PART[wave * 32 + (lane >> 2)] = st[0];
#pragma unroll
                for (int r = 0; r < 16; ++r) st[r] = a0[r] * a0[r] + a1[r] * a1[r];
                xreduce<16>(st, lane);
                if ((lane & 3) == 0) PART[wave * 32 + 16 + (lane >> 2)] = st[0]; }
            __syncthreads();
            if (tid < 16) { float s1 = 0.f, s2 = 0.f;
#pragma unroll
                for (int w8 = 0; w8 < 8; ++w8) { s1 += PART[w8 * 32 + tid]; s2 += PART[w8 * 32 + 16 + tid]; }
                const float mean = s1 * (1.0f / D); const float var = fmaxf(s2 * (1.0f / D) - mean * mean, 0.f);
                STAT[2 * tid] = mean; STAT[2 * tid + 1] = __builtin_amdgcn_rsqf(var + EPS); }
            __syncthreads();
#pragma unroll
            for (int r = 0; r < 16; ++r) { const float mean = STAT[2 * r], rs = STAT[2 * r + 1];
                const float y0 = (a0[r] - mean) * rs * gam[0] + bet[0], y1 = (a1[r] - mean) * rs * gam[1] + bet[1];
                *(unsigned*)(A2 + ((size_t)b * SEQ + t0 + 16 * og + r) * D + 2 * tid) = pk2(fast_silu(y0), fast_silu(y1)); }
            __syncthreads();
        }
    }
}

__device__ __forceinline__ void fox_attn_naive(LAS unsigned char* lds, const bf16_t* Q, const bf16_t* Kb, const bf16_t* V, const bf16_t* OG, const float* lf, bf16_t* A2, int vcu, int G) {
    const int tid = opaque_tid(), ql = tid >> 1, hf = tid & 1;
    LAS float* CUM = (LAS float*)lds;
    LAS float* Ks = (LAS float*)(lds + 16384);
    LAS float* Vs = (LAS float*)(lds + 32768);
    LAS float* SCN = (LAS float*)(lds + 49152);
    for (int pu = vcu; pu < NB * 16 * 8; pu += G) {
        const int bh = pu >> 3, b = bh >> 4, h = bh & 15, pr = pu & 7;
        { float loc[8]; float s = 0.f;
#pragma unroll
            for (int i = 0; i < 8; ++i) { s += lf[((size_t)b * SEQ + 8 * tid + i) * 16 + h]; loc[i] = s; }
            __syncthreads();
            SCN[tid] = s; __syncthreads();
            for (int off = 1; off < NTHR; off <<= 1) { const float t = (tid >= off) ? SCN[tid - off] : 0.f; __syncthreads(); SCN[tid] += t; __syncthreads(); }
            const float base = (tid > 0) ? SCN[tid - 1] : 0.f;
#pragma unroll
            for (int i = 0; i < 8; ++i) CUM[8 * tid + i] = (base + loc[i]) * LOG2E;
            __syncthreads(); }
        for (int half = 0; half < 2; ++half) {
            const int qt = half ? 15 - pr : pr; const int qi = qt * 256 + ql; const size_t qrow = (size_t)b * SEQ + qi;
            float q[32], o[32];
#pragma unroll
            for (int c = 0; c < 4; ++c) { const u32x4 w = *(const u32x4*)(Q + qrow * D + h * 64 + hf * 32 + c * 8);
                q[8 * c] = bf_lo(w.x); q[8 * c + 1] = bf_hi(w.x); q[8 * c + 2] = bf_lo(w.y); q[8 * c + 3] = bf_hi(w.y); q[8 * c + 4] = bf_lo(w.z); q[8 * c + 5] = bf_hi(w.z); q[8 * c + 6] = bf_lo(w.w); q[8 * c + 7] = bf_hi(w.w); }
#pragma unroll
            for (int d = 0; d < 32; ++d) o[d] = 0.f;
            float mx = -3.0e38f, l = 0.f; const float cq = CUM[qi];
            const int ntile = (qt * 256 + 256) / 64;
            for (int kt = 0; kt < ntile; ++kt) {
                __syncthreads();
                { const int r = tid >> 3, c = tid & 7; const size_t krow = (size_t)b * SEQ + kt * 64 + r;
                    const u32x4 kw = *(const u32x4*)(Kb + krow * D + h * 64 + c * 8), vw = *(const u32x4*)(V + krow * D + h * 64 + c * 8);
                    *(LAS f32x4*)(Ks + r * 64 + c * 8) = (f32x4){bf_lo(kw.x), bf_hi(kw.x), bf_lo(kw.y), bf_hi(kw.y)}; *(LAS f32x4*)(Ks + r * 64 + c * 8 + 4) = (f32x4){bf_lo(kw.z), bf_hi(kw.z), bf_lo(kw.w), bf_hi(kw.w)};
                    *(LAS f32x4*)(Vs + r * 64 + c * 8) = (f32x4){bf_lo(vw.x), bf_hi(vw.x), bf_lo(vw.y), bf_hi(vw.y)}; *(LAS f32x4*)(Vs + r * 64 + c * 8 + 4) = (f32x4){bf_lo(vw.z), bf_hi(vw.z), bf_lo(vw.w), bf_hi(vw.w)}; }
                __syncthreads();
#pragma unroll 1
                for (int j = 0; j < 64; ++j) {
                    const int kj = kt * 64 + j;
                    float acc = 0.f;
#pragma unroll
                    for (int d4 = 0; d4 < 8; ++d4) { const f32x4 kv = *(const LAS f32x4*)(Ks + j * 64 + hf * 32 + d4 * 4); acc += q[4 * d4] * kv[0] + q[4 * d4 + 1] * kv[1] + q[4 * d4 + 2] * kv[2] + q[4 * d4 + 3] * kv[3]; }
                    acc += __shfl_xor(acc, 1);
                    acc += cq - CUM[kj];
                    if (kj <= qi) {
                        const float mn = fmaxf(mx, acc), sc = __builtin_amdgcn_exp2f(mx - mn), p = __builtin_amdgcn_exp2f(acc - mn); mx = mn; l = l * sc + p;
#pragma unroll
                        for (int d4 = 0; d4 < 8; ++d4) { const f32x4 vv = *(const LAS f32x4*)(Vs + j * 64 + hf * 32 + d4 * 4);
                            o[4 * d4] = o[4 * d4] * sc + p * vv[0]; o[4 * d4 + 1] = o[4 * d4 + 1] * sc + p * vv[1]; o[4 * d4 + 2] = o[4 * d4 + 2] * sc + p * vv[2]; o[4 * d4 + 3] = o[4 * d4 + 3] * sc + p * vv[3]; }
                    }
                }
            }
            const float il = 1.0f / l;
#pragma unroll
            for (int c = 0; c < 4; ++c) { const u32x4 gw = *(const u32x4*)(OG + qrow * D + h * 64 + hf * 32 + c * 8); u32x4 w;
                w.x = pk2(o[8 * c] * il * bf_lo(gw.x), o[8 * c + 1] * il * bf_hi(gw.x)); w.y = pk2(o[8 * c + 2] * il * bf_lo(gw.y), o[8 * c + 3] * il * bf_hi(gw.y));
                w.z = pk2(o[8 * c + 4] * il * bf_lo(gw.z), o[8 * c + 5] * il * bf_hi(gw.z)); w.w = pk2(o[8 * c + 6] * il * bf_lo(gw.w), o[8 * c + 7] * il * bf_hi(gw.w));
                *(u32x4*)(A2 + qrow * D + h * 64 + hf * 32 + c * 8) = w; }
        }
        __syncthreads();
    }
}

#include <hip/hip_bf16.h>
namespace attn_body {
using bf16=__hip_bfloat16;
using bf16x8=__attribute__((ext_vector_type(8)))short;
using s16x4=__attribute__((ext_vector_type(4)))short;
using f32x16=__attribute__((ext_vector_type(16)))float;
using u32x4=__attribute__((ext_vector_type(4)))unsigned;
constexpr int BATCH=8,NHEAD=16,SEQ=4096,D=64,DM=NHEAD*D;
constexpr int NW=8,QBLK=32,QB=QBLK*NW,KVBLK=64,NQB=SEQ/QB;
constexpr int ATTN_PITCH=DM, ATTN_UNIT_ROWS=QB;
__device__ __forceinline__ int crow(int r,int hi){return (r&3)+8*(r>>2)+4*hi;}
#define SBAR() __builtin_amdgcn_sched_barrier(0)
__device__ __forceinline__ void cmask(f32x16&p0,f32x16&p1,int jb,int qrel,int hi){
  const float NEG=-INFINITY; int kb=64*jb+4*hi;
  #pragma unroll
  for(int r=0;r<16;++r){int kv=kb+(r&3)+8*(r>>2); if(kv>qrel)p0[r]=NEG; if(kv+32>qrel)p1[r]=NEG;}
}

constexpr int NSLOT=3, SLOTB=8192;
constexpr int LDS_K=0, LDS_V=NSLOT*SLOTB, LDS_WS=2*NSLOT*SLOTB, LDS_OST=LDS_WS+NW*64*4, LDS_CUM=LDS_OST+NW*4096, LDS_BYTES=LDS_CUM+SEQ*4;
constexpr float C2=0.125f*1.4426950408889634f;
__device__ __forceinline__ void glds16(const void*gsrc,unsigned lds_dst){unsigned keep;
  asm volatile("s_mov_b32 %0, m0\n\ts_mov_b32 m0, %2\n\ts_nop 0\n\tglobal_load_lds_dwordx4 %1, off\n\ts_mov_b32 m0, %0":"=&s"(keep):"v"(gsrc),"s"(lds_dst):"memory");}
__device__ __forceinline__ float max3f(float a,float b,float c){float r;asm("v_max3_f32 %0, %1, %2, %3":"=v"(r):"v"(a),"v"(b),"v"(c));return r;}
__device__ __forceinline__ float max2f(float a,float b){float r;asm("v_max_f32_e32 %0, %1, %2":"=v"(r):"v"(a),"v"(b));return r;}
__device__ __forceinline__ float fadd_s(float a,float b){float r;asm("v_add_f32_e32 %0, %1, %2":"=v"(r):"v"(a),"v"(b));return r;}
__device__ __forceinline__ float fsub_s(float a,float b){float r;asm("v_sub_f32_e32 %0, %1, %2":"=v"(r):"v"(a),"v"(b));return r;}
typedef float f32x2_t __attribute__((ext_vector_type(2))); typedef float f32x4_t __attribute__((ext_vector_type(4))); typedef __bf16 bf16x2_t __attribute__((ext_vector_type(2)));
__device__ __forceinline__ unsigned cvtpk_s(float lo,float hi){f32x2_t v={lo,hi};bf16x2_t b=__builtin_convertvector(v,bf16x2_t);return __builtin_bit_cast(unsigned,b);}
#define WAIT_BAR(N) asm volatile("s_waitcnt vmcnt(" #N ") lgkmcnt(0)\n\ts_barrier":::"memory")

__device__ __forceinline__ void qkt(f32x16&p0,f32x16&p1,const char*Kslot,const bf16x8*qr,const f32x16&negm,int r32,int hi){
  const char*kb=Kslot+hi*1024+r32*16;
  #pragma unroll
  for(int d0=0;d0<4;++d0){
    const bf16x8 b0=*reinterpret_cast<const bf16x8*>(kb+d0*2048);
    const bf16x8 b1=*reinterpret_cast<const bf16x8*>(kb+d0*2048+512);
    if(d0==0){p0=__builtin_amdgcn_mfma_f32_32x32x16_bf16(b0,qr[0],negm,0,0,0);p1=__builtin_amdgcn_mfma_f32_32x32x16_bf16(b1,qr[0],negm,0,0,0);}
    else{p0=__builtin_amdgcn_mfma_f32_32x32x16_bf16(b0,qr[d0],p0,0,0,0);p1=__builtin_amdgcn_mfma_f32_32x32x16_bf16(b1,qr[d0],p1,0,0,0);}}
}
typedef __attribute__((address_space(3))) const char* lds_cptr;
typedef short v4i16_t __attribute__((ext_vector_type(4)));
__device__ __forceinline__ void kload8(bf16x8*kf,lds_cptr kp){
  kf[0]=*(const __attribute__((address_space(3))) bf16x8*)(kp);      kf[1]=*(const __attribute__((address_space(3))) bf16x8*)(kp+512);
  kf[2]=*(const __attribute__((address_space(3))) bf16x8*)(kp+2048); kf[3]=*(const __attribute__((address_space(3))) bf16x8*)(kp+2560);
  kf[4]=*(const __attribute__((address_space(3))) bf16x8*)(kp+4096); kf[5]=*(const __attribute__((address_space(3))) bf16x8*)(kp+4608);
  kf[6]=*(const __attribute__((address_space(3))) bf16x8*)(kp+6144); kf[7]=*(const __attribute__((address_space(3))) bf16x8*)(kp+6656);
}
__device__ __forceinline__ void kload2(bf16x8*kf,lds_cptr kp,int j){ kf[2*j]=*(const __attribute__((address_space(3))) bf16x8*)(kp+j*2048); kf[2*j+1]=*(const __attribute__((address_space(3))) bf16x8*)(kp+j*2048+512); }
__device__ __forceinline__ s16x4 vtr(lds_cptr p){ return __builtin_bit_cast(s16x4,__builtin_amdgcn_ds_read_tr16_b64_v4i16((__attribute__((address_space(3))) v4i16_t*)p)); }
__device__ __forceinline__ float rowmax(const f32x16&p0,const f32x16&p1){
  float a=max3f(p0[0],p0[1],p1[0]),b=max3f(p0[2],p0[3],p1[1]);a=max3f(a,p1[2],p1[3]);
  #pragma unroll
  for(int r=4;r<16;r+=4){a=max3f(a,p0[r],p0[r+1]);b=max3f(b,p0[r+2],p0[r+3]);a=max3f(a,p1[r],p1[r+1]);b=max3f(b,p1[r+2],p1[r+3]);}
  const float m=max2f(a,b);
  auto rr=__builtin_amdgcn_permlane32_swap(__float_as_uint(m),__float_as_uint(m),false,false);
  return max2f(__uint_as_float(rr[0]),__uint_as_float(rr[1]));
}
__device__ __forceinline__ void pv(f32x16*o,int vb,bf16x8 pa0,bf16x8 pa1,bf16x8 pa2,bf16x8 pa3){
  #pragma unroll
  for(int d0=0;d0<2;++d0){s16x4 lo[4],hi[4];
    #pragma unroll
    for(int ks=0;ks<4;++ks){
      asm volatile("ds_read_b64_tr_b16 %0,%1 offset:%c2":"=&v"(lo[ks]):"v"(vb),"i"(d0*4096+ks*1024):"memory");
      asm volatile("ds_read_b64_tr_b16 %0,%1 offset:%c2":"=&v"(hi[ks]):"v"(vb),"i"(d0*4096+ks*1024+512):"memory");}
    asm volatile("s_waitcnt lgkmcnt(0)":::"memory");SBAR();
    #define PK(k) (bf16x8){lo[k][0],lo[k][1],lo[k][2],lo[k][3],hi[k][0],hi[k][1],hi[k][2],hi[k][3]}
    o[d0]=__builtin_amdgcn_mfma_f32_32x32x16_bf16(pa0,PK(0),o[d0],0,0,0);
    o[d0]=__builtin_amdgcn_mfma_f32_32x32x16_bf16(pa1,PK(1),o[d0],0,0,0);
    o[d0]=__builtin_amdgcn_mfma_f32_32x32x16_bf16(pa2,PK(2),o[d0],0,0,0);
    o[d0]=__builtin_amdgcn_mfma_f32_32x32x16_bf16(pa3,PK(3),o[d0],0,0,0);
    #undef PK
  }
}

#ifndef ATTN_STORE16
#define ATTN_STORE16(p,v) (*(u32x4*)(p)=(v))
#endif
constexpr float MFLOOR=-24.0f;
template<int THRL> __device__ __forceinline__ void attn_unit(int b,int h,int qb,int ts,const bf16*Q,const bf16*__restrict__ K,const bf16*__restrict__ V,const bf16*__restrict__ OG,bf16*O,char*shm){
  int tid=threadIdx.x; asm volatile("":"+v"(tid));
  const int lane=tid&63,r32=lane&31,hi=lane>>5; const int wid=__builtin_amdgcn_readfirstlane(tid>>6);
  const long rowbase=(long)b*SEQ; const int q0=qb*QB;
  const bf16*Qw=Q+(rowbase+q0+wid*QBLK)*DM+h*D;
  const bf16*Kh=K+(rowbase+(long)ts*KVBLK)*DM+h*D,*Vh=V+(rowbase+(long)ts*KVBLK)*DM+h*D;
  const lds_cptr shm3=(lds_cptr)shm;
  const unsigned lds0=(unsigned)(uintptr_t)shm;
  float*wsf=(float*)(shm+LDS_WS)+wid*64;
  const bf16*ksrc=Kh+(long)lane*DM+wid*8;
  const bf16*vsrc=Vh+(long)(16*(wid&3)+(lane>>2))*DM+(wid>>2)*32+(lane&3)*8;
  const unsigned kdst=lds0+LDS_K+wid*1024, vdst=lds0+LDS_V+wid*1024;
  #define DMA_K(t,slot) glds16(ksrc+(long)(t)*KVBLK*DM,(unsigned)__builtin_amdgcn_readfirstlane(kdst+(slot)))
  #define DMA_V(t,slot) glds16(vsrc+(long)(t)*KVBLK*DM,(unsigned)__builtin_amdgcn_readfirstlane(vdst+(slot)))
  const int vb0=(int)(lds0+LDS_V)+((lane>>4)&1)*32+(lane&3)*8+(4*hi+((lane&15)>>2))*64;
  const char*Kbase=shm+LDS_K; bf16x8 kf[8];
  const lds_cptr kp0=shm3+LDS_K+hi*1024+r32*16; const lds_cptr vp0=shm3+LDS_V+((lane>>4)&1)*32+(lane&3)*8+(4*hi+((lane&15)>>2))*64;
  const int NT=(q0+QB)/KVBLK-ts;
  DMA_K(0,0);DMA_V(0,0);DMA_K(1,SLOTB);
  bf16x8 qr[4];
  #pragma unroll
  for(int d0=0;d0<4;++d0)qr[d0]=*reinterpret_cast<const bf16x8*>(&Qw[(long)r32*DM+d0*16+hi*8]);
  const int qrel=wid*QBLK+r32;
  const __attribute__((address_space(3))) float* cum3=(const __attribute__((address_space(3))) float*)(shm3+LDS_CUM);
  const float cqv=cum3[q0+qrel];
  float mhat=0.f,l_reg=0.f;f32x16 o[2];o[0]=f32x16{};o[1]=f32x16{};f32x16 negm;
  _Pragma("unroll") for(int r=0;r<16;++r)negm[r]=cqv; asm volatile("":"+v"(negm));
  #define FBIAS(P0,P1,t) do{ const __attribute__((address_space(3))) float* cp_=cum3+((t)+ts)*KVBLK+4*hi; \
    _Pragma("unroll") for(int g_=0;g_<4;++g_){ const f32x4_t a_=*(const __attribute__((address_space(3))) f32x4_t*)(cp_+8*g_), b_=*(const __attribute__((address_space(3))) f32x4_t*)(cp_+32+8*g_); \
      P0[4*g_]-=a_[0];P0[4*g_+1]-=a_[1];P0[4*g_+2]-=a_[2];P0[4*g_+3]-=a_[3]; P1[4*g_]-=b_[0];P1[4*g_+1]-=b_[1];P1[4*g_+2]-=b_[2];P1[4*g_+3]-=b_[3]; } }while(0)
  #define CMASK(P0,P1,t) do{int jb_=(t)-(NT-4); if(jb_>=0)cmask(P0,P1,jb_,qrel,hi);}while(0)
  bool resc=false;
  #define START(P0,P1) do{ const float rm=rowmax(P0,P1); resc=false; \
    { const float dl=max2f(rm,MFLOOR); mhat=fadd_s(mhat,dl); \
      _Pragma("unroll") for(int r=0;r<16;++r){P0[r]=fsub_s(P0[r],dl);P1[r]=fsub_s(P1[r],dl);} \
      _Pragma("unroll") for(int r=0;r<16;++r)negm[r]=cqv-mhat; asm volatile("":"+v"(negm)); } \
    _Pragma("unroll") for(int r=0;r<16;++r)P0[r]=__builtin_amdgcn_exp2f(P0[r]); }while(0)
  #define RESC() do{ if(resc){ asm volatile("s_waitcnt lgkmcnt(0)":::"memory"); \
      _Pragma("unroll") for(int d_=0;d_<2;++d_) _Pragma("unroll") for(int r=0;r<16;++r)o[d_][r]*=wsf[crow(r,hi)]; } }while(0)
  f32x16 pA0,pA1,pB0,pB1;
  int sl_prev=0,sl_cur=0,sl_next=SLOTB;
  #define ROT() do{sl_prev=sl_cur;sl_cur=sl_next;sl_next=(sl_next==(NSLOT-1)*SLOTB)?0:sl_next+SLOTB;}while(0)
  DMA_K(2,2*SLOTB);
  WAIT_BAR(3);
  qkt(pA0,pA1,Kbase,qr,negm,r32,hi);asm volatile("s_nop 15\n\ts_nop 7":"+v"(pA0),"+v"(pA1));FBIAS(pA0,pA1,0);CMASK(pA0,pA1,0);
  START(pA0,pA1);
  _Pragma("unroll") for(int r=0;r<16;++r)pA1[r]=__builtin_amdgcn_exp2f(pA1[r]);
  WAIT_BAR(0);
  DMA_K(3,0);DMA_V(1,SLOTB);
  ROT();
  kload8(kf,kp0+sl_cur);
  WAIT_BAR(2);
  s16x4 vlo[8],vhi[8]; u32x4 pw0,pw1,pw2,pw3;
  #define PKW(P,B) cvtpk_s(P[B],P[B+1])
  #define PAF(k) __builtin_bit_cast(bf16x8,pw##k)
  #define VFR(i) (bf16x8){vlo[i][0],vlo[i][1],vlo[i][2],vlo[i][3],vhi[i][0],vhi[i][1],vhi[i][2],vhi[i][3]}
  #define PIN(x) asm volatile("":"+v"(x))
  #define MX3(a,b,c) __builtin_fmaxf(__builtin_fmaxf((a),(b)),(c))
  #define GAPA(MF,A0,A1,A2,A3,W0,W1,PW) do{ MF; sacc+=A0; sacc+=A1; sacc+=A2; sacc+=A3; PIN(sacc); W0; W1; PIN(PW); SBAR(); }while(0)
  #define EX(v) __builtin_amdgcn_exp2f(v)
  #define GAPB(MF,X,B) do{ MF; X[B]=EX(X[B]); X[B+1]=EX(X[B+1]); X[B+2]=EX(X[B+2]); X[B+3]=EX(X[B+3]); PIN(X); SBAR(); }while(0)
  #define VRD(i) do{ vlo[i]=vtr(vp_+(((i)>>2)*4096+((i)&3)*1024)); vhi[i]=vtr(vp_+(((i)>>2)*4096+((i)&3)*1024+512)); }while(0)
  #define KRD(G,j) do{ if(G){ kload2(kf,kp0+sl_next,j); SBAR(); } }while(0)
  #define STEP(C0,C1,P0,P1,t,GK,GV,GL) do{ SBAR(); \
    const lds_cptr vp_=vp0+sl_prev; \
    VRD(0); SBAR(); float sacc=(P0[0]+P0[1]); \
    GAPA(C0=__builtin_amdgcn_mfma_f32_32x32x16_bf16(kf[0],qr[0],negm,0,0,0), P0[2],P0[3],P0[4],P0[5],     pw0[0]=PKW(P0,0), pw0[1]=PKW(P0,2), pw0); \
    VRD(4); SBAR(); GAPA(C1=__builtin_amdgcn_mfma_f32_32x32x16_bf16(kf[1],qr[0],negm,0,0,0), P0[6],P0[7],P0[8],P0[9],     pw0[2]=PKW(P0,4), pw0[3]=PKW(P0,6), pw0); \
    VRD(1); SBAR(); GAPA(C0=__builtin_amdgcn_mfma_f32_32x32x16_bf16(kf[2],qr[1],C0,0,0,0),   P0[10],P0[11],P0[12],P0[13], pw1[0]=PKW(P0,8), pw1[1]=PKW(P0,10), pw1); \
    VRD(5); SBAR(); GAPA(C1=__builtin_amdgcn_mfma_f32_32x32x16_bf16(kf[3],qr[1],C1,0,0,0),   P0[14],P0[15],P1[0],P1[1],   pw1[2]=PKW(P0,12),pw1[3]=PKW(P0,14), pw1); \
    VRD(2); SBAR(); GAPA(C0=__builtin_amdgcn_mfma_f32_32x32x16_bf16(kf[4],qr[2],C0,0,0,0),   P1[2],P1[3],P1[4],P1[5],     pw2[0]=PKW(P1,0), pw2[1]=PKW(P1,2), pw2); \
    VRD(6); SBAR(); GAPA(C1=__builtin_amdgcn_mfma_f32_32x32x16_bf16(kf[5],qr[2],C1,0,0,0),   P1[6],P1[7],P1[8],P1[9],     pw2[2]=PKW(P1,4), pw2[3]=PKW(P1,6), pw2); \
    VRD(3); SBAR(); GAPA(C0=__builtin_amdgcn_mfma_f32_32x32x16_bf16(kf[6],qr[3],C0,0,0,0),   P1[10],P1[11],P1[12],P1[13], pw3[0]=PKW(P1,8), pw3[1]=PKW(P1,10), pw3); \
    VRD(7); SBAR(); GAPA(C1=__builtin_amdgcn_mfma_f32_32x32x16_bf16(kf[7],qr[3],C1,0,0,0),   P1[14],P1[15],0.f,0.f,       pw3[2]=PKW(P1,12),pw3[3]=PKW(P1,14), pw3); \
    l_reg+=sacc; \
    if(GK){DMA_K((t)+3,sl_cur);} if(GV){DMA_V((t)+1,sl_next);} \
    FBIAS(C0,C1,t); CMASK(C0,C1,t); \
    { float a=MX3(C0[0],C0[1],C1[0]),b=MX3(C0[2],C0[3],C1[1]); a=MX3(a,C1[2],C1[3]); \
      _Pragma("unroll") for(int r=4;r<16;r+=4){a=MX3(a,C0[r],C0[r+1]);b=MX3(b,C0[r+2],C0[r+3]);a=MX3(a,C1[r],C1[r+1]);b=MX3(b,C1[r+2],C1[r+3]);} \
      float rm=__builtin_fmaxf(a,b); { auto rr=__builtin_amdgcn_permlane32_swap(__float_as_uint(rm),__float_as_uint(rm),false,false); rm=__builtin_fmaxf(__uint_as_float(rr[0]),__uint_as_float(rr[1])); } \
      resc=false; \
      if(__builtin_expect(__any(rm>(float)THRL),0)){ const float dl=__builtin_fmaxf(rm,0.f); mhat+=dl; \
        _Pragma("unroll") for(int r=0;r<16;++r){C0[r]-=dl;C1[r]-=dl;} \
        _Pragma("unroll") for(int r=0;r<16;++r)negm[r]=cqv-mhat; asm volatile("":"+v"(negm)); \
        const float f=__builtin_amdgcn_exp2f(-dl); l_reg*=f; if(hi==0)wsf[r32]=f; resc=true; } } \
    SBAR(); \
    GAPB(o[0]=__builtin_amdgcn_mfma_f32_32x32x16_bf16(PAF(0),VFR(0),o[0],0,0,0), C0,0); \
    GAPB(o[1]=__builtin_amdgcn_mfma_f32_32x32x16_bf16(PAF(0),VFR(4),o[1],0,0,0), C0,4); \
    KRD(GL,0); GAPB(o[0]=__builtin_amdgcn_mfma_f32_32x32x16_bf16(PAF(1),VFR(1),o[0],0,0,0), C0,8); \
    KRD(GL,1); GAPB(o[1]=__builtin_amdgcn_mfma_f32_32x32x16_bf16(PAF(1),VFR(5),o[1],0,0,0), C0,12); \
    KRD(GL,2); GAPB(o[0]=__builtin_amdgcn_mfma_f32_32x32x16_bf16(PAF(2),VFR(2),o[0],0,0,0), C1,0); \
    KRD(GL,3); GAPB(o[1]=__builtin_amdgcn_mfma_f32_32x32x16_bf16(PAF(2),VFR(6),o[1],0,0,0), C1,4); \
    GAPB(o[0]=__builtin_amdgcn_mfma_f32_32x32x16_bf16(PAF(3),VFR(3),o[0],0,0,0), C1,8); \
    GAPB(o[1]=__builtin_amdgcn_mfma_f32_32x32x16_bf16(PAF(3),VFR(7),o[1],0,0,0), C1,12); \
    }while(0)
  int t=1;
  #undef CMASK
  #define CMASK(P0,P1,t) do{}while(0)
  for(;t+5<NT;t+=2){
    STEP(pB0,pB1,pA0,pA1,t,true,true,true);     WAIT_BAR(2); RESC(); ROT();
    STEP(pA0,pA1,pB0,pB1,t+1,true,true,true);   WAIT_BAR(2); RESC(); ROT();
  }
  #undef CMASK
  #define CMASK(P0,P1,t) do{int jb_=(t)-(NT-4); if(jb_>=0)cmask(P0,P1,jb_,qrel,hi);}while(0)
  #define ENDW(tt) do{ if((tt)+3<NT){WAIT_BAR(2);} else if((tt)+2<NT){WAIT_BAR(1);} else {WAIT_BAR(0);} }while(0)
  for(;t+1<NT;t+=2){
    STEP(pB0,pB1,pA0,pA1,t,(t+3<NT),(t+1<NT),(t+1<NT));       ENDW(t);   RESC(); ROT();
    STEP(pA0,pA1,pB0,pB1,t+1,(t+4<NT),(t+2<NT),(t+2<NT));     ENDW(t+1); RESC(); ROT();
  }
  STEP(pB0,pB1,pA0,pA1,NT-1,false,false,false); RESC();
  { float sacc=pB0[0]+pB0[1]; _Pragma("unroll") for(int r=2;r<16;++r)sacc+=pB0[r]; _Pragma("unroll") for(int r=0;r<16;++r)sacc+=pB1[r]; l_reg+=sacc;
    pw0=(u32x4){PKW(pB0,0),PKW(pB0,2),PKW(pB0,4),PKW(pB0,6)};pw1=(u32x4){PKW(pB0,8),PKW(pB0,10),PKW(pB0,12),PKW(pB0,14)};pw2=(u32x4){PKW(pB1,0),PKW(pB1,2),PKW(pB1,4),PKW(pB1,6)};pw3=(u32x4){PKW(pB1,8),PKW(pB1,10),PKW(pB1,12),PKW(pB1,14)};
    SBAR(); pv(o,vb0+sl_cur,PAF(0),PAF(1),PAF(2),PAF(3)); }
  #undef PKW
  #undef PAF
  #undef VFR
  #undef PIN
  #undef MX3
  #undef GAPA
  #undef GAPB
  #undef EX
  #undef VRD
  #undef KRD
  #undef STEP
  #undef ENDW
  {auto rr=__builtin_amdgcn_permlane32_swap(__float_as_uint(l_reg),__float_as_uint(l_reg),false,false);l_reg=__uint_as_float(rr[0])+__uint_as_float(rr[1]);}
  if(hi==0)wsf[32+r32]=l_reg;asm volatile("s_waitcnt lgkmcnt(0)":::"memory");
  float rli[16];
  #pragma unroll
  for(int r=0;r<16;++r)rli[r]=__builtin_amdgcn_rcpf(wsf[32+crow(r,hi)]);
  bf16*Ow=O+(rowbase+q0+wid*QBLK)*DM+h*D;
  { bf16*stg=(bf16*)(shm+LDS_OST)+wid*2048;
    #pragma unroll
    for(int r=0;r<16;++r){const int orow=crow(r,hi);
      #pragma unroll
      for(int d0=0;d0<2;++d0)stg[orow*64+d0*32+r32]=__float2bfloat16(o[d0][r]*rli[r]);}
    asm volatile("s_waitcnt lgkmcnt(0)":::"memory");
    const bf16*Gw=OG+(rowbase+q0+wid*QBLK)*DM+h*D;
    #pragma unroll
    for(int i=0;i<4;++i){const int row=i*8+(lane>>3),ch=lane&7; const u32x4 v=*(const u32x4*)(stg+row*64+ch*8); const u32x4 g=*(const u32x4*)(Gw+(long)row*DM+ch*8); u32x4 w;
      _Pragma("unroll") for(int e=0;e<4;++e){ const float lo=__uint_as_float(v[e]<<16)*__uint_as_float(g[e]<<16), hi2=__uint_as_float(v[e]&0xffff0000u)*__uint_as_float(g[e]&0xffff0000u); w[e]=cvtpk_s(lo,hi2); }
      ATTN_STORE16(Ow+(long)row*DM+ch*8,w);} }
  asm volatile("s_waitcnt lgkmcnt(0)\n\ts_barrier":::"memory");
  #undef DMA_K
  #undef DMA_V
  #undef CMASK
  #undef FBIAS
  #undef START
  #undef RESC
  #undef ROT
}
constexpr int ATTN_LDS_BYTES=LDS_BYTES;
struct AttnTensors { const bf16* Q; const bf16* K; const bf16* V; const bf16* G; bf16* O; };
struct AttnUnit { int bh; int qb; };
struct StaticOrder {
  int vcu;
  __device__ __forceinline__ explicit StaticOrder(int grid,int block):vcu((block%8)*(grid/8)+block/8){}
  __device__ __forceinline__ bool next(int i,AttnUnit&u)const{ if(i>=8)return false; const int s=2*(i>>1)+(vcu&1); u.bh=vcu>>1; u.qb=(i&1)?15-s:s; return true; }
  __device__ __forceinline__ void a_ready(const AttnUnit&)const{}
  __device__ __forceinline__ void done(const AttnUnit&)const{}
};
template<class Sched,int THRL=8> __device__ __forceinline__ void attn_phase(char*lds,const AttnTensors&T,const Sched&S){
  AttnUnit u;
  for(int i=0;S.next(i,u);++i){ S.a_ready(u); attn_unit<THRL>(u.bh/NHEAD,u.bh%NHEAD,u.qb,0,T.Q,T.K,T.V,T.G,T.O,lds); S.done(u); }
}
#undef SBAR
#undef WAIT_BAR
}

__device__ __forceinline__ void fox_cum_phase(LAS unsigned char* lds, const float* lf, float* cumg, int G) {
    const int tid = opaque_tid();
    LAS float* SCN = (LAS float*)lds;
    for (int bh = blockIdx.x; bh < NB * 16; bh += G) {
        const int b = bh >> 4, h = bh & 15;
        float loc[8]; float s = 0.f;
#pragma unroll
        for (int i = 0; i < 8; ++i) { s += lf[((size_t)b * SEQ + 8 * tid + i) * 16 + h]; loc[i] = s; }
        float ws_ = s;
        asm volatile("s_nop 1\n\t"
                     "v_add_f32_dpp %0, %0, %0 row_shr:1 row_mask:0xf bank_mask:0xf bound_ctrl:1\n\ts_nop 1\n\t"
                     "v_add_f32_dpp %0, %0, %0 row_shr:2 row_mask:0xf bank_mask:0xf bound_ctrl:1\n\ts_nop 1\n\t"
                     "v_add_f32_dpp %0, %0, %0 row_shr:4 row_mask:0xf bank_mask:0xf bound_ctrl:1\n\ts_nop 1\n\t"
                     "v_add_f32_dpp %0, %0, %0 row_shr:8 row_mask:0xf bank_mask:0xf bound_ctrl:1\n\ts_nop 1\n\t"
                     "v_add_f32_dpp %0, %0, %0 row_bcast:15 row_mask:0xa bank_mask:0xf\n\ts_nop 1\n\t"
                     "v_add_f32_dpp %0, %0, %0 row_bcast:31 row_mask:0xc bank_mask:0xf\n\ts_nop 1" : "+v"(ws_));
        __syncthreads();
        if ((tid & 63) == 63) SCN[tid >> 6] = ws_;
        __syncthreads();
        float base = ws_ - s;
        for (int w8 = 0; w8 < (tid >> 6); ++w8) base += SCN[w8];
        f32x4 o0, o1;
#pragma unroll
        for (int i = 0; i < 4; ++i) { o0[i] = (base + loc[i]) * LOG2E; o1[i] = (base + loc[4 + i]) * LOG2E; }
        *(f32x4*)(cumg + (size_t)bh * SEQ + 8 * tid) = o0; *(f32x4*)(cumg + (size_t)bh * SEQ + 8 * tid + 4) = o1;
    }
    __syncthreads();
}
__device__ __forceinline__ void fox_attn_phase(unsigned char* ldsg, LAS unsigned char* lds, const float* qg, const float* kg) {
    LAS float* CUM = (LAS float*)(lds + attn_body::LDS_CUM);
    LAS int* BC = (LAS int*)(lds + LDS_TAB);
    float gq = 0.f, gk = 0.f;
    for (int i = 0; i < 64; ++i) { gq = fmaxf(gq, fabsf(qg[i])); gk = fmaxf(gk, fabsf(kg[i])); }
    if (opaque_tid() == 0) ((LAS float*)BC)[2] = 2.0f * 64.0f * attn_body::C2 * gq * gk + 48.0f;
    __syncthreads();
#define Tskip (((const LAS float*)BC)[2])
    int cur_bh = -1;
    for (;;) {
        const int tid = opaque_tid();
        unsigned char* const wsb = karg_ws();
        const float* cumg = (const float*)(wsb + WS_CUMG);
        if (tid == 0) BC[0] = (int)atomicAdd((unsigned*)(wsb + WS_CTL) + CW_ATTQ, 1u);
        __syncthreads();
        const int u = __builtin_amdgcn_readfirstlane(BC[0]);
        if (u >= NB * 16 * 16) break;
        const int qb = 15 - (u >> 7), bh = u & 127;
        if (bh != cur_bh) { cur_bh = bh;
            *(LAS f32x4*)(CUM + 8 * tid) = *(const f32x4*)(cumg + (size_t)bh * SEQ + 8 * tid); *(LAS f32x4*)(CUM + 8 * tid + 4) = *(const f32x4*)(cumg + (size_t)bh * SEQ + 8 * tid + 4); }
        __syncthreads();
        if (tid < 64) { const int ntf = 4 * qb + 4; const bool dead = (tid < ntf) && (CUM[qb * 256] - CUM[64 * tid + 63] < -Tskip);
            const unsigned long long m = __ballot(dead);
            if (tid == 0) { int ts = __popcll(m) & ~1; ts = ts > ntf - 4 ? ntf - 4 : ts; BC[1] = ts; } }
        __syncthreads();
        const int ts = __builtin_amdgcn_readfirstlane(BC[1]);
        unsigned char* const sb = wsb + WS_SCR;
        attn_body::attn_unit<8>(bh >> 4, bh & 15, qb, ts, (const attn_body::bf16*)(sb + S_FQ), (const attn_body::bf16*)(sb + S_FK), (const attn_body::bf16*)(sb + S_FV), (const attn_body::bf16*)(sb + S_FG), (attn_body::bf16*)(sb + S_A2), (char*)ldsg);
    }
#undef Tskip
}

constexpr int PH_PER_LAYER = 8, N_PHASES = 1 + DEPTH * PH_PER_LAYER + 1;

__device__ __forceinline__ void moe_tab(LAS unsigned char* lds, const unsigned* cnt) {
    LAS int* TAB = (LAS int*)(lds + LDS_TAB);
    if (threadIdx.x == 0) { int s = 0; for (int e = 0; e < NE; ++e) { const int c = (int)cnt[e]; TAB[e] = s; TAB[16 + e] = c; s += (c + 255) >> 8; } TAB[8] = s; }
    __syncthreads();
}

__global__ void __launch_bounds__(NTHR, 2) mk_fwd(Args args) {
#define bWS (karg_ws())
#define bCTL ((unsigned*)(bWS + WS_CTL))
#define bMOD ((float*)(bWS + WS_MOD))
#define bX ((bf16_t*)(bWS + WS_X))
#define bH ((bf16_t*)(bWS + WS_H))
#define bY ((bf16_t*)(bWS + WS_Y))
#define bTOK ((int*)(bWS + WS_TOK))
#define bTINFO ((u32x4*)(bWS + WS_TINFO))
#define bLF ((float*)(bWS + WS_LF))
#define bSCR (bWS + WS_SCR)
#define bA2 ((bf16_t*)(bSCR + S_A2))
    extern __shared__ __attribute__((aligned(16))) unsigned char lds_raw[];
    LAS unsigned char* lds = (LAS unsigned char*)lds_raw;
    const int tid = threadIdx.x, G = gridDim.x;
    const int vcu = (G % 8 == 0) ? ((int)blockIdx.x % 8) * (G / 8) + (int)blockIdx.x / 8 : (int)blockIdx.x;
    if (tid < 8) ((volatile LAS unsigned*)(lds + LDS_MISC))[tid] = 0u;
    __syncthreads();
#if MK_N_LAUNCHES == 1
    XcdBarrier bar = xcd_barrier_post(bCTL + CW_BAR, (volatile LAS unsigned*)(lds + LDS_MISC));
#define SEAM() xcd_barrier(bar)
#else
#define SEAM() do { } while (0)
#endif
    const int lo = args.ph_lo, hi = args.ph_hi;
#define IN(k) (lo <= (k) && (k) < hi)
#define BOTH(k) (IN(k) && IN((k) + 1))

    if (IN(0)) for (int rep = 0; rep < NREP(0); ++rep) { phase_prologue(lds, args, vcu, G); if (BOTH(0)) SEAM(); }

    for (int L = 0; L < DEPTH; ++L) {
        const int pb = 1 + PH_PER_LAYER * L, mixer = L % 3, mj = L / 3, fj = L >> 1; const bool moe = (L & 1) != 0, prev_moe = (L > 0) && (((L - 1) & 1) != 0);
#define modL (bMOD + (size_t)L * NB * MOD_W)
#define modP (bMOD + (size_t)(L > 0 ? L - 1 : 0) * NB * MOD_W)
#define xin_first ((L == 0) ? karg_in(I_X) : (const float*)bX)
        if (IN(pb + 0)) for (int rep = 0; rep < NREP(pb + 0); ++rep) {
            NormArgs na{}; na.xin = xin_first; na.xout = (float*)bX; na.H = bH; na.sc = modL + D; na.sh = modL; na.combine = prev_moe; na.cscale = (float)(int)(ABLATE != 2 * (L - 1) + 1); na.Y = bY; na.tinfo = bTINFO; na.g2p = modP + 5 * D; na.cntp = bCTL + CW_CNT + 64 * ((L - 1) >> 1);
            if (mixer == 0) { na.wx = karg_in(I_GLA_WIN) + (size_t)mj * D * GLA_IN + 3072; na.wx_pitch = GLA_IN; na.w2 = karg_in(I_GLA_WG2) + (size_t)mj * 16 * 512; na.bvec = karg_in(I_GLA_BG) + mj * 512;
                na.Dk = (float*)(bSCR + S_DK); na.dref = (float*)(bSCR + S_DR); na.etot = (float*)(bSCR + S_ET); if (L == 0) norm_mfma2<1, true>(lds, na, opq(G)); else norm_mfma2<1, false>(lds, na, opq(G)); }
            else if (mixer == 1) { na.wx_pitch = CONV_FP8 ? -1 : 0; norm_phase<0>(lds, na, opq(G)); }
            else { na.wx = karg_in(I_FOX_WIN) + 3072; na.wx_pitch = FOX_IN; na.bvec = karg_in(I_FOX_BF); na.lf = bLF; norm_mfma2<2>(lds, na, opq(G)); }
            if (BOTH(pb + 0)) SEAM();
        }
        if (IN(pb + 1)) for (int rep = 0; rep < NREP(pb + 1); ++rep) {
            if (mixer == 0) {
                pg8::DenseSched S{NTOK / 256, 3072 / 256, opq(G), opq((int)blockIdx.x), 2 * D, (const char*)(bWS + W_GLA_IN + mj * SZ_GLA_IN)};
                pg8::EpiGlaIn E{(bf16_t*)(bSCR + S_QG), (bf16_t*)(bSCR + S_KD), (bf16_t*)(bSCR + S_V), (bf16_t*)(bSCR + S_R), (const float*)(bSCR + S_DK), (const float*)(bSCR + S_DR)};
                pg8::gemm_phase(lds, (const char*)bH, S, E);
            } else if (mixer == 1) {
                pg8::DenseSched S{NTOK / 256, 2048 / 256, opq(G), opq((int)blockIdx.x), CONV_FP8 ? D : 2 * D, (const char*)(bWS + W_CONV_IN)};
                pg8::EpiGated<1> E{(bf16_t*)bSCR, D, karg_in(I_CONV_BIN), 1024, CONV_FP8 ? 1.0f / F8_W13 : 1.0f, 1.0f};
                pg8::gemm_phase<pg8::EpiGated<1>, pg8::DenseSched, CONV_FP8 != 0>(lds, (const char*)bH, S, E);
            } else {
                if (rep == 0) fox_cum_phase(lds, bLF, (float*)(bWS + WS_CUMG), opq(G));
                pg8::DenseSched S{NTOK / 256, 4096 / 256, opq(G), opq((int)blockIdx.x), 2 * D, (const char*)(bWS + W_FOX_IN)};
                pg8::EpiFoxIn E{(bf16_t*)(bSCR + S_FQ), (bf16_t*)(bSCR + S_FK), (bf16_t*)(bSCR + S_FV), (bf16_t*)(bSCR + S_FG), karg_in(I_FOX_QN), karg_in(I_FOX_KN)};
                pg8::gemm_phase(lds, (const char*)bH, S, E);
            }
            if (BOTH(pb + 1)) SEAM();
        }
        if (IN(pb + 2)) for (int rep = 0; rep < NREP(pb + 2); ++rep) {
            if (mixer == 0) gla_scan_mfma(lds, (const bf16_t*)(bSCR + S_QG), (const bf16_t*)(bSCR + S_KD), (const bf16_t*)(bSCR + S_V), (const float*)(bSCR + S_ET), (bf16_t*)(bSCR + S_O), opq(vcu), opq(G));
            else if (mixer == 1) conv_phase(lds, (const bf16_t*)bSCR, karg_in(I_CONV_DW), karg_in(I_CONV_DWB), karg_in(I_CONV_LNG), karg_in(I_CONV_LNB), bA2, opq(vcu), opq(G));
            else fox_attn_phase(lds_raw, lds, karg_in(I_FOX_QN), karg_in(I_FOX_KN));
            if (BOTH(pb + 2)) SEAM();
        }
        if (IN(pb + 3)) for (int rep = 0; rep < NREP(pb + 3); ++rep) {
            if (mixer == 0) { gla_gn_phase((const bf16_t*)(bSCR + S_O), (const bf16_t*)(bSCR + S_R), karg_in(I_GLA_GN) + mj * D, bA2, opq(vcu), opq(G)); if (BOTH(pb + 3)) SEAM(); }
        }
        if (IN(pb + 4)) for (int rep = 0; rep < NREP(pb + 4); ++rep) {
            const float* wsrc = nullptr; const float* bias = nullptr; size_t woff = 0;
            if (mixer == 0) woff = W_GLA_OUT + mj * SZ_SQ; else if (mixer == 1) { woff = W_CONV_OUT; bias = karg_in(I_CONV_BOUT); } else woff = W_FOX_OUT;
            (void)wsrc;
            pg8::DenseSched S{NTOK / 256, D / 256, opq(G), opq((int)blockIdx.x), 2 * D, (const char*)(bWS + woff)};
            pg8::EpiOut E{(L == 0) ? karg_in(I_X) : (const float*)nullptr, bX, bX, modL + 2 * D, bias, (float)(int)(ABLATE != 2 * L)};
            pg8::gemm_phase(lds, (const char*)bA2, S, E);
            if (BOTH(pb + 4)) SEAM();
        }
        if (IN(pb + 5)) for (int rep = 0; rep < NREP(pb + 5); ++rep) {
            NormArgs na{}; na.xin = (const float*)bX; na.xout = (float*)bX; na.H = bH; na.sc = modL + 4 * D; na.sh = modL + 3 * D; na.combine = false;
            if (!moe) { na.wx_pitch = FFN_FP8 ? -1 : 0; norm_phase<0>(lds, na, opq(G)); if (DUP_NORM == 1) { __syncthreads(); norm_phase<0>(lds, na, opq(G)); } }
            else { na.wx = karg_in(I_MOE_R) + (size_t)fj * D * NE; na.wx_pitch = NE; na.tok = bTOK; na.tinfo_out = bTINFO; na.cnt = bCTL + CW_CNT + 64 * fj; norm_mfma2<3>(lds, na, opq(G)); }
            if (BOTH(pb + 5)) SEAM();
        }
        if (IN(pb + 6)) for (int rep = 0; rep < NREP(pb + 6); ++rep) {
            if (!moe) {
                pg8::DenseSched S{NTOK / 256, 2 * DFF / 256, opq(G), opq((int)blockIdx.x), FFN_FP8 ? D : 2 * D, (const char*)(bWS + W_FFN13 + fj * SZ_FFN13)};
                pg8::EpiGated<0> E{(bf16_t*)bSCR, DFF, nullptr, DFF, FFN_FP8 ? 1.0f / F8_W13 : 1.0f, 1.0f};
                pg8::gemm_phase<pg8::EpiGated<0>, pg8::DenseSched, FFN_FP8 != 0>(lds, (const char*)bH, S, E);
            } else {
                moe_tab(lds, bCTL + CW_CNT + 64 * fj);
                const LAS int* TAB = (const LAS int*)(lds + LDS_TAB);
                pg8::MoeSched S{TAB[8], 2 * DFE / 256, opq(G), opq((int)blockIdx.x), MOE_FP8 ? D : 2 * D, (const char*)(bWS + W_MOE13 + (size_t)fj * 8 * MOE13_STRIDE), MOE13_STRIDE, bTOK, TAB};
                pg8::EpiGated<0, MOE_FP8 != 0> E{(bf16_t*)bSCR, DFE, nullptr, DFE, MOE_FP8 ? 1.0f / F8_W13 : 1.0f, F8_HID};
                pg8::gemm_phase<pg8::EpiGated<0, MOE_FP8 != 0>, pg8::MoeSched, MOE_FP8 != 0>(lds, (const char*)bH, S, E);
            }
            if (BOTH(pb + 6)) SEAM();
        }
        if (IN(pb + 7)) for (int rep = 0; rep < NREP(pb + 7); ++rep) {
            if (!moe) {
                pg8::DenseSched S{NTOK / 256, D / 256, opq(G), opq((int)blockIdx.x), 2 * DFF, (const char*)(bWS + W_FFN2 + fj * SZ_FFN2)};
                pg8::EpiOut E{nullptr, bX, bX, modL + 5 * D, nullptr, (float)(int)(ABLATE != 2 * L + 1)};
                pg8::gemm_phase(lds, (const char*)bSCR, S, E);
            } else {
                moe_tab(lds, bCTL + CW_CNT + 64 * fj);
                const LAS int* TAB = (const LAS int*)(lds + LDS_TAB);
                pg8::MoeSched S{TAB[8], D / 256, opq(G), opq((int)blockIdx.x), MOE_FP8 ? DFE : 2 * DFE, (const char*)(bWS + W_MOE2 + (size_t)fj * 8 * MOE2_STRIDE), MOE2_STRIDE, nullptr, TAB};
                pg8::EpiBf16 E{bY, D, MOE_FP8 ? 1.0f / (F8_HID * F8_W2) : 1.0f};
                pg8::gemm_phase<pg8::EpiBf16, pg8::MoeSched, MOE_FP8 != 0>(lds, (const char*)bSCR, S, E);
            }
            if (BOTH(pb + 7)) SEAM();
        }
    }
    if (IN(N_PHASES - 1)) {
        NormArgs na{}; na.xin = (const float*)bX; na.xout = (float*)bX; na.combine = true; na.cscale = (ABLATE == 7) ? 0.f : 1.f; na.Y = bY; na.tinfo = bTINFO; na.g2p = bMOD + (size_t)3 * NB * MOD_W + 5 * D; na.cntp = bCTL + CW_CNT + 64 * 1;
        na.gamma = karg_in(I_NORMF); na.out = args.out;
        norm_phase<4>(lds, na, G);
        if (DUP_NORM == 4) { __syncthreads(); norm_phase<4>(lds, na, G); }
    }
#undef IN
#undef BOTH
#undef SEAM
#undef bWS
#undef bCTL
#undef bMOD
#undef bX
#undef bH
#undef bY
#undef bTOK
#undef bTINFO
#undef bLF
#undef bSCR
#undef bA2
#undef modL
#undef modP
#undef xin_first
}


#ifdef DBG_CHECK
constexpr int CW_DBG = 20000;
__global__ void dbg_check_router(const float* X, const float* mod  , const float* router, const u32x4* tinfo, const int* tok, unsigned* flags) {
    const int row = blockIdx.x * blockDim.x + threadIdx.x; if (row >= NTOK) return;
    const int b = row / SEQ; const float* x = X + (size_t)row * D; const float* sc = mod + (size_t)b * MOD_W + 4 * D; const float* sh = mod + (size_t)b * MOD_W + 3 * D;
    float ss = 0.f; for (int k = 0; k < D; ++k) ss += x[k] * x[k];
    const float rstd = 1.0f / sqrtf(ss / D + EPS);
    float lg[8]; for (int n = 0; n < 8; ++n) lg[n] = 0.f;
    for (int k = 0; k < D; ++k) { const float h = x[k] * rstd * (1.0f + sc[k]) + sh[k]; for (int n = 0; n < 8; ++n) lg[n] += h * router[k * 8 + n]; }
    int e0 = 0; for (int n = 1; n < 8; ++n) if (lg[n] > lg[e0]) e0 = n;
    int e1 = -1; for (int n = 0; n < 8; ++n) if (n != e0 && (e1 < 0 || lg[n] > lg[e1])) e1 = n;
    float l2 = -1e30f; for (int n = 0; n < 8; ++n) if (n != e0 && n != e1 && lg[n] > l2) l2 = lg[n];
    const float g0 = 1.0f / (1.0f + expf(lg[e1] - lg[e0]));
    const u32x4 ti = tinfo[row]; const int k0 = ti.x >> 15, k1 = ti.y >> 15;
    const bool safe = (lg[e0] - lg[e1] > 1e-3f) && (lg[e1] - l2 > 1e-3f);
    if (safe && (k0 != e0 || k1 != e1)) atomicAdd(flags + 0, 1u);
    if (safe && fabsf(__uint_as_float(ti.z) - g0) > 2e-3f) atomicAdd(flags + 1, 1u);
    if (safe && fabsf(__uint_as_float(ti.w) - (1.0f - g0)) > 2e-3f) atomicAdd(flags + 1, 1u);
    if (tok[ti.x] != row || tok[ti.y] != row) atomicAdd(flags + 2, 1u);
}
#ifndef DBG_FLAG
#define DBG_FLAG 0
#endif
__global__ void dbg_report(const unsigned* flags, float* out) {
    if (threadIdx.x == 0 && blockIdx.x == 0) out[0] = 50.0f + (float)flags[DBG_FLAG];
}
#endif
extern "C" void kernel_launch(void* const* d_in, const int* in_sizes, int n_in, void* d_out, int out_size, void* d_ws, size_t ws_size, hipStream_t stream) {
    static int grid = 0;
    if (grid == 0) {
        if (n_in != 28 || in_sizes[0] != NTOK * D || out_size != NTOK * D || ws_size < WS_END) {
            fprintf(stderr, "kernel_launch: unexpected shapes (n_in %d, in0 %d, out %d, ws %zu, need %zu); nothing launched\n", n_in, n_in > 0 ? in_sizes[0] : -1, out_size, ws_size, (size_t)WS_END); grid = -1; return; }
        int dev = 0, cus = 0, per_cu = 0;
        if (hipGetDevice(&dev) != hipSuccess || hipDeviceGetAttribute(&cus, hipDeviceAttributeMultiprocessorCount, dev) != hipSuccess) { grid = -1; return; }
        if (hipFuncSetAttribute((const void*)mk_fwd, hipFuncAttributeMaxDynamicSharedMemorySize, LDS_BYTES) != hipSuccess) { fprintf(stderr, "kernel_launch: hipFuncSetAttribute failed\n"); grid = -1; return; }
        if (hipOccupancyMaxActiveBlocksPerMultiprocessor(&per_cu, (const void*)mk_fwd, NTHR, LDS_BYTES) != hipSuccess || per_cu < 1)
            fprintf(stderr, "kernel_launch: note: occupancy query reports %d workgroups per CU\n", per_cu);
        (void)hipGetLastError();
        grid = cus;
    }
    if (grid < 0) return;
    if (hipMemsetAsync((char*)d_ws + WS_CTL, 0, CTL_ZERO_BYTES, stream) != hipSuccess) return;
    Args a{};
    for (int i = 0; i < 28; ++i) a.in[i] = (const float*)d_in[i];
    a.out = (float*)d_out; a.ws = (unsigned char*)d_ws;
#if MK_N_LAUNCHES == 1
    a.ph_lo = 0; a.ph_hi = N_PHASES;
    hipLaunchKernelGGL(mk_fwd, dim3(grid), dim3(NTHR), LDS_BYTES, stream, a);
#else
    for (int p = 0; p < N_PHASES; ++p) {
        const int L = (p - 1) / PH_PER_LAYER, slot = (p - 1) % PH_PER_LAYER;
        if (p >= 1 && p < N_PHASES - 1 && slot == 3 && (L % 3) != 0) continue;
        a.ph_lo = p; a.ph_hi = p + 1;
        hipLaunchKernelGGL(mk_fwd, dim3(grid), dim3(NTHR), LDS_BYTES, stream, a);
#ifdef DBG_CHECK
        if (p >= 1 && p < N_PHASES - 1 && slot == 5 && (L & 1)) {
            unsigned char* ws = (unsigned char*)d_ws;
            hipLaunchKernelGGL(dbg_check_router, dim3(NTOK / 256), dim3(256), 0, stream, (const float*)(ws + WS_X), (const float*)(ws + WS_MOD) + (size_t)L * NB * MOD_W, a.in[I_MOE_R] + (size_t)(L >> 1) * D * NE,
                               (const u32x4*)(ws + WS_TINFO), (const int*)(ws + WS_TOK), (unsigned*)(ws + WS_CTL) + CW_DBG + 4 * (L >> 1));
        }
#endif
    }
#ifdef DBG_CHECK
    hipLaunchKernelGGL(dbg_report, dim3(1), dim3(64), 0, stream, (const unsigned*)((unsigned char*)d_ws + WS_CTL) + CW_DBG, (float*)d_out);
#endif
#endif
}
```

```cpp
#include <hip/hip_runtime.h>
#include <cstdio>
#include <cstdint>
#include <utility>

#ifndef MK_N_LAUNCHES
#define MK_N_LAUNCHES 1
#endif
#ifndef DUP_PH
#define DUP_PH -1
#endif
#define NREP(p) ((DUP_PH == (p)) ? 2 : 1)
#ifndef DUP_NORM
#define DUP_NORM 0
#endif
#ifndef MOE_FP8
#define MOE_FP8 1
#endif
#ifndef FFN_FP8
#ifndef FOXG_FP8
#define FOXG_FP8 1
#endif
#ifndef CONV_FP8
#define CONV_FP8 1
#endif
#define FFN_FP8 1
#endif
#ifndef ABLATE
#define ABLATE -1
#endif

#define LAS __attribute__((address_space(3)))
#define GAS __attribute__((address_space(1)))
typedef unsigned short bf16_t;
typedef short bf16x8 __attribute__((ext_vector_type(8)));
typedef float f32x4 __attribute__((ext_vector_type(4)));
typedef float f32x2 __attribute__((ext_vector_type(2)));
typedef unsigned u32x4 __attribute__((ext_vector_type(4)));
typedef unsigned u32x2 __attribute__((ext_vector_type(2)));
typedef __bf16 bf16x2_t __attribute__((ext_vector_type(2)));

constexpr int NB = 8, SEQ = 4096, D = 1024, NTOK = NB * SEQ, DEPTH = 4;
constexpr int GLA_IN = 3088, FOX_IN = 4112, DFF = 2816, DFE = 3584, NE = 8, MOD_W = 6 * D;
constexpr int CONVW = 31;
constexpr float EPS = 1e-6f;
constexpr float LOG2E = 1.4426950408889634f;
constexpr float QSCALE = 0.125f * LOG2E;
constexpr int NTHR = 512, NWAVES = 8;
constexpr int MOE_CAP = NTOK;
constexpr int MOE_MAXT = NTOK * 2 / 256 + NE;

constexpr size_t MiB = 1u << 20;
constexpr size_t WS_CTL = 0, CTL_ZERO_BYTES = 128 * 1024;
constexpr size_t WS_MOD = 1 * MiB;
constexpr size_t WS_W = 2 * MiB;
constexpr size_t SZ_GLA_IN = (size_t)3072 * D * 2, SZ_SQ = (size_t)D * D * 2, SZ_CONV_IN = (size_t)2048 * D * 2, SZ_FOX_IN = (size_t)4096 * D * 2;
constexpr size_t SZ_FFN13 = (size_t)2 * DFF * D * 2, SZ_FFN2 = (size_t)D * DFF * 2, SZ_MOE13 = (size_t)2 * DFE * D * 2, SZ_MOE2 = (size_t)D * DFE * 2;
constexpr size_t W_GLA_IN = WS_W, W_GLA_OUT = W_GLA_IN + 2 * SZ_GLA_IN, W_CONV_IN = W_GLA_OUT + 2 * SZ_SQ, W_CONV_OUT = W_CONV_IN + SZ_CONV_IN;
constexpr size_t W_FOX_IN = W_CONV_OUT + SZ_SQ, W_FOX_OUT = W_FOX_IN + SZ_FOX_IN, W_FFN13 = W_FOX_OUT + SZ_SQ, W_FFN2 = W_FFN13 + 2 * SZ_FFN13;
constexpr size_t W_MOE13 = W_FFN2 + 2 * SZ_FFN2, W_MOE2 = W_MOE13 + 16 * SZ_MOE13, W_END = W_MOE2 + 16 * SZ_MOE2;
constexpr size_t MOE13_STRIDE = MOE_FP8 ? SZ_MOE13 / 2 : SZ_MOE13, MOE2_STRIDE = MOE_FP8 ? SZ_MOE2 / 2 : SZ_MOE2;
constexpr size_t WS_X = (W_END + MiB - 1) / MiB * MiB;
constexpr size_t WS_H = WS_X + (size_t)NTOK * D * 4;
constexpr size_t WS_Y = WS_H + (size_t)NTOK * D * 2;
constexpr size_t WS_TOK = WS_Y + (size_t)MOE_MAXT * 256 * D * 2;
constexpr size_t WS_TINFO = WS_TOK + (size_t)NE * MOE_CAP * 4;
constexpr size_t WS_LF = WS_TINFO + (size_t)NTOK * 16;
constexpr size_t WS_CUMG = WS_LF + (size_t)NTOK * 16 * 4;
constexpr size_t WS_SCR = WS_CUMG + (size_t)NB * 16 * SEQ * 4;
constexpr size_t SCR_BYTES = (size_t)MOE_MAXT * 256 * DFE * 2;
constexpr size_t WS_H8 = WS_SCR + SCR_BYTES;
constexpr size_t WS_END = WS_H8 + (size_t)NTOK * D;
constexpr size_t S_QG = 0, S_KD = S_QG + (size_t)NTOK * 512 * 2, S_V = S_KD + (size_t)NTOK * 512 * 2, S_R = S_V + (size_t)NTOK * D * 2;
constexpr size_t S_DK = S_R + (size_t)NTOK * D * 2, S_ET = S_DK + (size_t)NTOK * 512 * 4, S_DR = S_ET + (size_t)512 * 512 * 4, S_O = S_DR + (size_t)512 * 8 * 512 * 4, S_A2 = S_O + (size_t)NTOK * D * 2;
static_assert(S_A2 + (size_t)NTOK * D * 2 <= SCR_BYTES, "GLA scratch");
constexpr size_t S_FQ = 0, S_FK = (size_t)NTOK * D * 2, S_FV = 2 * S_FK, S_FG = 3 * S_FK;
static_assert(4 * S_FK <= S_A2, "fox scratch");
constexpr int CW_BAR = 4096;
constexpr int CW_ATTQ = 16384 + 512;
constexpr int CW_CNT = 16384;

__device__ __forceinline__ int opaque_tid() { int t = threadIdx.x; asm volatile("" : "+v"(t)); return t; }
#define FENCE() do { asm volatile("" ::: "memory"); __builtin_amdgcn_sched_barrier(0); } while (0)
__device__ __forceinline__ unsigned pk2(float lo, float hi) { f32x2 v = {lo, hi}; bf16x2_t b = __builtin_convertvector(v, bf16x2_t); return __builtin_bit_cast(unsigned, b); }
constexpr float F8_W13 = 32.0f, F8_HID = 4.0f, F8_W2 = 64.0f;
__device__ __forceinline__ float f8clamp(float x) { return __builtin_amdgcn_fmed3f(x, -448.0f, 448.0f); }
__device__ __forceinline__ unsigned pk4_fp8(float a, float b, float c, float d) { int w = __builtin_amdgcn_cvt_pk_fp8_f32(f8clamp(a), f8clamp(b), 0, false); w = __builtin_amdgcn_cvt_pk_fp8_f32(f8clamp(c), f8clamp(d), w, true); return (unsigned)w; }
__device__ __forceinline__ float bf_lo(unsigned w) { return __uint_as_float(w << 16); }
__device__ __forceinline__ float bf_hi(unsigned w) { return __uint_as_float(w & 0xffff0000u); }
__device__ __forceinline__ float wave_sum(float v) {
    asm volatile("s_nop 1\n\t"
                 "v_add_f32_dpp %0, %0, %0 quad_perm:[1,0,3,2] row_mask:0xf bank_mask:0xf\n\ts_nop 1\n\t"
                 "v_add_f32_dpp %0, %0, %0 quad_perm:[2,3,0,1] row_mask:0xf bank_mask:0xf\n\ts_nop 1\n\t"
                 "v_add_f32_dpp %0, %0, %0 row_half_mirror row_mask:0xf bank_mask:0xf\n\ts_nop 1\n\t"
                 "v_add_f32_dpp %0, %0, %0 row_mirror row_mask:0xf bank_mask:0xf\n\ts_nop 1\n\t"
                 "v_add_f32_dpp %0, %0, %0 row_bcast:15 row_mask:0xa bank_mask:0xf\n\ts_nop 1\n\t"
                 "v_add_f32_dpp %0, %0, %0 row_bcast:31 row_mask:0xc bank_mask:0xf\n\ts_nop 1" : "+v"(v));
    return __uint_as_float((unsigned)__builtin_amdgcn_readlane((int)__float_as_uint(v), 63));
}
template <int N> __device__ __forceinline__ void xreduce(float (&v)[N], int lane) {
    constexpr int LG = (N == 64) ? 6 : (N == 32) ? 5 : (N == 16) ? 4 : (N == 8) ? 3 : 0;
    static_assert(LG > 0, "xreduce N");
#pragma unroll
    for (int s = 0; s < LG; ++s) {
        const int off = 32 >> s, n = N >> (s + 1);
        const bool hi = (lane & off) != 0;
#pragma unroll
        for (int i = 0; i < n; ++i) { float lo_v = v[i], hi_v = v[i + n]; asm volatile("" : "+v"(lo_v), "+v"(hi_v));
            const float keep = hi ? hi_v : lo_v; const float send = hi ? lo_v : hi_v; v[i] = keep + __shfl_xor(send, off); }
    }
#pragma unroll
    for (int off = (32 >> LG); off >= 1; off >>= 1) v[0] += __shfl_xor(v[0], off);
}
__device__ __forceinline__ float fast_sigmoid(float x) { return __builtin_amdgcn_rcpf(1.0f + __expf(-x)); }
__device__ __forceinline__ float fast_silu(float x) { return x * fast_sigmoid(x); }
__device__ __forceinline__ float log_sigmoid(float z) { return fminf(z, 0.f) - 0.6931471805599453f * __builtin_amdgcn_logf(1.0f + __builtin_amdgcn_exp2f(-LOG2E * fabsf(z))); }

#define XB_TMO      128
#define XB_XCNT(j)  (256  + 64 * (j))
#define XB_XSUB(j)  (1280 + 64 * (j))
#define XB_XGEN(j)  (2304 + 64 * (j))
#define XB_TOP      3328
#define XB_TOPGEN   3392
#define XCD_BAR_WORDS 3456
#define XB_SPIN_CAP (1u << 22)
__device__ __forceinline__ unsigned xb_ld(unsigned* p)              { return __hip_atomic_load(p, __ATOMIC_RELAXED, __HIP_MEMORY_SCOPE_AGENT); }
__device__ __forceinline__ unsigned xb_add(unsigned* p, unsigned v) { return __hip_atomic_fetch_add(p, v, __ATOMIC_RELAXED, __HIP_MEMORY_SCOPE_AGENT); }
__device__ __forceinline__ unsigned xb_xcc_id() { return (unsigned)__builtin_amdgcn_s_getreg((3 << 11) | 20) & 0xFu; }
#define XB_SPIN(cond, bar) do { unsigned _sp = 0; while (cond) { __builtin_amdgcn_s_sleep(1); \
    if ((++_sp & 255u) == 0u) { if (xb_ld(&(bar)[XB_TMO])) break; if (_sp > XB_SPIN_CAP) { atomicAdd(&(bar)[XB_TMO], 1u); break; } } } } while (0)
struct XcdBarrier { unsigned* bar; unsigned x; volatile LAS unsigned* st; };
__device__ __forceinline__ XcdBarrier xcd_barrier_post(unsigned* bar, volatile LAS unsigned* st) {
    XcdBarrier b; b.bar = bar; b.x = xb_xcc_id(); b.st = st;
    if (threadIdx.x == 0) (void)xb_add(&bar[XB_XCNT(b.x)], 1u);
    return b;
}
__device__ __forceinline__ void xcd_barrier_complete(unsigned* bar, unsigned x, unsigned& nloc, unsigned& nx) {
    const unsigned G = gridDim.x * gridDim.y * gridDim.z;
    unsigned sum, cnt, mine, sp = 0u;
    for (;;) {
        sum = 0u; cnt = 0u; mine = 0u;
#pragma unroll
        for (unsigned j = 0; j < 16; ++j) { const unsigned c = xb_ld(&bar[XB_XCNT(j)]); sum += c; cnt += (c > 0u) ? 1u : 0u; mine = (j == x) ? c : mine; }
        if (sum == G) break;
        __builtin_amdgcn_s_sleep(1);
        if ((++sp & 255u) == 0u) { if (xb_ld(&bar[XB_TMO])) break; if (sp > XB_SPIN_CAP) { atomicAdd(&bar[XB_TMO], 1u); break; } }
    }
    nloc = mine > 0u ? mine : 1u; nx = cnt > 0u ? cnt : 1u;
}
__device__ __forceinline__ void xcd_barrier(const XcdBarrier& b) {
    asm volatile("s_waitcnt vmcnt(0)" ::: "memory");
    __syncthreads();
    if (threadIdx.x == 0) {
        unsigned* bar = b.bar; unsigned bx = b.x;
        asm volatile("" : "+s"(bar), "+s"(bx));
        __builtin_amdgcn_s_waitcnt(0);
        unsigned nloc = b.st[0], nx = b.st[1];
        if (nloc == 0u) { xcd_barrier_complete(bar, bx, nloc, nx); b.st[0] = nloc; b.st[1] = nx; }
        const unsigned old = xb_add(&bar[XB_XSUB(bx)], 1u);
        const unsigned gen = old / nloc;
        if (old + 1u == (gen + 1u) * nloc) {
            __builtin_amdgcn_fence(__ATOMIC_RELEASE, "agent");
            asm volatile("s_waitcnt vmcnt(0)" ::: "memory");
            const unsigned og = xb_add(&bar[XB_TOP], 1u);
            const unsigned tg = og / nx;
            if (og + 1u == (tg + 1u) * nx) xb_add(&bar[XB_TOPGEN], 1u);
            else XB_SPIN(xb_ld(&bar[XB_TOPGEN]) == tg, bar);
            __builtin_amdgcn_fence(__ATOMIC_ACQUIRE, "agent");
            xb_add(&bar[XB_XGEN(bx)], 1u);
            asm volatile("s_waitcnt vmcnt(0)" ::: "memory");
        } else {
            XB_SPIN(xb_ld(&bar[XB_XGEN(bx)]) == gen, bar);
            __builtin_amdgcn_fence(__ATOMIC_ACQUIRE, "agent");
            asm volatile("s_waitcnt vmcnt(0)" ::: "memory");
        }
    }
    __syncthreads();
}

namespace pg8 {
constexpr int BM = 256, BK = 64, HALF = 128, HTB = HALF * BK * 2, STAGE_BYTES = 8 * HTB, NXCD = 8, WGM = 8;
__host__ __device__ __forceinline__ int lds_byte(int r, int c) { const int st = (r >> 4) * 2 + (c >> 5), rr = r & 15, cc = c & 31, ob = rr * 64 + cc * 2; return st * 1024 + (ob ^ (((ob >> 9) & 1) << 5)); }
__host__ __device__ __forceinline__ void stage_rc(int b, int& R, int& C) { const int st = b / 1024, sb = b % 1024, swz = sb ^ (((sb >> 9) & 1) << 5); R = (st >> 1) * 16 + swz / 64; C = (st & 1) * 32 + (swz % 64) / 2; }
__host__ __device__ __forceinline__ int perm32(int rho) { const int n = rho >> 4, i = rho & 15; return 8 * (i >> 2) + 4 * n + (i & 3); }
struct Unit { int pm, pn, e; };

__device__ __forceinline__ bool order_next(int i, int G, int c, int nM, int nN, int& pm, int& pn) {
    const int nwg = nM * nN; const long L = (long)i * G + c; if (L >= nwg) return false;
    int wgid = (int)L; { const int q = nwg / NXCD, r = nwg % NXCD, xcd = wgid % NXCD, off = wgid / NXCD; wgid = (xcd < r ? xcd * (q + 1) : r * (q + 1) + (xcd - r) * q) + off; }
    const int nig = WGM * nN, gid = wgid / nig, fm = gid * WGM, gsz = (nM - fm) < WGM ? (nM - fm) : WGM;
    pm = fm + ((wgid % nig) % gsz); pn = (wgid % nig) / gsz; return true;
}
struct DenseSched {
    int nM, nN, G, c, KB; const char* Bt;
    __device__ __forceinline__ bool next(int i, Unit& u) const { u.e = 0; return order_next(i, G, c, nM, nN, u.pm, u.pn); }
    __device__ __forceinline__ int row(const Unit& u, int lr) const { return u.pm * BM + lr; }
    __device__ __forceinline__ const char* b_tile(const Unit& u) const { return Bt + (size_t)u.pn * BM * KB; }
};
struct MoeSched {
    int nM, nN, G, c, KB; const char* Bt; size_t estride; const int* tok; const LAS int* tab;
    __device__ __forceinline__ bool next(int i, Unit& u) const {
        if (!order_next(i, G, c, nM, nN, u.pm, u.pn)) return false;
        int e = 0;
#pragma unroll
        for (int j = 1; j < NE; ++j) e = (u.pm >= tab[j]) ? j : e;
        u.e = e; return true;
    }
    __device__ __forceinline__ int row(const Unit& u, int lr) const {
        if (tok == nullptr) return u.pm * BM + lr;
        const int pos = (u.pm - tab[u.e]) * BM + lr;
        return pos < tab[16 + u.e] ? tok[u.e * MOE_CAP + pos] : 0;
    }
    __device__ __forceinline__ const char* b_tile(const Unit& u) const { return Bt + (size_t)u.e * estride + (size_t)u.pn * BM * KB; }
};

typedef int v8i32 __attribute__((ext_vector_type(8)));
__device__ __forceinline__ const char* uni_ptr(const char* p) { const unsigned long long v = (unsigned long long)p; const unsigned lo = (unsigned)__builtin_amdgcn_readfirstlane((int)(unsigned)v), hi = (unsigned)__builtin_amdgcn_readfirstlane((int)(unsigned)(v >> 32)); return (const char*)(((unsigned long long)hi << 32) | lo); }
__device__ __forceinline__ v8i32 cat8(bf16x8 lo, bf16x8 hi) { const u32x4 a = __builtin_bit_cast(u32x4, lo), b = __builtin_bit_cast(u32x4, hi); return (v8i32){(int)a.x, (int)a.y, (int)a.z, (int)a.w, (int)b.x, (int)b.y, (int)b.z, (int)b.w}; }
template <class Epi, class Sched, bool FP8 = false>
__device__ __forceinline__ void gemm_phase(LAS unsigned char* lds, const char* Abase, const Sched& S, const Epi& E) {
    const int tid = opaque_tid(), wid = __builtin_amdgcn_readfirstlane(tid >> 6), lane = tid & 63, wr = wid >> 2, wc = wid & 3, fr = lane & 15, fq = lane >> 4;
    const int KB = S.KB, nt = KB / (BK * 2);
    int Rp[2], Cp[2]; unsigned voffB[2];
#pragma unroll
    for (int i = 0; i < 2; ++i) { int R, C; stage_rc(tid * 16 + i * 8192, R, C); Rp[i] = R; Cp[i] = C; const int Rb = Epi::PERM ? ((R & ~31) + perm32(R & 31)) : R; voffB[i] = (unsigned)(Rb * KB + C * 2); }
    const size_t kstep = (size_t)(BK * 2);
    const size_t hstep = (size_t)HALF * KB;
    const unsigned ldsw = (unsigned)wid * 1024u;
    const unsigned lds0 = (unsigned)__builtin_amdgcn_readfirstlane((int)((unsigned)(size_t)lds + ldsw));
    const int aoff = lds_byte(wr * 64 + fr, fq * 8), boff = lds_byte(wc * 32 + fr, fq * 8);
#define PG8_SA(b, h) (((b) * 2 + (h)) * HTB)
#define PG8_SB(b, h) ((4 + (b) * 2 + (h)) * HTB)
#define PG8_GLDS(sbase, voff32, ldsdst) do { unsigned _keep; asm volatile("s_mov_b32 %0, m0\n\ts_mov_b32 m0, %3\n\ts_nop 0\n\tglobal_load_lds_dwordx4 %1, %2\n\ts_mov_b32 m0, %0" \
        : "=&s"(_keep) : "v"(voff32), "s"(sbase), "s"(ldsdst) : "memory"); } while (0)
#define PG8_STAGE(bufoff, gbase, voff) do { const char* _sb = uni_ptr((const char*)(gbase)); _Pragma("unroll") for (int _i = 0; _i < 2; ++_i) \
        PG8_GLDS(_sb, (voff)[_i], lds0 + (unsigned)((bufoff) + _i * 8192)); } while (0)
#define PG8_STAGEA(bufoff, ra2, koff) do { const char* _sb = uni_ptr(Abase + (size_t)(koff)); _Pragma("unroll") for (int _i = 0; _i < 2; ++_i) \
        PG8_GLDS(_sb, (ra2)[_i], lds0 + (unsigned)((bufoff) + _i * 8192)); } while (0)
#define PG8_LDA(dst, b, h) do { _Pragma("unroll") for (int m = 0; m < 4; ++m) _Pragma("unroll") for (int k = 0; k < 2; ++k) dst[m][k] = *(const LAS bf16x8*)(lds + PG8_SA(b, h) + aoff + m * 2048 + k * 1024); } while (0)
#define PG8_LDB(dst, b, h) do { _Pragma("unroll") for (int n = 0; n < 2; ++n) _Pragma("unroll") for (int k = 0; k < 2; ++k) dst[n][k] = *(const LAS bf16x8*)(lds + PG8_SB(b, h) + boff + n * 2048 + k * 1024); } while (0)
#define PG8_MMA(ai, bj, At, Bt) do { __builtin_amdgcn_s_setprio(1); _Pragma("unroll") for (int m = 0; m < 4; ++m) _Pragma("unroll") for (int n = 0; n < 2; ++n) { \
        if constexpr (FP8) { const v8i32 _b8 = cat8(Bt[n][0], Bt[n][1]), _a8 = cat8(At[m][0], At[m][1]); \
            asm volatile("v_mfma_scale_f32_16x16x128_f8f6f4 %0, %1, %2, %0, %3, %3 op_sel_hi:[0,0,0]" : "+v"(acc[ai][bj][m][n]) : "v"(_b8), "v"(_a8), "v"(f8one)); } \
        else { _Pragma("unroll") for (int k = 0; k < 2; ++k) acc[ai][bj][m][n] = __builtin_amdgcn_mfma_f32_16x16x32_bf16(Bt[n][k], At[m][k], acc[ai][bj][m][n], 0, 0, 0); } } \
        __builtin_amdgcn_s_setprio(0); } while (0)
#define PG8_WAIT_V(n) asm volatile("s_waitcnt vmcnt(" #n ")" ::: "memory")
#define PG8_WAIT_L(n) asm volatile("s_waitcnt lgkmcnt(" #n ")" ::: "memory")
#define PG8_BAR __builtin_amdgcn_s_barrier()
#define PG8_SCHED __builtin_amdgcn_sched_barrier(0)
#define PG8_ROWS(u, ra) do { _Pragma("unroll") for (int _h = 0; _h < 2; ++_h) _Pragma("unroll") for (int _i = 0; _i < 2; ++_i) \
        ra[_h][_i] = (unsigned)(S.row(u, _h * HALF + Rp[_i]) * KB + Cp[_i] * 2); } while (0)
    unsigned f8one = 0x7F7F7F7Fu; asm volatile("" : "+v"(f8one));
    Unit cur, nxt; int ui = 0;
    if (!S.next(0, cur)) return;
    bool has_next = S.next(1, nxt);
    unsigned ra_cur[2][2], ra_nxt[2][2];
    PG8_ROWS(cur, ra_cur);
    if (has_next) { PG8_ROWS(nxt, ra_nxt); } else {
#pragma unroll
        for (int h = 0; h < 2; ++h) { ra_nxt[h][0] = ra_cur[h][0]; ra_nxt[h][1] = ra_cur[h][1]; } }
    f32x4 acc[2][2][4][2];
#pragma unroll
    for (int a = 0; a < 2; ++a)
#pragma unroll
        for (int b = 0; b < 2; ++b)
#pragma unroll
            for (int m = 0; m < 4; ++m)
#pragma unroll
                for (int n = 0; n < 2; ++n) acc[a][b][m][n] = (f32x4){0.f, 0.f, 0.f, 0.f};
    bf16x8 At[4][2], B0[2][2], B1[2][2];
    const char* cB = S.b_tile(cur);
    PG8_STAGE(PG8_SB(0, 0), cB, voffB); PG8_STAGE(PG8_SB(0, 1), cB + hstep, voffB); PG8_STAGEA(PG8_SA(0, 0), ra_cur[0], 0); PG8_STAGEA(PG8_SA(0, 1), ra_cur[1], 0);
    if (wr == 1) PG8_BAR;
    PG8_WAIT_V(2); PG8_BAR;
    PG8_STAGE(PG8_SB(1, 0), cB + kstep, voffB); PG8_STAGEA(PG8_SA(1, 0), ra_cur[0], kstep); PG8_STAGE(PG8_SB(1, 1), cB + hstep + kstep, voffB);
    PG8_WAIT_V(6); PG8_BAR;
    for (;;) {
        const char* nB = has_next ? S.b_tile(nxt) : cB;
        for (int t = 0; t < nt; t += 2) {
            const bool last = (t == nt - 2);
            const size_t k1 = (size_t)(t + 1) * kstep;
            const size_t k2 = last ? (size_t)0 : (size_t)(t + 2) * kstep; const char* b2 = last ? nB : cB + (size_t)(t + 2) * kstep;
            const size_t k3 = k2 + kstep; const char* b3 = b2 + kstep;
            unsigned r2[2][2];
#pragma unroll
            for (int h = 0; h < 2; ++h) { r2[h][0] = last ? ra_nxt[h][0] : ra_cur[h][0]; r2[h][1] = last ? ra_nxt[h][1] : ra_cur[h][1]; }
            PG8_LDB(B0, 0, 0); PG8_LDB(B1, 0, 1); PG8_SCHED; PG8_LDA(At, 0, 0); PG8_STAGEA(PG8_SA(1, 1), ra_cur[1], k1);
            PG8_WAIT_V(8); PG8_WAIT_L(0); PG8_BAR; PG8_MMA(0, 0, At, B0); PG8_MMA(0, 1, At, B1); PG8_BAR; PG8_SCHED;
            PG8_LDA(At, 0, 1); PG8_STAGE(PG8_SB(0, 0), b2, voffB); PG8_STAGE(PG8_SB(0, 1), b2 + hstep, voffB); PG8_STAGEA(PG8_SA(0, 0), r2[0], k2);
            PG8_WAIT_V(8); PG8_WAIT_L(0); PG8_BAR; PG8_MMA(1, 0, At, B0); PG8_MMA(1, 1, At, B1); PG8_BAR; PG8_SCHED;
            PG8_LDB(B0, 1, 0); PG8_LDB(B1, 1, 1); PG8_SCHED; PG8_LDA(At, 1, 0); PG8_STAGEA(PG8_SA(0, 1), r2[1], k2);
            PG8_WAIT_V(8); PG8_WAIT_L(0); PG8_BAR; PG8_MMA(0, 0, At, B0); PG8_MMA(0, 1, At, B1); PG8_BAR; PG8_SCHED;
            PG8_LDA(At, 1, 1); PG8_STAGE(PG8_SB(1, 0), b3, voffB); PG8_STAGE(PG8_SB(1, 1), b3 + hstep, voffB); PG8_STAGEA(PG8_SA(1, 0), r2[0], k3);
            PG8_WAIT_V(8); PG8_WAIT_L(0); PG8_BAR; PG8_MMA(1, 0, At, B0); PG8_MMA(1, 1, At, B1); PG8_BAR; PG8_SCHED;
        }
        if (wr == 0) PG8_BAR;
        if constexpr (FP8) asm volatile("s_nop 15\n\ts_nop 7" ::: "memory");
        Unit nx2; const bool hn2 = has_next && S.next(ui + 2, nx2); int rr2[2][2];
        if (hn2) {
#pragma unroll
            for (int h = 0; h < 2; ++h) { rr2[h][0] = S.row(nx2, h * HALF + Rp[0]); rr2[h][1] = S.row(nx2, h * HALF + Rp[1]); } }
        asm volatile("" ::: "memory");
        E(acc, cur, wr, wc, fr, fq);
        if (!has_next) break;
#pragma unroll
        for (int a = 0; a < 2; ++a)
#pragma unroll
            for (int b = 0; b < 2; ++b)
#pragma unroll
                for (int m = 0; m < 4; ++m)
#pragma unroll
                    for (int n = 0; n < 2; ++n) acc[a][b][m][n] = (f32x4){0.f, 0.f, 0.f, 0.f};
        cur = nxt; cB = nB; ++ui;
#pragma unroll
        for (int h = 0; h < 2; ++h) { ra_cur[h][0] = ra_nxt[h][0]; ra_cur[h][1] = ra_nxt[h][1]; }
        has_next = hn2; nxt = nx2;
        if (has_next) {
#pragma unroll
            for (int h = 0; h < 2; ++h) { ra_nxt[h][0] = (unsigned)(rr2[h][0] * KB + Cp[0] * 2); ra_nxt[h][1] = (unsigned)(rr2[h][1] * KB + Cp[1] * 2); } }
        if (wr == 1) PG8_BAR;
    }
    PG8_WAIT_V(0);
    PG8_BAR;
#undef PG8_SA
#undef PG8_SB
#undef PG8_STAGE
#undef PG8_STAGEA
#undef PG8_LDA
#undef PG8_LDB
#undef PG8_MMA
#undef PG8_WAIT_V
#undef PG8_WAIT_L
#undef PG8_BAR
#undef PG8_SCHED
#undef PG8_ROWS
}

typedef const f32x4 (&AccRef)[2][2][4][2];
struct EpiOut {
    static constexpr bool PERM = true;
    const float* xin32; const bf16_t* xin; bf16_t* xout; const float* gate; const float* bias; float gscale;
    __device__ __forceinline__ void operator()(AccRef acc, const Unit& u, int wr, int wc, int fr, int fq) const {
        const int row0 = u.pm * BM + wr * 64 + fr, col0 = u.pn * BM + wc * 32 + 8 * fq, b = (u.pm * BM) / SEQ;
        f32x4 gv[2][2], bv[2][2];
#pragma unroll
        for (int bj = 0; bj < 2; ++bj)
#pragma unroll
            for (int n = 0; n < 2; ++n) { gv[bj][n] = *(const f32x4*)(gate + (size_t)b * MOD_W + col0 + bj * HALF + n * 4) * gscale;
                bv[bj][n] = bias ? *(const f32x4*)(bias + col0 + bj * HALF + n * 4) : (f32x4){0.f, 0.f, 0.f, 0.f}; }
        if (xin32 != nullptr) {
#pragma unroll
            for (int ai = 0; ai < 2; ++ai)
#pragma unroll
                for (int m = 0; m < 4; ++m) { const size_t off = (size_t)(row0 + ai * HALF + m * 16) * D + col0;
#pragma unroll
                    for (int bj = 0; bj < 2; ++bj) { const f32x4 x0 = *(const f32x4*)(xin32 + off + bj * HALF), x1 = *(const f32x4*)(xin32 + off + bj * HALF + 4);
                        const f32x4 v0 = x0 + gv[bj][0] * (acc[ai][bj][m][0] + bv[bj][0]), v1 = x1 + gv[bj][1] * (acc[ai][bj][m][1] + bv[bj][1]);
                        u32x4 w; w.x = pk2(v0[0], v0[1]); w.y = pk2(v0[2], v0[3]); w.z = pk2(v1[0], v1[1]); w.w = pk2(v1[2], v1[3]);
                        *(u32x4*)(xout + off + bj * HALF) = w; }
                    asm volatile("" ::: "memory"); }
        } else {
#pragma unroll
            for (int ai = 0; ai < 2; ++ai)
#pragma unroll
                for (int m = 0; m < 4; ++m) { const size_t off = (size_t)(row0 + ai * HALF + m * 16) * D + col0;
#pragma unroll
                    for (int bj = 0; bj < 2; ++bj) { const u32x4 xw = *(const u32x4*)(xin + off + bj * HALF);
                        const f32x4 x0 = {bf_lo(xw.x), bf_hi(xw.x), bf_lo(xw.y), bf_hi(xw.y)}, x1 = {bf_lo(xw.z), bf_hi(xw.z), bf_lo(xw.w), bf_hi(xw.w)};
                        const f32x4 v0 = x0 + gv[bj][0] * (acc[ai][bj][m][0] + bv[bj][0]), v1 = x1 + gv[bj][1] * (acc[ai][bj][m][1] + bv[bj][1]);
                        u32x4 w; w.x = pk2(v0[0], v0[1]); w.y = pk2(v0[2], v0[3]); w.z = pk2(v1[0], v1[1]); w.w = pk2(v1[2], v1[3]);
                        *(u32x4*)(xout + off + bj * HALF) = w; }
                    asm volatile("" ::: "memory"); }
        }
    }
};
template <int MODE, bool F8OUT = false> struct EpiGated {
    static constexpr bool PERM = true;
    bf16_t* O; int ldc; const float* bias; int hid; float ascale, oscale;
    __device__ __forceinline__ void operator()(AccRef acc, const Unit& u, int wr, int wc, int fr, int fq) const {
        const int row0 = u.pm * BM + wr * 64 + fr, col0 = u.pn * HALF + wc * 32 + 8 * fq;
        f32x4 ba[2], bb[2];
#pragma unroll
        for (int n = 0; n < 2; ++n) { ba[n] = (MODE == 1) ? *(const f32x4*)(bias + col0 + 4 * n) : (f32x4){0.f, 0.f, 0.f, 0.f}; bb[n] = (MODE == 1) ? *(const f32x4*)(bias + hid + col0 + 4 * n) : (f32x4){0.f, 0.f, 0.f, 0.f}; }
#pragma unroll
        for (int ai = 0; ai < 2; ++ai)
#pragma unroll
            for (int m = 0; m < 4; ++m) { bf16_t* rowp = O + (size_t)(row0 + ai * HALF + m * 16) * ldc + col0; float o[8];
#pragma unroll
                for (int n = 0; n < 2; ++n) {
                    if constexpr (MODE == 0) {
                        const f32x4 A4 = acc[ai][0][m][n], U4 = acc[ai][1][m][n]; const float c1 = -LOG2E * ascale, kk = 1.0f / (ascale * ascale * (F8OUT ? oscale : 1.0f));
                        const f32x4 t = A4 * c1; f32x4 e;
#pragma unroll
                        for (int i = 0; i < 4; ++i) e[i] = __builtin_amdgcn_exp2f(t[i]);
                        const f32x4 d = e * kk + kk; f32x4 r;
#pragma unroll
                        for (int i = 0; i < 4; ++i) r[i] = __builtin_amdgcn_rcpf(d[i]);
                        const f32x4 ov = (A4 * U4) * r;
#pragma unroll
                        for (int i = 0; i < 4; ++i) o[4 * n + i] = ov[i];
                        continue; }
                    const f32x4 a = acc[ai][0][m][n] * ascale + ba[n], g = acc[ai][1][m][n] * ascale + bb[n];
                    const f32x4 t = ((MODE == 0) ? a : g) * (-LOG2E); f32x4 e;
#pragma unroll
                    for (int i = 0; i < 4; ++i) e[i] = __builtin_amdgcn_exp2f(t[i]);
                    const f32x4 d = e + 1.0f; f32x4 r;
#pragma unroll
                    for (int i = 0; i < 4; ++i) r[i] = __builtin_amdgcn_rcpf(d[i]);
                    const f32x4 ov = (a * r) * ((MODE == 0) ? g : (f32x4){1.f, 1.f, 1.f, 1.f}) * (F8OUT ? oscale : 1.0f);
#pragma unroll
                    for (int i = 0; i < 4; ++i) o[4 * n + i] = ov[i]; }
                if constexpr (F8OUT) { u32x2 w; w.x = pk4_fp8(o[0], o[1], o[2], o[3]); w.y = pk4_fp8(o[4], o[5], o[6], o[7]);
                    *(u32x2*)((unsigned char*)O + (size_t)(row0 + ai * HALF + m * 16) * ldc + col0) = w; }
                else { u32x4 w; w.x = pk2(o[0], o[1]); w.y = pk2(o[2], o[3]); w.z = pk2(o[4], o[5]); w.w = pk2(o[6], o[7]);
                    *(u32x4*)rowp = w; } }
    }
};
struct EpiBf16 {
    static constexpr bool PERM = true;
    bf16_t* O; int ldc; float scale;
    __device__ __forceinline__ void operator()(AccRef acc, const Unit& u, int wr, int wc, int fr, int fq) const {
        const int row0 = u.pm * BM + wr * 64 + fr, col0 = u.pn * BM + wc * 32 + 8 * fq;
#pragma unroll
        for (int ai = 0; ai < 2; ++ai)
#pragma unroll
            for (int m = 0; m < 4; ++m) { bf16_t* rowp = O + (size_t)(row0 + ai * HALF + m * 16) * ldc + col0;
#pragma unroll
                for (int bj = 0; bj < 2; ++bj) { const f32x4 v0 = acc[ai][bj][m][0] * scale, v1 = acc[ai][bj][m][1] * scale;
                    u32x4 w; w.x = pk2(v0[0], v0[1]); w.y = pk2(v0[2], v0[3]); w.z = pk2(v1[0], v1[1]); w.w = pk2(v1[2], v1[3]);
                    *(u32x4*)(rowp + bj * HALF) = w; } }
    }
};
struct EpiGlaIn {
    static constexpr bool PERM = true;
    bf16_t *Q, *KD, *V, *R; const float* Dk; const float* dref;
    __device__ __forceinline__ void operator()(AccRef acc, const Unit& u, int wr, int wc, int fr, int fq) const {
        const int row0 = u.pm * BM + wr * 64 + fr, cw = wc * 32 + 8 * fq;
        const int type = (u.pn < 2) ? 0 : (u.pn < 4) ? 1 : (u.pn < 8) ? 2 : 3;
        const int tcol = (type == 0) ? u.pn * BM : (type == 1) ? (u.pn - 2) * BM : (type == 2) ? (u.pn - 4) * BM : (u.pn - 8) * BM;
        bf16_t* base = (type == 0) ? Q : (type == 1) ? KD : (type == 2) ? V : R; const int ldc = (type < 2) ? 512 : D;
#pragma unroll
        for (int ai = 0; ai < 2; ++ai)
#pragma unroll
            for (int m = 0; m < 4; ++m) { const int row = row0 + ai * HALF + m * 16;
#pragma unroll
                for (int bj = 0; bj < 2; ++bj) { const int col = tcol + bj * HALF + cw; f32x4 v0 = acc[ai][bj][m][0], v1 = acc[ai][bj][m][1];
                    if (type == 0) { v0 = v0 * 0.08838834764831845f; v1 = v1 * 0.08838834764831845f; }
                    else if (type == 1) { const float* rp = dref + (size_t)(row >> 4) * 512 + col;
                        const u32x4 cw = *(const u32x4*)((const bf16_t*)Dk + (size_t)row * 512 + col); const f32x4 c0 = (f32x4){bf_lo(cw.x), bf_hi(cw.x), bf_lo(cw.y), bf_hi(cw.y)}, c1 = (f32x4){bf_lo(cw.z), bf_hi(cw.z), bf_lo(cw.w), bf_hi(cw.w)}, r0 = *(const f32x4*)rp, r1 = *(const f32x4*)(rp + 4);
#pragma unroll
                        for (int i = 0; i < 4; ++i) { v0[i] *= __expf(r0[i] - c0[i]); v1[i] *= __expf(r1[i] - c1[i]); } }
                    else if (type == 3) {
#pragma unroll
                        for (int i = 0; i < 4; ++i) { v0[i] = fast_silu(v0[i]); v1[i] = fast_silu(v1[i]); } }
                    u32x4 w; w.x = pk2(v0[0], v0[1]); w.y = pk2(v0[2], v0[3]); w.z = pk2(v1[0], v1[1]); w.w = pk2(v1[2], v1[3]);
                    *(u32x4*)(base + (size_t)row * ldc + col) = w; } }
    }
};
struct EpiFoxIn {
    static constexpr bool PERM = true;
    bf16_t *Q, *Kb, *V, *G; const float *qg, *kg; int pn0; float ascale;
    __device__ __forceinline__ void operator()(AccRef acc, const Unit& u, int wr, int wc, int fr, int fq) const {
        const int pn = u.pn + pn0; const int row0 = u.pm * BM + wr * 64 + fr, type = pn >> 2;
        bf16_t* base = (type == 0) ? Q : (type == 1) ? Kb : (type == 2) ? V : G;
        const int colw = (pn & 3) * BM + 64 * wc + 8 * fq;
        f32x4 gn[2][2];
#pragma unroll
        for (int bj = 0; bj < 2; ++bj)
#pragma unroll
            for (int n = 0; n < 2; ++n) { const f32x4 gq = *(const f32x4*)(qg + 32 * bj + 8 * fq + 4 * n) * QSCALE, gk = *(const f32x4*)(kg + 32 * bj + 8 * fq + 4 * n);
                gn[bj][n] = (type == 0) ? gq : gk; }
#pragma unroll
        for (int ai = 0; ai < 2; ++ai)
#pragma unroll
            for (int m = 0; m < 4; ++m) { const int row = row0 + ai * HALF + m * 16; float rs = 1.f;
                if (type < 2) { float ss = 0.f;
#pragma unroll
                    for (int bj = 0; bj < 2; ++bj)
#pragma unroll
                        for (int n = 0; n < 2; ++n) { const f32x4 x = acc[ai][bj][m][n]; ss += (x[0] * x[0] + x[1] * x[1]) + (x[2] * x[2] + x[3] * x[3]); }
                    ss += __shfl_xor(ss, 16); ss += __shfl_xor(ss, 32);
                    rs = __builtin_amdgcn_rsqf(ss * (1.0f / 64.0f) + EPS); }
#pragma unroll
                for (int bj = 0; bj < 2; ++bj) { f32x4 v0 = acc[ai][bj][m][0] * ascale, v1 = acc[ai][bj][m][1] * ascale;
                    if (type < 2) { v0 = v0 * rs * gn[bj][0]; v1 = v1 * rs * gn[bj][1]; }
                    else if (type == 3) {
#pragma unroll
                        for (int i = 0; i < 4; ++i) { v0[i] = fast_sigmoid(v0[i]); v1[i] = fast_sigmoid(v1[i]); } }
                    u32x4 w; w.x = pk2(v0[0], v0[1]); w.y = pk2(v0[2], v0[3]); w.z = pk2(v1[0], v1[1]); w.w = pk2(v1[2], v1[3]);
                    *(u32x4*)(base + (size_t)row * D + colw + 32 * bj) = w; } }
    }
};
}

constexpr int RING_BYTES = 131072;
constexpr int LDS_TAB = 135168;
constexpr int LDS_MISC = LDS_TAB + 256;
constexpr int LDS_BYTES = 147456;

struct Args { const float* in[28]; float* out; unsigned char* ws; int ph_lo, ph_hi; };
enum { I_X = 0, I_C, I_ADA_W, I_ADA_B, I_GLA_WIN, I_GLA_WG2, I_GLA_BG, I_GLA_GN, I_GLA_WOUT, I_CONV_WIN, I_CONV_BIN, I_CONV_DW, I_CONV_DWB, I_CONV_LNG, I_CONV_LNB, I_CONV_WOUT, I_CONV_BOUT,
       I_FOX_WIN, I_FOX_BF, I_FOX_QN, I_FOX_KN, I_FOX_WOUT, I_FFN_W13, I_FFN_W2, I_MOE_R, I_MOE_W13, I_MOE_W2, I_NORMF };

__device__ __forceinline__ const float* karg_in(int i) {
    asm volatile("" : "+s"(i));
    const __attribute__((address_space(4))) char* ka = (const __attribute__((address_space(4))) char*)__builtin_amdgcn_kernarg_segment_ptr();
    return *(const float* const __attribute__((address_space(4)))*)(ka + 8 * i);
}
__device__ __forceinline__ int opq(int x) { asm volatile("" : "+s"(x)); return x; }
__device__ __forceinline__ unsigned char* karg_ws() {
    int i = 29; asm volatile("" : "+s"(i));
    const __attribute__((address_space(4))) char* ka = (const __attribute__((address_space(4))) char*)__builtin_amdgcn_kernarg_segment_ptr();
    return *(unsigned char* const __attribute__((address_space(4)))*)(ka + 8 * i);
}
template <int MODE, bool F8 = false>
__device__ __forceinline__ void tr_item(const float* W, int K, int pitch, int ncols, bf16_t* WT, LAS float* scr, int item, int lane, int hid, float f8scale = 1.0f, int l0base = 0) {
    constexpr int KD = F8 ? 128 : 64;
    const int nblk = ncols / 32, kb = item / nblk, nb = item % nblk, k0 = KD * kb, L0 = l0base + 32 * nb;
    int src0 = L0, dst0 = L0;
    if (MODE == 1) { if (L0 < hid) dst0 = 256 * (L0 / 128) + (L0 % 128); else { const int n = L0 - hid; dst0 = 256 * (n / 128) + 128 + (n % 128); } }
    if (MODE == 2) { src0 = (L0 < 3072) ? L0 : L0 + 16; const int tile = L0 / 256, within = L0 % 256, wc = within / 64, bj = (within % 64) / 32; dst0 = tile * 256 + 128 * bj + 32 * wc; }
#pragma unroll 8
    for (int i = 0; i < KD / 2; ++i) { const int kk = 2 * i + (lane >> 5); scr[kk * 33 + (lane & 31)] = W[(size_t)(k0 + kk) * pitch + src0 + (lane & 31)]; }
    asm volatile("s_waitcnt lgkmcnt(0)" ::: "memory");
    const int c = lane & 7;
#pragma unroll
    for (int j = 0; j < 4; ++j) { const int n = (lane >> 3) + 8 * j; const LAS float* s = scr + ((KD / 8) * c) * 33 + n;
        if constexpr (F8) { u32x4 o; o.x = pk4_fp8(s[0 * 33] * f8scale, s[1 * 33] * f8scale, s[2 * 33] * f8scale, s[3 * 33] * f8scale); o.y = pk4_fp8(s[4 * 33] * f8scale, s[5 * 33] * f8scale, s[6 * 33] * f8scale, s[7 * 33] * f8scale);
            o.z = pk4_fp8(s[8 * 33] * f8scale, s[9 * 33] * f8scale, s[10 * 33] * f8scale, s[11 * 33] * f8scale); o.w = pk4_fp8(s[12 * 33] * f8scale, s[13 * 33] * f8scale, s[14 * 33] * f8scale, s[15 * 33] * f8scale);
            *(u32x4*)((unsigned char*)WT + (size_t)(dst0 + n) * K + k0 + 16 * c) = o; }
        else { u32x4 o; o.x = pk2(s[0 * 33], s[1 * 33]); o.y = pk2(s[2 * 33], s[3 * 33]); o.z = pk2(s[4 * 33], s[5 * 33]); o.w = pk2(s[6 * 33], s[7 * 33]);
            *(u32x4*)(WT + (size_t)(dst0 + n) * K + k0 + 8 * c) = o; } }
    asm volatile("s_waitcnt lgkmcnt(0)" ::: "memory");
}

__device__ __forceinline__ void phase_prologue(LAS unsigned char* lds, const Args& a, int vcu, int G) {
    const int tid = opaque_tid(), lane = tid & 63, wave = __builtin_amdgcn_readfirstlane(tid >> 6);
    unsigned char* ws = a.ws;
    LAS float* cond = (LAS float*)lds;
    LAS float* part = (LAS float*)(lds + 32768);
    for (int i = tid; i < NB * D; i += NTHR) { const int b = i / D, k = i % D; const float v = karg_in(I_C)[i]; cond[k * 8 + b] = v * fast_sigmoid(v); }
    __syncthreads();
    float* mod = (float*)(ws + WS_MOD);
    for (int task = blockIdx.x; task < DEPTH * MOD_W / 32; task += G) {
        const int J0 = task * 32, L = J0 / MOD_W, j0 = J0 % MOD_W, col = lane & 31, kp = lane >> 5;
        const float* w = karg_in(I_ADA_W) + (size_t)L * D * MOD_W + j0 + col;
        float acc[8];
#pragma unroll
        for (int b = 0; b < 8; ++b) acc[b] = 0.f;
#pragma unroll 8
        for (int i = 0; i < 64; ++i) { const int k = wave * 128 + 2 * i + kp; const float wv = w[(size_t)k * MOD_W];
            const f32x4 c0 = *(const LAS f32x4*)(cond + k * 8), c1 = *(const LAS f32x4*)(cond + k * 8 + 4);
            acc[0] += wv * c0[0]; acc[1] += wv * c0[1]; acc[2] += wv * c0[2]; acc[3] += wv * c0[3]; acc[4] += wv * c1[0]; acc[5] += wv * c1[1]; acc[6] += wv * c1[2]; acc[7] += wv * c1[3]; }
#pragma unroll
        for (int b = 0; b < 8; ++b) acc[b] += __shfl_xor(acc[b], 32);
        if (kp == 0) {
#pragma unroll
            for (int b = 0; b < 8; ++b) part[(wave * 8 + b) * 32 + col] = acc[b]; }
        __syncthreads();
        if (tid < 256) { const int b = tid >> 5, cc = tid & 31; float s = karg_in(I_ADA_B)[L * MOD_W + j0 + cc];
#pragma unroll
            for (int w8 = 0; w8 < 8; ++w8) s += part[(w8 * 8 + b) * 32 + cc];
            mod[((size_t)L * NB + b) * MOD_W + j0 + cc] = s; }
        __syncthreads();
    }
    LAS float* scr = (LAS float*)(lds + wave * 16896);
    const int gw = vcu * NWAVES + wave, NGW = G * NWAVES;
    constexpr int IT_GLA_IN = (D / 64) * (3072 / 32), IT_SQ = (D / 64) * (D / 32), IT_CONV_IN = (D / (CONV_FP8 ? 128 : 64)) * (2048 / 32), IT_FOX_QKV = (D / 64) * (3072 / 32), IT_FOX_G = FOXG_FP8 ? (D / 128) * (1024 / 32) : (D / 64) * (1024 / 32), IT_FOX_IN = IT_FOX_QKV + IT_FOX_G;
    constexpr int IT_FFN13 = (D / (FFN_FP8 ? 128 : 64)) * (2 * DFF / 32), IT_FFN2 = (DFF / 64) * (D / 32), IT_MOE13 = (D / (MOE_FP8 ? 128 : 64)) * (2 * DFE / 32), IT_MOE2 = (DFE / (MOE_FP8 ? 128 : 64)) * (D / 32);
    constexpr int NITEMS = 2 * IT_GLA_IN + 2 * IT_SQ + IT_CONV_IN + IT_SQ + IT_FOX_IN + IT_SQ + 2 * IT_FFN13 + 2 * IT_FFN2 + 16 * IT_MOE13 + 16 * IT_MOE2;
    for (int it = gw; it < NITEMS; it += NGW) {
        int r = it;
        if (r < 2 * IT_GLA_IN) { const int j = r / IT_GLA_IN; r %= IT_GLA_IN; tr_item<0>(karg_in(I_GLA_WIN) + (size_t)j * D * GLA_IN, D, GLA_IN, 3072, (bf16_t*)(ws + W_GLA_IN + j * SZ_GLA_IN), scr, r, lane, 0); continue; } r -= 2 * IT_GLA_IN;
        if (r < 2 * IT_SQ) { const int j = r / IT_SQ; r %= IT_SQ; tr_item<0>(karg_in(I_GLA_WOUT) + (size_t)j * D * D, D, D, D, (bf16_t*)(ws + W_GLA_OUT + j * SZ_SQ), scr, r, lane, 0); continue; } r -= 2 * IT_SQ;
        if (r < IT_CONV_IN) { tr_item<1, CONV_FP8 != 0>(karg_in(I_CONV_WIN), D, 2048, 2048, (bf16_t*)(ws + W_CONV_IN), scr, r, lane, 1024, F8_W13); continue; } r -= IT_CONV_IN;
        if (r < IT_SQ) { tr_item<0>(karg_in(I_CONV_WOUT), D, D, D, (bf16_t*)(ws + W_CONV_OUT), scr, r, lane, 0); continue; } r -= IT_SQ;
        if (r < IT_FOX_IN) {
            if (r < IT_FOX_QKV) tr_item<2>(karg_in(I_FOX_WIN), D, FOX_IN, 3072, (bf16_t*)(ws + W_FOX_IN), scr, r, lane, 0);
            else if (FOXG_FP8) tr_item<2, true>(karg_in(I_FOX_WIN), D, FOX_IN, 1024, (bf16_t*)(ws + W_FOX_IN + (size_t)3072 * D * 2 - (size_t)3072 * D), scr, r - IT_FOX_QKV, lane, 0, F8_W13, 3072);
            else tr_item<2>(karg_in(I_FOX_WIN), D, FOX_IN, 1024, (bf16_t*)(ws + W_FOX_IN), scr, r - IT_FOX_QKV, lane, 0, 1.0f, 3072);
            continue; } r -= IT_FOX_IN;
        if (r < IT_SQ) { tr_item<0>(karg_in(I_FOX_WOUT), D, D, D, (bf16_t*)(ws + W_FOX_OUT), scr, r, lane, 0); continue; } r -= IT_SQ;
        if (r < 2 * IT_FFN13) { const int j = r / IT_FFN13; r %= IT_FFN13; tr_item<1, FFN_FP8 != 0>(karg_in(I_FFN_W13) + (size_t)j * D * 2 * DFF, D, 2 * DFF, 2 * DFF, (bf16_t*)(ws + W_FFN13 + j * SZ_FFN13), scr, r, lane, DFF, F8_W13); continue; } r -= 2 * IT_FFN13;
        if (r < 2 * IT_FFN2) { const int j = r / IT_FFN2; r %= IT_FFN2; tr_item<0>(karg_in(I_FFN_W2) + (size_t)j * DFF * D, DFF, D, D, (bf16_t*)(ws + W_FFN2 + j * SZ_FFN2), scr, r, lane, 0); continue; } r -= 2 * IT_FFN2;
        if (r < 16 * IT_MOE13) { const int j = r / IT_MOE13; r %= IT_MOE13; tr_item<1, MOE_FP8 != 0>(karg_in(I_MOE_W13) + (size_t)j * D * 2 * DFE, D, 2 * DFE, 2 * DFE, (bf16_t*)(ws + W_MOE13 + j * MOE13_STRIDE), scr, r, lane, DFE, F8_W13); continue; } r -= 16 * IT_MOE13;
        { const int j = r / IT_MOE2; r %= IT_MOE2; tr_item<0, MOE_FP8 != 0>(karg_in(I_MOE_W2) + (size_t)j * DFE * D, DFE, D, D, (bf16_t*)(ws + W_MOE2 + j * MOE2_STRIDE), scr, r, lane, 0, F8_W2); }
    }
}

struct NormArgs {
    const float* xin; float* xout; bf16_t* H; const float* sc; const float* sh;
    int combine; const bf16_t* Y; const u32x4* tinfo; const float* g2p; const unsigned* cntp;
    const float* wx; int wx_pitch; float cscale;
    const float* w2; const float* bvec;
    float* Dk; float* dref; float* etot; float* lf;
    int* tok; u32x4* tinfo_out; unsigned* cnt;
    const float* gamma; float* out;
};
template <int VAR>
__device__ __forceinline__ void norm_phase(LAS unsigned char* lds, const NormArgs& a, int G) {
    const int tid = opaque_tid(), lane = tid & 63, wave = __builtin_amdgcn_readfirstlane(tid >> 6);
    constexpr int NX = (VAR == 1 || VAR == 2) ? 16 : (VAR == 3) ? 8 : 0;
    LAS float* WX = (LAS float*)lds;
    LAS float* W2 = (LAS float*)(lds + 65536);
    LAS float* BG = (LAS float*)(lds + 98304);
    LAS float* TOTW = (LAS float*)(lds + 100352);
    LAS int* SEL_E = (LAS int*)(lds + 65536);
    LAS float* SEL_G = (LAS float*)(lds + 65536 + 512);
    LAS int* BASE = (LAS int*)(lds + 65536 + 1024);
    LAS int* TAB = (LAS int*)(lds + LDS_TAB);
    if constexpr (NX > 0) {
        for (int idx = tid; idx < D * NX; idx += NTHR) { const int k = idx / NX, n = idx % NX; const float v = a.wx[(size_t)k * a.wx_pitch + n];
            const int l = (k & 255) >> 2, j = k >> 8, i = k & 3; WX[((((j * 4 + i) * (NX / 4) + (n >> 2)) * 64 + l) << 2) + (n & 3)] = v; }
    }
    if (VAR == 1) { for (int idx = tid; idx < 16 * 512; idx += NTHR) W2[idx] = a.w2[idx]; for (int idx = tid; idx < 512; idx += NTHR) BG[idx] = a.bvec[idx]; }
    if (a.combine && tid == 0) { int s = 0; for (int e = 0; e < NE; ++e) { TAB[e] = s; s += ((int)a.cntp[e] + 255) >> 8; } TAB[8] = s; }
    __syncthreads();
    for (int g = blockIdx.x; g < NTOK / 64; g += G) {
        const int b = g / (SEQ / 64);
        f32x4 scv[4], shv[4], g2v[4], gmv[4];
#pragma unroll
        for (int j = 0; j < 4; ++j) {
            if (VAR != 4) { scv[j] = *(const f32x4*)(a.sc + (size_t)b * MOD_W + 4 * lane + 256 * j) + 1.0f; shv[j] = *(const f32x4*)(a.sh + (size_t)b * MOD_W + 4 * lane + 256 * j); }
            else gmv[j] = *(const f32x4*)(a.gamma + 4 * lane + 256 * j);
            if (a.combine) g2v[j] = *(const f32x4*)(a.g2p + (size_t)b * MOD_W + 4 * lane + 256 * j) * a.cscale; }
        float run[8];
        if (VAR == 1) {
#pragma unroll
            for (int c = 0; c < 8; ++c) run[c] = 0.f; }
        const bf16_t* xin16 = (const bf16_t*)a.xin; bf16_t* xout16 = (bf16_t*)a.xout;
        u32x2 xn[4];
#pragma unroll
        for (int j = 0; j < 4; ++j) xn[j] = *(const u32x2*)(xin16 + (size_t)(g * 64 + wave * 8) * D + 4 * lane + 256 * j);
#pragma unroll 1
        for (int r = 0; r < 8; ++r) {
            const int row = g * 64 + wave * 8 + r;
            f32x4 x[4];
#pragma unroll
            for (int j = 0; j < 4; ++j) x[j] = (f32x4){bf_lo(xn[j].x), bf_hi(xn[j].x), bf_lo(xn[j].y), bf_hi(xn[j].y)};
            if (r < 7) {
#pragma unroll
                for (int j = 0; j < 4; ++j) xn[j] = *(const u32x2*)(xin16 + (size_t)(row + 1) * D + 4 * lane + 256 * j); }
            if (a.combine) {
                const u32x4 ti = a.tinfo[row];
                const int e0 = ti.x >> 15, e1 = ti.y >> 15; const size_t r0 = (size_t)TAB[e0] * 256 + (ti.x & 32767u), r1 = (size_t)TAB[e1] * 256 + (ti.y & 32767u);
                const float ga = __uint_as_float(ti.z), gb = __uint_as_float(ti.w);
#pragma unroll
                for (int j = 0; j < 4; ++j) { const u32x2 y0 = *(const u32x2*)(a.Y + r0 * D + 4 * lane + 256 * j), y1 = *(const u32x2*)(a.Y + r1 * D + 4 * lane + 256 * j);
                    f32x4 m; m[0] = ga * bf_lo(y0.x) + gb * bf_lo(y1.x); m[1] = ga * bf_hi(y0.x) + gb * bf_hi(y1.x); m[2] = ga * bf_lo(y0.y) + gb * bf_lo(y1.y); m[3] = ga * bf_hi(y0.y) + gb * bf_hi(y1.y);
                    x[j] = x[j] + g2v[j] * m; if (VAR != 4) { u32x2 xw; xw.x = pk2(x[j][0], x[j][1]); xw.y = pk2(x[j][2], x[j][3]); *(u32x2*)(xout16 + (size_t)row * D + 4 * lane + 256 * j) = xw; } }
            }
            float ss = 0.f;
#pragma unroll
            for (int j = 0; j < 4; ++j) ss += (x[j][0] * x[j][0] + x[j][1] * x[j][1]) + (x[j][2] * x[j][2] + x[j][3] * x[j][3]);
            const float rstd = __builtin_amdgcn_rsqf(wave_sum(ss) * (1.0f / D) + EPS);
            if (VAR == 4) {
#pragma unroll
                for (int j = 0; j < 4; ++j) *(f32x4*)(a.out + (size_t)row * D + 4 * lane + 256 * j) = x[j] * rstd * gmv[j];
                continue;
            }
            f32x4 h[4];
#pragma unroll
            for (int j = 0; j < 4; ++j) { h[j] = x[j] * rstd * scv[j] + shv[j];
                if ((VAR == 3 && MOE_FP8) || (VAR == 0 && a.wx_pitch < 0)) {        *(unsigned*)((unsigned char*)a.H + (size_t)row * D + 4 * lane + 256 * j) = pk4_fp8(h[j][0], h[j][1], h[j][2], h[j][3]); }
                else { u32x2 w; w.x = pk2(h[j][0], h[j][1]); w.y = pk2(h[j][2], h[j][3]); *(u32x2*)(a.H + (size_t)row * D + 4 * lane + 256 * j) = w; } }
            if constexpr (NX > 0) {
                float p[NX];
#pragma unroll
                for (int n = 0; n < NX; ++n) p[n] = 0.f;
#pragma unroll
                for (int j = 0; j < 4; ++j)
#pragma unroll
                    for (int i = 0; i < 4; ++i)
                    {
#pragma unroll
                        for (int n4 = 0; n4 < NX / 4; ++n4) { const f32x4 w = *(const LAS f32x4*)(WX + ((((j * 4 + i) * (NX / 4) + n4) * 64 + lane) << 2));
                            p[4 * n4 + 0] += h[j][i] * w[0]; p[4 * n4 + 1] += h[j][i] * w[1]; p[4 * n4 + 2] += h[j][i] * w[2]; p[4 * n4 + 3] += h[j][i] * w[3]; }
                        if (i & 1) { if constexpr (NX == 16) asm volatile("" : "+v"(p[0]), "+v"(p[1]), "+v"(p[2]), "+v"(p[3]), "+v"(p[4]), "+v"(p[5]), "+v"(p[6]), "+v"(p[7]), "+v"(p[8]), "+v"(p[9]), "+v"(p[10]), "+v"(p[11]), "+v"(p[12]), "+v"(p[13]), "+v"(p[14]), "+v"(p[15]) :: "memory");
                            else asm volatile("" : "+v"(p[0]), "+v"(p[1]), "+v"(p[2]), "+v"(p[3]), "+v"(p[4]), "+v"(p[5]), "+v"(p[6]), "+v"(p[7]) :: "memory");
                            __builtin_amdgcn_sched_barrier(0); } }
                xreduce<NX>(p, lane);
                const float red = p[0];
                if (VAR == 1) {
                    float gl[16];
#pragma unroll
                    for (int n = 0; n < 16; ++n) gl[n] = __uint_as_float(__builtin_amdgcn_readlane(__float_as_uint(red), 4 * n));
#pragma unroll
                    for (int jj = 0; jj < 2; ++jj) { f32x4 z = *(const LAS f32x4*)(BG + 256 * jj + 4 * lane);
#pragma unroll
                        for (int n = 0; n < 16; ++n) { z = z + gl[n] * *(const LAS f32x4*)(W2 + n * 512 + 256 * jj + 4 * lane); if ((n & 3) == 3) { asm volatile("" : "+v"(z) :: "memory"); __builtin_amdgcn_sched_barrier(0); } }
#pragma unroll
                        for (int i = 0; i < 4; ++i) run[4 * jj + i] += log_sigmoid(z[i]) * (1.0f / 16.0f);
                        *(f32x4*)(a.Dk + (size_t)row * 512 + 256 * jj + 4 * lane) = (f32x4){run[4 * jj], run[4 * jj + 1], run[4 * jj + 2], run[4 * jj + 3]}; }
                }
                if (VAR == 2) { if ((lane & 3) == 0) { const int n = lane >> 2; a.lf[(size_t)row * 16 + n] = log_sigmoid(red + a.bvec[n]); } }
                if (VAR == 3) {
                    float lg[8];
#pragma unroll
                    for (int n = 0; n < 8; ++n) lg[n] = __uint_as_float(__builtin_amdgcn_readlane(__float_as_uint(red), 8 * n));
                    int e0 = 0; float l0 = lg[0];
#pragma unroll
                    for (int n = 1; n < 8; ++n) if (lg[n] > l0) { l0 = lg[n]; e0 = n; }
                    int e1 = -1; float l1 = -3.0e38f;
#pragma unroll
                    for (int n = 0; n < 8; ++n) if (n != e0 && lg[n] > l1) { l1 = lg[n]; e1 = n; }
                    const float g0 = 1.0f / (1.0f + __expf(l1 - l0));
                    if (lane == 0) { const int lr = wave * 8 + r; SEL_E[lr * 2] = e0; SEL_E[lr * 2 + 1] = e1; SEL_G[lr * 2] = g0; SEL_G[lr * 2 + 1] = 1.0f - g0; }
                }
            }
            FENCE();
        }
        if (VAR == 1) {
#pragma unroll
            for (int jj = 0; jj < 2; ++jj) { f32x4 t; t[0] = run[4 * jj]; t[1] = run[4 * jj + 1]; t[2] = run[4 * jj + 2]; t[3] = run[4 * jj + 3]; *(LAS f32x4*)(TOTW + wave * 512 + 256 * jj + 4 * lane) = t; }
            __syncthreads();
#pragma unroll
            for (int jj = 0; jj < 2; ++jj) { f32x4 off = (f32x4){0.f, 0.f, 0.f, 0.f}, tot = (f32x4){0.f, 0.f, 0.f, 0.f};
#pragma unroll
                for (int w8 = 0; w8 < 8; ++w8) { const f32x4 t = *(const LAS f32x4*)(TOTW + w8 * 512 + 256 * jj + 4 * lane); tot = tot + t; if (w8 < wave) off = off + t; }
                *(f32x4*)(a.dref + ((size_t)g * 8 + wave) * 512 + 256 * jj + 4 * lane) = tot - off;
                if (wave == 0) { f32x4 e;
#pragma unroll
                    for (int i = 0; i < 4; ++i) e[i] = __expf(tot[i]);
                    *(f32x4*)(a.etot + (size_t)g * 512 + 256 * jj + 4 * lane) = e; } }
            __syncthreads();
        }
        if (VAR == 3) {
            __syncthreads();
            if (tid < NE) { int c = 0; for (int q = 0; q < 128; ++q) c += (SEL_E[q] == tid) ? 1 : 0; BASE[tid] = c ? (int)atomicAdd(a.cnt + tid, (unsigned)c) : 0; }
            __syncthreads();
            if (tid < 128) { const int e = SEL_E[tid]; int pos = BASE[e]; for (int q = 0; q < tid; ++q) pos += (SEL_E[q] == e) ? 1 : 0;
                const int row = g * 64 + (tid >> 1); a.tok[e * MOE_CAP + pos] = row;
                unsigned* ti = (unsigned*)(a.tinfo_out + row); ti[tid & 1] = (unsigned)(e * MOE_CAP + pos); ti[2 + (tid & 1)] = __float_as_uint(SEL_G[tid]); }
            __syncthreads();
        }
    }
}


template <int VAR>
__device__ __forceinline__ void norm_mfma(LAS unsigned char* lds, const NormArgs& a, int G) {
    const int tid = opaque_tid(), lane = tid & 63, wave = __builtin_amdgcn_readfirstlane(tid >> 6), r = lane & 15, g = lane >> 4;
    constexpr int NXv = (VAR == 3) ? 8 : 16, WP = 1032;
    LAS bf16_t* WT = (LAS bf16_t*)lds; LAS bf16_t* WTL = (LAS bf16_t*)(lds + 33024);
    LAS float* SC = (LAS float*)(lds + 66048); LAS float* SH = SC + 1024; LAS float* G2 = SH + 1024;
    LAS bf16_t* W2T = (LAS bf16_t*)(lds + 78336); LAS float* BG = (LAS float*)(lds + 94720); LAS float* GL = (LAS float*)(lds + 96768); LAS float* TOT = (LAS float*)(lds + 105472);
    LAS float* LG = (LAS float*)(lds + 78336); LAS int* SEL_E = (LAS int*)(lds + 82432); LAS float* SEL_G = (LAS float*)(lds + 83456); LAS int* BASE = (LAS int*)(lds + 84480);
    LAS int* TAB = (LAS int*)(lds + LDS_TAB);
    for (int idx = tid; idx < D * 16; idx += NTHR) { const int k = idx >> 4, n = idx & 15; const float v = (n < NXv) ? a.wx[(size_t)k * a.wx_pitch + n] : 0.f;
        const unsigned hi = pk2(v, 0.f) & 0xffffu; WT[n * WP + k] = (bf16_t)hi;
        if (VAR == 3) WTL[n * WP + k] = (bf16_t)(pk2(v - __uint_as_float(hi << 16), 0.f) & 0xffffu); }
    if (VAR == 1) { for (int idx = tid; idx < 16 * 512; idx += NTHR) { const int rr = idx >> 9, col = idx & 511; W2T[col * 16 + rr] = (bf16_t)(pk2(a.w2[idx], 0.f) & 0xffffu); }
        for (int idx = tid; idx < 512; idx += NTHR) BG[idx] = a.bvec[idx]; }
    if (a.combine && tid == 0) { int sx = 0; for (int e = 0; e < NE; ++e) { TAB[e] = sx; sx += ((int)a.cntp[e] + 255) >> 8; } TAB[8] = sx; }
    for (int rb = blockIdx.x; rb < NTOK / 128; rb += G) {
        const int b = rb / (SEQ / 128), row = rb * 128 + wave * 16 + r;
        __syncthreads();
        for (int k = tid; k < D; k += NTHR) { SC[k] = a.sc[(size_t)b * MOD_W + k] + 1.0f; SH[k] = a.sh[(size_t)b * MOD_W + k]; if (a.combine) G2[k] = a.g2p[(size_t)b * MOD_W + k] * a.cscale; }
        __syncthreads();
        const float* xr = a.xin + (size_t)row * D + 8 * g; float* xw = a.xout + (size_t)row * D + 8 * g;
        float ss = 0.f;
        if (a.combine) {
            const u32x4 ti = a.tinfo[row];
            const size_t r0 = (size_t)TAB[ti.x >> 15] * 256 + (ti.x & 32767u), r1 = (size_t)TAB[ti.y >> 15] * 256 + (ti.y & 32767u);
            const float ga = __uint_as_float(ti.z), gb = __uint_as_float(ti.w);
            const bf16_t* y0p = a.Y + r0 * D + 8 * g; const bf16_t* y1p = a.Y + r1 * D + 8 * g;
#pragma unroll 4
            for (int sK = 0; sK < 32; ++sK) { f32x4 x0 = *(const f32x4*)(xr + 32 * sK), x1 = *(const f32x4*)(xr + 32 * sK + 4);
                const u32x4 y0 = *(const u32x4*)(y0p + 32 * sK), y1 = *(const u32x4*)(y1p + 32 * sK);
                const f32x4 g0 = *(const LAS f32x4*)(G2 + 32 * sK + 8 * g), g1 = *(const LAS f32x4*)(G2 + 32 * sK + 8 * g + 4);
                f32x4 m0, m1; m0[0] = ga * bf_lo(y0.x) + gb * bf_lo(y1.x); m0[1] = ga * bf_hi(y0.x) + gb * bf_hi(y1.x); m0[2] = ga * bf_lo(y0.y) + gb * bf_lo(y1.y); m0[3] = ga * bf_hi(y0.y) + gb * bf_hi(y1.y);
                m1[0] = ga * bf_lo(y0.z) + gb * bf_lo(y1.z); m1[1] = ga * bf_hi(y0.z) + gb * bf_hi(y1.z); m1[2] = ga * bf_lo(y0.w) + gb * bf_lo(y1.w); m1[3] = ga * bf_hi(y0.w) + gb * bf_hi(y1.w);
                x0 = x0 + g0 * m0; x1 = x1 + g1 * m1; *(f32x4*)(xw + 32 * sK) = x0; *(f32x4*)(xw + 32 * sK + 4) = x1;
                ss += (x0[0] * x0[0] + x0[1] * x0[1]) + (x0[2] * x0[2] + x0[3] * x0[3]) + (x1[0] * x1[0] + x1[1] * x1[1]) + (x1[2] * x1[2] + x1[3] * x1[3]); }
        } else {
#pragma unroll 8
            for (int sK = 0; sK < 32; ++sK) { const f32x4 x0 = *(const f32x4*)(xr + 32 * sK), x1 = *(const f32x4*)(xr + 32 * sK + 4);
                ss += (x0[0] * x0[0] + x0[1] * x0[1]) + (x0[2] * x0[2] + x0[3] * x0[3]) + (x1[0] * x1[0] + x1[1] * x1[1]) + (x1[2] * x1[2] + x1[3] * x1[3]); }
        }
        ss += __shfl_xor(ss, 16); ss += __shfl_xor(ss, 32);
        const float rstd = __builtin_amdgcn_rsqf(ss * (1.0f / D) + EPS);
        const float* x2 = (a.combine ? (const float*)a.xout : a.xin) + (size_t)row * D + 8 * g;
        f32x4 acc = (f32x4){0.f, 0.f, 0.f, 0.f};
#pragma unroll 4
        for (int sK = 0; sK < 32; ++sK) { const f32x4 x0 = *(const f32x4*)(x2 + 32 * sK), x1 = *(const f32x4*)(x2 + 32 * sK + 4);
            const f32x4 c0 = *(const LAS f32x4*)(SC + 32 * sK + 8 * g), c1 = *(const LAS f32x4*)(SC + 32 * sK + 8 * g + 4), s0 = *(const LAS f32x4*)(SH + 32 * sK + 8 * g), s1 = *(const LAS f32x4*)(SH + 32 * sK + 8 * g + 4);
            const f32x4 h0 = x0 * rstd * c0 + s0, h1 = x1 * rstd * c1 + s1;
            u32x4 hw; hw.x = pk2(h0[0], h0[1]); hw.y = pk2(h0[2], h0[3]); hw.z = pk2(h1[0], h1[1]); hw.w = pk2(h1[2], h1[3]);
            if (VAR == 3 && MOE_FP8) { u32x2 w8; w8.x = pk4_fp8(h0[0], h0[1], h0[2], h0[3]); w8.y = pk4_fp8(h1[0], h1[1], h1[2], h1[3]); *(u32x2*)((unsigned char*)a.H + (size_t)row * D + 32 * sK + 8 * g) = w8; }
            else *(u32x4*)(a.H + (size_t)row * D + 32 * sK + 8 * g) = hw;
            const bf16x8 af = __builtin_bit_cast(bf16x8, hw), bw = *(const LAS bf16x8*)(WT + r * WP + 32 * sK + 8 * g);
            acc = __builtin_amdgcn_mfma_f32_16x16x32_bf16(af, bw, acc, 0, 0, 0);
            if (VAR == 3) {
                u32x4 lw; lw.x = pk2(h0[0] - bf_lo(hw.x), h0[1] - bf_hi(hw.x)); lw.y = pk2(h0[2] - bf_lo(hw.y), h0[3] - bf_hi(hw.y)); lw.z = pk2(h1[0] - bf_lo(hw.z), h1[1] - bf_hi(hw.z)); lw.w = pk2(h1[2] - bf_lo(hw.w), h1[3] - bf_hi(hw.w));
                const bf16x8 bl = *(const LAS bf16x8*)(WTL + r * WP + 32 * sK + 8 * g);
                acc = __builtin_amdgcn_mfma_f32_16x16x32_bf16(__builtin_bit_cast(bf16x8, lw), bw, acc, 0, 0, 0);
                acc = __builtin_amdgcn_mfma_f32_16x16x32_bf16(af, bl, acc, 0, 0, 0); } }
        const int grow0 = rb * 128 + wave * 16;
        if (VAR == 2) {
            const float bfv = a.bvec[r];
#pragma unroll
            for (int i = 0; i < 4; ++i) a.lf[(size_t)(grow0 + 4 * g + i) * 16 + r] = log_sigmoid(acc[i] + bfv);
        }
        if (VAR == 3) {
            if (r < 8) {
#pragma unroll
                for (int i = 0; i < 4; ++i) LG[(wave * 16 + 4 * g + i) * 8 + r] = acc[i]; }
            asm volatile("s_waitcnt lgkmcnt(0)" ::: "memory");
            if (lane < 16) { const int lr = wave * 16 + lane; float lg[8];
                const f32x4 la = *(const LAS f32x4*)(LG + lr * 8), lb = *(const LAS f32x4*)(LG + lr * 8 + 4);
                lg[0] = la[0]; lg[1] = la[1]; lg[2] = la[2]; lg[3] = la[3]; lg[4] = lb[0]; lg[5] = lb[1]; lg[6] = lb[2]; lg[7] = lb[3];
                int e0 = 0; float l0 = lg[0];
#pragma unroll
                for (int n = 1; n < 8; ++n) { const bool up = lg[n] > l0; l0 = up ? lg[n] : l0; e0 = up ? n : e0; }
                int e1 = 0; float l1 = -3.0e38f;
#pragma unroll
                for (int n = 0; n < 8; ++n) { const bool up = (n != e0) && (lg[n] > l1); l1 = up ? lg[n] : l1; e1 = up ? n : e1; }
                const float g0 = 1.0f / (1.0f + __expf(l1 - l0));
                SEL_E[lr * 2] = e0; SEL_E[lr * 2 + 1] = e1; SEL_G[lr * 2] = g0; SEL_G[lr * 2 + 1] = 1.0f - g0; }
            __syncthreads();
            if (tid < NE) { int c = 0; for (int q = 0; q < 256; ++q) c += (SEL_E[q] == tid) ? 1 : 0; BASE[tid] = c ? (int)atomicAdd(a.cnt + tid, (unsigned)c) : 0; }
            __syncthreads();
            if (tid < 256) { const int e = SEL_E[tid]; int pos = BASE[e]; for (int q = 0; q < tid; ++q) pos += (SEL_E[q] == e) ? 1 : 0;
                const int trow = rb * 128 + (tid >> 1); a.tok[e * MOE_CAP + pos] = trow;
                unsigned* ti = (unsigned*)(a.tinfo_out + trow); ti[tid & 1] = (unsigned)(e * MOE_CAP + pos); ti[2 + (tid & 1)] = __float_as_uint(SEL_G[tid]); }
        }
        if (VAR == 1) {
            LAS float* GLw = GL + wave * (16 * 17);
#pragma unroll
            for (int i = 0; i < 4; ++i) GLw[(4 * g + i) * 17 + r] = acc[i];
            asm volatile("s_waitcnt lgkmcnt(0)" ::: "memory");
            bf16x8 bg8; { float t[8];
#pragma unroll
                for (int j = 0; j < 8; ++j) t[j] = (g < 2) ? GLw[r * 17 + 8 * (g & 1) + j] : 0.f;
                u32x4 tw; tw.x = pk2(t[0], t[1]); tw.y = pk2(t[2], t[3]); tw.z = pk2(t[4], t[5]); tw.w = pk2(t[6], t[7]); bg8 = __builtin_bit_cast(bf16x8, tw); }
#pragma unroll 2
            for (int cb = 0; cb < 32; ++cb) {
                u32x4 aw = *(const LAS u32x4*)(W2T + (16 * cb + r) * 16 + 8 * (g & 1)); if (g >= 2) aw = (u32x4){0u, 0u, 0u, 0u};
                const f32x4 z = __builtin_amdgcn_mfma_f32_16x16x32_bf16(__builtin_bit_cast(bf16x8, aw), bg8, (f32x4){0.f, 0.f, 0.f, 0.f}, 0, 0, 0);
                const f32x4 bgv = *(const LAS f32x4*)(BG + 16 * cb + 4 * g);
                f32x4 la;
#pragma unroll
                for (int i = 0; i < 4; ++i) la[i] = log_sigmoid(z[i] + bgv[i]) * (1.0f / 16.0f);
#pragma unroll
                for (int off = 1; off < 16; off <<= 1) {
#pragma unroll
                    for (int i = 0; i < 4; ++i) { const float t = __shfl_up(la[i], off, 16); la[i] += (r >= off) ? t : 0.f; } }
                *(f32x4*)(a.Dk + (size_t)row * 512 + 16 * cb + 4 * g) = la;
                if (r == 15) *(LAS f32x4*)(TOT + wave * 512 + 16 * cb + 4 * g) = la;
            }
            __syncthreads();
            const int w0 = wave & ~3;
#pragma unroll
            for (int j = 0; j < 8; ++j) { const int c = lane + 64 * j; float tot = 0.f, off = 0.f;
#pragma unroll
                for (int w4 = 0; w4 < 4; ++w4) { const float t = TOT[(w0 + w4) * 512 + c]; tot += t; off += (w0 + w4 < wave) ? t : 0.f; }
                a.dref[((size_t)rb * 8 + wave) * 512 + c] = tot - off;
                if ((wave & 3) == 0) a.etot[((size_t)rb * 2 + (wave >> 2)) * 512 + c] = __expf(tot); }
        }
    }
}


template <int VAR, bool XF32 = false>
__device__ __forceinline__ void norm_mfma2(LAS unsigned char* lds, const NormArgs& a, int G) {
    const int tid = opaque_tid(), lane = tid & 63, wave = __builtin_amdgcn_readfirstlane(tid >> 6), r = lane & 15, g = lane >> 4;
    constexpr int NXv = (VAR == 3) ? 8 : 16, WP = 1032;
    LAS bf16_t* WT = (LAS bf16_t*)lds; LAS bf16_t* WTL = (LAS bf16_t*)(lds + 33024);
    LAS float* SC = (LAS float*)(lds + 66048); LAS float* SH = SC + 1024; LAS float* G2 = SH + 1024;
    LAS bf16_t* W2T = (LAS bf16_t*)(lds + 78336); LAS float* BG = (LAS float*)(lds + 94720); LAS float* TOT = (LAS float*)(lds + 96768);
    LAS float* PS = (LAS float*)(lds + 113152);
    LAS float* PA = (LAS float*)(lds + 113664);
    LAS float* OUTS = (LAS float*)(lds + 121856);
    LAS int* SEL_E = (LAS int*)(lds + 123008); LAS float* SEL_G = (LAS float*)(lds + 124032); LAS int* BASE = (LAS int*)(lds + 125056);
    LAS int* TAB = (LAS int*)(lds + LDS_TAB);
    for (int idx = tid; idx < D * 16; idx += NTHR) { const int k = idx >> 4, n = idx & 15; const float v = (n < NXv) ? a.wx[(size_t)k * a.wx_pitch + n] : 0.f;
        const unsigned hi = pk2(v, 0.f) & 0xffffu; WT[n * WP + k] = (bf16_t)hi;
        if (VAR == 3) WTL[n * WP + k] = (bf16_t)(pk2(v - __uint_as_float(hi << 16), 0.f) & 0xffffu); }
    if (VAR == 1) { for (int idx = tid; idx < 16 * 512; idx += NTHR) { const int rr = idx >> 9, col = idx & 511; W2T[col * 16 + rr] = (bf16_t)(pk2(a.w2[idx], 0.f) & 0xffffu); }
        for (int idx = tid; idx < 512; idx += NTHR) BG[idx] = a.bvec[idx]; }
    if (a.combine && tid == 0) { int sx = 0; for (int e = 0; e < NE; ++e) { TAB[e] = sx; sx += ((int)a.cntp[e] + 255) >> 8; } TAB[8] = sx; }
    const int kw = 128 * wave + 8 * g;
    for (int rb = blockIdx.x; rb < NTOK / 128; rb += G) {
        const int b = rb / (SEQ / 128);
        __syncthreads();
        for (int k = tid; k < D; k += NTHR) { SC[k] = a.sc[(size_t)b * MOD_W + k] + 1.0f; SH[k] = a.sh[(size_t)b * MOD_W + k]; if (a.combine) G2[k] = a.g2p[(size_t)b * MOD_W + k] * a.cscale; }
        __syncthreads();
        f32x4 xa[4][2]; u32x4 xb[4];
#define NM2_LOAD(ROW) do { if constexpr (XF32) { const float* xr = a.xin + (size_t)(ROW) * D + kw; \
            _Pragma("unroll") for (int sK = 0; sK < 4; ++sK) { xa[sK][0] = *(const f32x4*)(xr + 32 * sK); xa[sK][1] = *(const f32x4*)(xr + 32 * sK + 4); } } \
        else { const bf16_t* xr = (const bf16_t*)a.xin + (size_t)(ROW) * D + kw; \
            _Pragma("unroll") for (int sK = 0; sK < 4; ++sK) xb[sK] = *(const u32x4*)(xr + 32 * sK); } } while (0)
        NM2_LOAD(rb * 128 + r);
#pragma unroll 1
        for (int gi = 0; gi < 8; ++gi) {
            const int row = rb * 128 + gi * 16 + r;
            f32x4 x[4][2];
#pragma unroll
            for (int sK = 0; sK < 4; ++sK) { if constexpr (XF32) { x[sK][0] = xa[sK][0]; x[sK][1] = xa[sK][1]; }
                else { x[sK][0] = (f32x4){bf_lo(xb[sK].x), bf_hi(xb[sK].x), bf_lo(xb[sK].y), bf_hi(xb[sK].y)}; x[sK][1] = (f32x4){bf_lo(xb[sK].z), bf_hi(xb[sK].z), bf_lo(xb[sK].w), bf_hi(xb[sK].w)}; } }
            if (gi < 7) NM2_LOAD(row + 16);
            if (a.combine) {
                const u32x4 ti = a.tinfo[row];
                const size_t r0 = (size_t)TAB[ti.x >> 15] * 256 + (ti.x & 32767u), r1 = (size_t)TAB[ti.y >> 15] * 256 + (ti.y & 32767u);
                const float ga = __uint_as_float(ti.z), gb = __uint_as_float(ti.w);
                const bf16_t* y0p = a.Y + r0 * D + kw; const bf16_t* y1p = a.Y + r1 * D + kw; bf16_t* xw = (bf16_t*)a.xout + (size_t)row * D + kw;
#pragma unroll
                for (int sK = 0; sK < 4; ++sK) { const u32x4 y0 = *(const u32x4*)(y0p + 32 * sK), y1 = *(const u32x4*)(y1p + 32 * sK);
                    const f32x4 g0 = *(const LAS f32x4*)(G2 + kw + 32 * sK), g1 = *(const LAS f32x4*)(G2 + kw + 32 * sK + 4);
                    f32x4 m0, m1; m0[0] = ga * bf_lo(y0.x) + gb * bf_lo(y1.x); m0[1] = ga * bf_hi(y0.x) + gb * bf_hi(y1.x); m0[2] = ga * bf_lo(y0.y) + gb * bf_lo(y1.y); m0[3] = ga * bf_hi(y0.y) + gb * bf_hi(y1.y);
                    m1[0] = ga * bf_lo(y0.z) + gb * bf_lo(y1.z); m1[1] = ga * bf_hi(y0.z) + gb * bf_hi(y1.z); m1[2] = ga * bf_lo(y0.w) + gb * bf_lo(y1.w); m1[3] = ga * bf_hi(y0.w) + gb * bf_hi(y1.w);
                    x[sK][0] = x[sK][0] + g0 * m0; x[sK][1] = x[sK][1] + g1 * m1;
                    u32x4 xs; xs.x = pk2(x[sK][0][0], x[sK][0][1]); xs.y = pk2(x[sK][0][2], x[sK][0][3]); xs.z = pk2(x[sK][1][0], x[sK][1][1]); xs.w = pk2(x[sK][1][2], x[sK][1][3]); *(u32x4*)(xw + 32 * sK) = xs; }
            }
            float ss = 0.f;
#pragma unroll
            for (int sK = 0; sK < 4; ++sK) { const f32x4 x0 = x[sK][0], x1 = x[sK][1];
                ss += (x0[0] * x0[0] + x0[1] * x0[1]) + (x0[2] * x0[2] + x0[3] * x0[3]) + (x1[0] * x1[0] + x1[1] * x1[1]) + (x1[2] * x1[2] + x1[3] * x1[3]); }
            ss += __shfl_xor(ss, 16); ss += __shfl_xor(ss, 32);
            if (g == 0) PS[wave * 16 + r] = ss;
            __syncthreads();
            float st = 0.f;
#pragma unroll
            for (int w8 = 0; w8 < 8; ++w8) st += PS[w8 * 16 + r];
            const float rstd = __builtin_amdgcn_rsqf(st * (1.0f / D) + EPS);
            f32x4 acc = (f32x4){0.f, 0.f, 0.f, 0.f};
#pragma unroll
            for (int sK = 0; sK < 4; ++sK) {
                const f32x4 c0 = *(const LAS f32x4*)(SC + kw + 32 * sK), c1 = *(const LAS f32x4*)(SC + kw + 32 * sK + 4), s0 = *(const LAS f32x4*)(SH + kw + 32 * sK), s1 = *(const LAS f32x4*)(SH + kw + 32 * sK + 4);
                const f32x4 h0 = x[sK][0] * rstd * c0 + s0, h1 = x[sK][1] * rstd * c1 + s1;
                u32x4 hw; hw.x = pk2(h0[0], h0[1]); hw.y = pk2(h0[2], h0[3]); hw.z = pk2(h1[0], h1[1]); hw.w = pk2(h1[2], h1[3]);
                if (VAR == 3 && MOE_FP8) { u32x2 w8; w8.x = pk4_fp8(h0[0], h0[1], h0[2], h0[3]); w8.y = pk4_fp8(h1[0], h1[1], h1[2], h1[3]); *(u32x2*)((unsigned char*)a.H + (size_t)row * D + kw + 32 * sK) = w8; }
                else *(u32x4*)(a.H + (size_t)row * D + kw + 32 * sK) = hw;
                if (VAR == 2 && FOXG_FP8) { u32x2 w8; w8.x = pk4_fp8(h0[0], h0[1], h0[2], h0[3]); w8.y = pk4_fp8(h1[0], h1[1], h1[2], h1[3]); *(u32x2*)((unsigned char*)a.H + (WS_H8 - WS_H) + (size_t)row * D + kw + 32 * sK) = w8; }
                const bf16x8 af = __builtin_bit_cast(bf16x8, hw), bw = *(const LAS bf16x8*)(WT + r * WP + kw + 32 * sK);
                acc = __builtin_amdgcn_mfma_f32_16x16x32_bf16(af, bw, acc, 0, 0, 0);
                if (VAR == 3) {
                    u32x4 lw; lw.x = pk2(h0[0] - bf_lo(hw.x), h0[1] - bf_hi(hw.x)); lw.y = pk2(h0[2] - bf_lo(hw.y), h0[3] - bf_hi(hw.y)); lw.z = pk2(h1[0] - bf_lo(hw.z), h1[1] - bf_hi(hw.z)); lw.w = pk2(h1[2] - bf_lo(hw.w), h1[3] - bf_hi(hw.w));
                    const bf16x8 bl = *(const LAS bf16x8*)(WTL + r * WP + kw + 32 * sK);
                    acc = __builtin_amdgcn_mfma_f32_16x16x32_bf16(__builtin_bit_cast(bf16x8, lw), bw, acc, 0, 0, 0);
                    acc = __builtin_amdgcn_mfma_f32_16x16x32_bf16(af, bl, acc, 0, 0, 0); } }
#pragma unroll
            for (int i = 0; i < 4; ++i) PA[(wave * 16 + 4 * g + i) * 16 + r] = acc[i];
            __syncthreads();
            if (tid < 256) { float o = 0.f;
#pragma unroll
                for (int w8 = 0; w8 < 8; ++w8) o += PA[w8 * 256 + tid];
                OUTS[(tid >> 4) * 17 + (tid & 15)] = o; }
            __syncthreads();
            const int grow0 = rb * 128 + gi * 16;
            if (VAR == 2) { if (tid < 256) { const int rr = tid >> 4, n = tid & 15; a.lf[(size_t)(grow0 + rr) * 16 + n] = log_sigmoid(OUTS[rr * 17 + n] + a.bvec[n]); } }
            if (VAR == 3) {
                if (tid < 16) { const int lr = gi * 16 + tid; float lg[8];
#pragma unroll
                    for (int n = 0; n < 8; ++n) lg[n] = OUTS[tid * 17 + n];
                    int e0 = 0; float l0 = lg[0];
#pragma unroll
                    for (int n = 1; n < 8; ++n) { const bool up = lg[n] > l0; l0 = up ? lg[n] : l0; e0 = up ? n : e0; }
                    int e1 = 0; float l1 = -3.0e38f;
#pragma unroll
                    for (int n = 0; n < 8; ++n) { const bool up = (n != e0) && (lg[n] > l1); l1 = up ? lg[n] : l1; e1 = up ? n : e1; }
                    const float g0 = 1.0f / (1.0f + __expf(l1 - l0));
                    SEL_E[lr * 2] = e0; SEL_E[lr * 2 + 1] = e1; SEL_G[lr * 2] = g0; SEL_G[lr * 2 + 1] = 1.0f - g0; } }
            if (VAR == 1) {
                bf16x8 bg8; { float t[8];
#pragma unroll
                    for (int j = 0; j < 8; ++j) t[j] = (g < 2) ? OUTS[r * 17 + 8 * (g & 1) + j] : 0.f;
                    u32x4 tw; tw.x = pk2(t[0], t[1]); tw.y = pk2(t[2], t[3]); tw.z = pk2(t[4], t[5]); tw.w = pk2(t[6], t[7]); bg8 = __builtin_bit_cast(bf16x8, tw); }
#pragma unroll
                for (int c4 = 0; c4 < 4; ++c4) { const int cb = 4 * wave + c4;
                    u32x4 aw = *(const LAS u32x4*)(W2T + (16 * cb + r) * 16 + 8 * (g & 1)); if (g >= 2) aw = (u32x4){0u, 0u, 0u, 0u};
                    const f32x4 z = __builtin_amdgcn_mfma_f32_16x16x32_bf16(__builtin_bit_cast(bf16x8, aw), bg8, (f32x4){0.f, 0.f, 0.f, 0.f}, 0, 0, 0);
                    const f32x4 bgv = *(const LAS f32x4*)(BG + 16 * cb + 4 * g);
                    f32x4 la;
#pragma unroll
                    for (int i = 0; i < 4; ++i) la[i] = log_sigmoid(z[i] + bgv[i]) * (1.0f / 16.0f);
                    { float a0 = la[0], a1 = la[1], a2 = la[2], a3 = la[3];
#define NM2_DPP(sh) "v_add_f32_dpp %0, %0, %0 row_shr:" #sh " row_mask:0xf bank_mask:0xf bound_ctrl:1\n\tv_add_f32_dpp %1, %1, %1 row_shr:" #sh " row_mask:0xf bank_mask:0xf bound_ctrl:1\n\t" \
                        "v_add_f32_dpp %2, %2, %2 row_shr:" #sh " row_mask:0xf bank_mask:0xf bound_ctrl:1\n\tv_add_f32_dpp %3, %3, %3 row_shr:" #sh " row_mask:0xf bank_mask:0xf bound_ctrl:1\n\t"
                        asm volatile("s_nop 1\n\t" NM2_DPP(1) NM2_DPP(2) NM2_DPP(4) NM2_DPP(8) "s_nop 1" : "+v"(a0), "+v"(a1), "+v"(a2), "+v"(a3));
#undef NM2_DPP
                        la[0] = a0; la[1] = a1; la[2] = a2; la[3] = a3; }
                    { u32x2 dw; dw.x = pk2(la[0], la[1]); dw.y = pk2(la[2], la[3]); *(u32x2*)((bf16_t*)a.Dk + (size_t)row * 512 + 16 * cb + 4 * g) = dw; }
                    if (r == 15) *(LAS f32x4*)(TOT + gi * 512 + 16 * cb + 4 * g) = la; } }
        }
        if (VAR == 1) {
            __syncthreads();
#pragma unroll
            for (int j = 0; j < 8; ++j) { const int idx = tid + NTHR * j, gi = idx >> 9, c = idx & 511, g0i = gi & ~3; float tot = 0.f, off = 0.f;
#pragma unroll
                for (int w4 = 0; w4 < 4; ++w4) { const float t = TOT[(g0i + w4) * 512 + c]; tot += t; off += (g0i + w4 < gi) ? t : 0.f; }
                a.dref[((size_t)rb * 8 + gi) * 512 + c] = tot - off;
                if ((gi & 3) == 0) a.etot[((size_t)rb * 2 + (gi >> 2)) * 512 + c] = __expf(tot); }
        }
        if (VAR == 3) {
            __syncthreads();
            if (tid < NE) { int c = 0; for (int q = 0; q < 256; ++q) c += (SEL_E[q] == tid) ? 1 : 0; BASE[tid] = c ? (int)atomicAdd(a.cnt + tid, (unsigned)c) : 0; }
            __syncthreads();
            if (tid < 256) { const int e = SEL_E[tid]; int pos = BASE[e]; for (int q = 0; q < tid; ++q) pos += (SEL_E[q] == e) ? 1 : 0;
                const int trow = rb * 128 + (tid >> 1); a.tok[e * MOE_CAP + pos] = trow;
                unsigned* ti = (unsigned*)(a.tinfo_out + trow); ti[tid & 1] = (unsigned)(e * MOE_CAP + pos); ti[2 + (tid & 1)] = __float_as_uint(SEL_G[tid]); }
        }
    }
}
#undef NM2_LOAD

__device__ __forceinline__ void gla_scan_phase(LAS unsigned char* lds, const bf16_t* Qg, const bf16_t* KD, const bf16_t* V, const float* etot, bf16_t* O, int vcu, int G) {
    const int tid = opaque_tid();
    constexpr int QP = 272;
    LAS unsigned char* Qs = lds; LAS unsigned char* Ks = lds + 64 * QP; LAS unsigned char* Vs = lds + 2 * 64 * QP;
    LAS float* Sl = (LAS float*)(lds + 2 * 64 * QP + 4096); LAS float* Et = Sl + 128 * 32;
    for (int u = vcu; u < NB * 4 * 8; u += G) {
        const int b = u >> 5, h = (u >> 3) & 3, vs = u & 7;
        const int kg = tid >> 5, v = tid & 31;
        const int oc = tid >> 3, ov = tid & 7;
        float S[8];
#pragma unroll
        for (int i = 0; i < 8; ++i) S[i] = 0.f;
        u32x4 pq[2], pk[2], pv; float pe = 0.f; pv = (u32x4){0u, 0u, 0u, 0u};
        auto fetch = [&](int n) {
            const size_t row0 = (size_t)b * SEQ + (size_t)n * 64;
#pragma unroll
            for (int i = 0; i < 2; ++i) { const int idx = tid + i * NTHR, r = idx >> 4, c = idx & 15;
                pq[i] = *(const u32x4*)(Qg + (row0 + r) * 512 + h * 128 + c * 8); pk[i] = *(const u32x4*)(KD + (row0 + r) * 512 + h * 128 + c * 8); }
            if (tid < 256) { const int r = tid >> 2, c = tid & 3; pv = *(const u32x4*)(V + (row0 + r) * D + h * 256 + vs * 32 + c * 8); }
            if (tid < 128) pe = etot[((size_t)b * 64 + n) * 512 + h * 128 + tid];
        };
        fetch(0);
        for (int n = 0; n < 64; ++n) {
#pragma unroll
            for (int i = 0; i < 2; ++i) { const int idx = tid + i * NTHR, r = idx >> 4, c = idx & 15; *(LAS u32x4*)(Qs + r * QP + c * 16) = pq[i]; *(LAS u32x4*)(Ks + r * QP + c * 16) = pk[i]; }
            if (tid < 256) { const int r = tid >> 2, c = tid & 3; *(LAS u32x4*)(Vs + r * 64 + c * 16) = pv; }
            if (tid < 128) Et[tid] = pe;
            __syncthreads();
            if (n + 1 < 64) fetch(n + 1);
#pragma unroll
            for (int i = 0; i < 8; ++i) S[i] *= Et[kg * 8 + i];
#pragma unroll 4
            for (int c = 0; c < 64; ++c) { const u32x4 kw = *(const LAS u32x4*)(Ks + c * QP + kg * 16); const float vv = __uint_as_float((unsigned)(*(const LAS unsigned short*)(Vs + c * 64 + v * 2)) << 16);
                S[0] += bf_lo(kw.x) * vv; S[1] += bf_hi(kw.x) * vv; S[2] += bf_lo(kw.y) * vv; S[3] += bf_hi(kw.y) * vv; S[4] += bf_lo(kw.z) * vv; S[5] += bf_hi(kw.z) * vv; S[6] += bf_lo(kw.w) * vv; S[7] += bf_hi(kw.w) * vv; }
#pragma unroll
            for (int i = 0; i < 8; ++i) Sl[(kg * 8 + i) * 32 + v] = S[i];
            __syncthreads();
            f32x4 o = (f32x4){0.f, 0.f, 0.f, 0.f};
#pragma unroll 2
            for (int k8 = 0; k8 < 16; ++k8) { const u32x4 qw = *(const LAS u32x4*)(Qs + oc * QP + k8 * 16);
                const float qf[8] = {bf_lo(qw.x), bf_hi(qw.x), bf_lo(qw.y), bf_hi(qw.y), bf_lo(qw.z), bf_hi(qw.z), bf_lo(qw.w), bf_hi(qw.w)};
#pragma unroll
                for (int i = 0; i < 8; ++i) o = o + qf[i] * *(const LAS f32x4*)(Sl + (k8 * 8 + i) * 32 + ov * 4); }
            u32x2 w; w.x = pk2(o[0], o[1]); w.y = pk2(o[2], o[3]);
            *(u32x2*)(O + ((size_t)b * SEQ + (size_t)n * 64 + oc) * D + h * 256 + vs * 32 + ov * 4) = w;
            __syncthreads();
        }
    }
}


namespace gscan {
typedef short v4i16_t __attribute__((ext_vector_type(4)));
__device__ __forceinline__ unsigned off_b(unsigned row, unsigned ch) { return 256u * row + 16u * (ch ^ (((row & 3u) << 2) | ((row >> 2) & 3u))); }
__device__ __forceinline__ unsigned off_v(unsigned row, unsigned half) { return 64u * row + 32u * (half ^ ((row >> 3) & 1u)); }
constexpr int IMG_Q = 0, IMG_K = 16384, IMG_V = 32768, IMG_E = 36864, BUFB = 37376, ST_OFF = 2 * BUFB;
__device__ __forceinline__ bf16x8 tr8(const LAS unsigned char* p0, const LAS unsigned char* p1) {
    const v4i16_t lo = __builtin_amdgcn_ds_read_tr16_b64_v4i16((LAS v4i16_t*)p0), hi = __builtin_amdgcn_ds_read_tr16_b64_v4i16((LAS v4i16_t*)p1);
    return (bf16x8){lo[0], lo[1], lo[2], lo[3], hi[0], hi[1], hi[2], hi[3]};
}
#define GS_BAR() do { asm volatile("s_waitcnt lgkmcnt(0)" ::: "memory"); __builtin_amdgcn_s_barrier(); asm volatile("" ::: "memory"); } while (0)
struct Pre { u32x4 q[2], k[2], v; float e; };
__device__ __forceinline__ void gload(Pre& r, const bf16_t* Qg, const bf16_t* KD, const bf16_t* V, const float* etot, int b, int h, int vs, int n, int tid) {
    const size_t row0 = (size_t)b * SEQ + (size_t)n * 64;
#pragma unroll
    for (int i = 0; i < 2; ++i) { const int idx = tid + i * NTHR, rr = idx >> 4, c = idx & 15;
        r.q[i] = *(const u32x4*)(Qg + (row0 + rr) * 512 + h * 128 + c * 8); r.k[i] = *(const u32x4*)(KD + (row0 + rr) * 512 + h * 128 + c * 8); }
    if (tid < 256) { const int rr = tid >> 2, c = tid & 3; r.v = *(const u32x4*)(V + (row0 + rr) * D + h * 256 + vs * 32 + c * 8); }
    if (tid < 128) r.e = etot[((size_t)b * 64 + n) * 512 + h * 128 + tid];
}
__device__ __forceinline__ void lwrite(const Pre& r, LAS unsigned char* buf, int tid) {
#pragma unroll
    for (int i = 0; i < 2; ++i) { const int idx = tid + i * NTHR, rr = idx >> 4, c = idx & 15; *(LAS u32x4*)(buf + IMG_Q + off_b(rr, c)) = r.q[i]; *(LAS u32x4*)(buf + IMG_K + off_b(rr, c)) = r.k[i]; }
    if (tid < 256) { const int rr = tid >> 2, c = tid & 3; *(LAS u32x4*)(buf + IMG_V + off_v(rr, c >> 1) + 16 * (c & 1)) = r.v; }
    if (tid < 128) *(LAS float*)(buf + IMG_E + 4 * tid) = r.e;
}
__device__ __forceinline__ void chunk(LAS unsigned char* lds, LAS unsigned char* buf, f32x4& S0, f32x4& S1, bf16_t* Orow0, int w, int lane) {
    const int g = lane >> 4, l15 = lane & 15, q = l15 >> 2, p = lane & 3;
    LAS unsigned char* ST = lds + ST_OFF;
    { const f32x4 et = *(const LAS f32x4*)(buf + IMG_E + 4 * (16 * w + 4 * g));
        S0 = S0 * et; S1 = S1 * et;
#pragma unroll
        for (int ks = 0; ks < 2; ++ks) {
            const unsigned r0 = 32 * ks + 8 * g + q, r1 = r0 + 4;
            const bf16x8 a = tr8(buf + IMG_K + off_b(r0, 2 * w + (p >> 1)) + 8 * (p & 1), buf + IMG_K + off_b(r1, 2 * w + (p >> 1)) + 8 * (p & 1));
            const bf16x8 b0 = tr8(buf + IMG_V + off_v(r0, 0) + 8 * p, buf + IMG_V + off_v(r1, 0) + 8 * p);
            const bf16x8 b1 = tr8(buf + IMG_V + off_v(r0, 1) + 8 * p, buf + IMG_V + off_v(r1, 1) + 8 * p);
            S0 = __builtin_amdgcn_mfma_f32_16x16x32_bf16(a, b0, S0, 0, 0, 0);
            S1 = __builtin_amdgcn_mfma_f32_16x16x32_bf16(a, b1, S1, 0, 0, 0);
        }
        u32x2 w0, w1; w0.x = pk2(S0[0], S0[1]); w0.y = pk2(S0[2], S0[3]); w1.x = pk2(S1[0], S1[1]); w1.y = pk2(S1[2], S1[3]);
        *(LAS u32x2*)(ST + off_b(l15, 2 * w + (g >> 1)) + 8 * (g & 1)) = w0;
        *(LAS u32x2*)(ST + off_b(16 + l15, 2 * w + (g >> 1)) + 8 * (g & 1)) = w1; }
    GS_BAR();
    { const int vt = w & 1, ct = w >> 1; f32x4 o = (f32x4){0.f, 0.f, 0.f, 0.f};
#pragma unroll
        for (int sK = 0; sK < 4; ++sK) {
            const bf16x8 a = *(const LAS bf16x8*)(ST + off_b(16 * vt + l15, 4 * sK + g));
            const bf16x8 bq = *(const LAS bf16x8*)(buf + IMG_Q + off_b(16 * ct + l15, 4 * sK + g));
            o = __builtin_amdgcn_mfma_f32_16x16x32_bf16(a, bq, o, 0, 0, 0);
        }
        u32x2 wo; wo.x = pk2(o[0], o[1]); wo.y = pk2(o[2], o[3]);
        *(u32x2*)(Orow0 + (size_t)(16 * ct + l15) * D + 16 * vt + 4 * g) = wo; }
    GS_BAR();
}
}
__device__ __forceinline__ void gla_scan_mfma(LAS unsigned char* lds, const bf16_t* Qg, const bf16_t* KD, const bf16_t* V, const float* etot, bf16_t* O, int vcu, int G) {
    using namespace gscan;
    const int tid = opaque_tid(), lane = tid & 63, w = __builtin_amdgcn_readfirstlane(tid >> 6);
    for (int u = vcu; u < NB * 4 * 8; u += G) {
        const int b = u >> 5, h = (u >> 3) & 3, vs = u & 7;
        f32x4 S0 = (f32x4){0.f, 0.f, 0.f, 0.f}, S1 = (f32x4){0.f, 0.f, 0.f, 0.f};
        Pre pa, pb; pa.v = (u32x4){0u, 0u, 0u, 0u}; pb.v = pa.v; pa.e = 0.f; pb.e = 0.f;
        gload(pa, Qg, KD, V, etot, b, h, vs, 0, tid); gload(pb, Qg, KD, V, etot, b, h, vs, 1, tid);
        lwrite(pa, lds, tid); lwrite(pb, lds + BUFB, tid);
        gload(pa, Qg, KD, V, etot, b, h, vs, 2, tid); gload(pb, Qg, KD, V, etot, b, h, vs, 3, tid);
        GS_BAR();
        bf16_t* Ob = O + ((size_t)b * SEQ) * D + h * 256 + vs * 32;
        for (int n = 0; n < 64; n += 2) {
            chunk(lds, lds, S0, S1, Ob + (size_t)n * 64 * D, w, lane);
            if (n + 2 < 64) { lwrite(pa, lds, tid); if (n + 4 < 64) gload(pa, Qg, KD, V, etot, b, h, vs, n + 4, tid); }
            chunk(lds, lds + BUFB, S0, S1, Ob + (size_t)(n + 1) * 64 * D, w, lane);
            if (n + 3 < 64) { lwrite(pb, lds + BUFB, tid); if (n + 5 < 64) gload(pb, Qg, KD, V, etot, b, h, vs, n + 5, tid); }
        }
        GS_BAR();
    }
}

__device__ __forceinline__ void gla_gn_phase(const bf16_t* O, const bf16_t* R, const float* gn, bf16_t* A2, int vcu, int G) {
    const int tid = opaque_tid(), lane = tid & 63, wave = tid >> 6;
    f32x4 g[4];
#pragma unroll
    for (int j = 0; j < 4; ++j) g[j] = *(const f32x4*)(gn + 16 * lane + 4 * j);
    for (int row = vcu * NWAVES + wave; row < NTOK; row += G * NWAVES) {
        const u32x4 o0 = *(const u32x4*)(O + (size_t)row * D + 16 * lane), o1 = *(const u32x4*)(O + (size_t)row * D + 16 * lane + 8);
        const u32x4 r0 = *(const u32x4*)(R + (size_t)row * D + 16 * lane), r1 = *(const u32x4*)(R + (size_t)row * D + 16 * lane + 8);
        float ov[16], rv[16];
        const unsigned ow[8] = {o0.x, o0.y, o0.z, o0.w, o1.x, o1.y, o1.z, o1.w}, rw[8] = {r0.x, r0.y, r0.z, r0.w, r1.x, r1.y, r1.z, r1.w};
        float ss = 0.f;
#pragma unroll
        for (int i = 0; i < 8; ++i) { ov[2 * i] = bf_lo(ow[i]); ov[2 * i + 1] = bf_hi(ow[i]); rv[2 * i] = bf_lo(rw[i]); rv[2 * i + 1] = bf_hi(rw[i]); ss += ov[2 * i] * ov[2 * i] + ov[2 * i + 1] * ov[2 * i + 1]; }
        ss += __shfl_xor(ss, 1); ss += __shfl_xor(ss, 2); ss += __shfl_xor(ss, 4); ss += __shfl_xor(ss, 8);
        const float rs = __builtin_amdgcn_rsqf(ss * (1.0f / 256.0f) + EPS);
        u32x4 w0, w1;
        w0.x = pk2(ov[0] * rs * g[0][0] * rv[0], ov[1] * rs * g[0][1] * rv[1]); w0.y = pk2(ov[2] * rs * g[0][2] * rv[2], ov[3] * rs * g[0][3] * rv[3]);
        w0.z = pk2(ov[4] * rs * g[1][0] * rv[4], ov[5] * rs * g[1][1] * rv[5]); w0.w = pk2(ov[6] * rs * g[1][2] * rv[6], ov[7] * rs * g[1][3] * rv[7]);
        w1.x = pk2(ov[8] * rs * g[2][0] * rv[8], ov[9] * rs * g[2][1] * rv[9]); w1.y = pk2(ov[10] * rs * g[2][2] * rv[10], ov[11] * rs * g[2][3] * rv[11]);
        w1.z = pk2(ov[12] * rs * g[3][0] * rv[12], ov[13] * rs * g[3][1] * rv[13]); w1.w = pk2(ov[14] * rs * g[3][2] * rv[14], ov[15] * rs * g[3][3] * rv[15]);
        *(u32x4*)(A2 + (size_t)row * D + 16 * lane) = w0; *(u32x4*)(A2 + (size_t)row * D + 16 * lane + 8) = w1;
    }
}

template <int J> __device__ __forceinline__ void conv_step(f32x2 (&ac)[16], const f32x2 (&wv2)[CONVW], unsigned packed) {
    const f32x2 uu = (f32x2){bf_lo(packed), bf_hi(packed)};
#pragma unroll
    for (int ro = 0; ro < 16; ++ro) { constexpr int dummy = 0; (void)dummy; const int w = J - ro;
        if (w >= 0 && w <= 30) {
            asm("v_fmac_f32 %0, %1, %2" : "+v"(ac[ro][0]) : "v"(wv2[w][0]), "v"(uu[0]));
            asm("v_fmac_f32 %0, %1, %2" : "+v"(ac[ro][1]) : "v"(wv2[w][1]), "v"(uu[1])); } }
}
__device__ __forceinline__ void conv_phase(LAS unsigned char* lds, const bf16_t* U, const float* dw, const float* dwb, const float* lng, const float* lnb, bf16_t* A2, int vcu, int G) {
    const int tid = opaque_tid(), lane = tid & 63, wave = __builtin_amdgcn_readfirstlane(tid >> 6);
    LAS float* PART = (LAS float*)lds;
    LAS float* STAT = PART + 512;
    f32x2 wv2[CONVW];
#pragma unroll
    for (int w = 0; w < CONVW; ++w) wv2[w] = *(const f32x2*)(dw + w * D + 2 * tid);
    const f32x2 bia = *(const f32x2*)(dwb + 2 * tid), gam = *(const f32x2*)(lng + 2 * tid), bet = *(const f32x2*)(lnb + 2 * tid);
    for (int u = vcu; u < NB * (SEQ / 128); u += G) {
        const int b = u / (SEQ / 128), t0 = (u % (SEQ / 128)) * 128;
        const bf16_t* ub = U + ((size_t)b * SEQ) * D + 2 * tid;
        unsigned inp[46], nx[16];
#pragma unroll
        for (int j = 0; j < 30; ++j) { const int sfr = t0 - 30 + j; inp[j] = (sfr >= 0) ? *(const unsigned*)(ub + (size_t)sfr * D) : 0u; }
#pragma unroll
        for (int j = 0; j < 16; ++j) nx[j] = *(const unsigned*)(ub + (size_t)(t0 + j) * D);
#pragma unroll 1
        for (int og = 0; og < 8; ++og) {
#pragma unroll
            for (int j = 0; j < 16; ++j) inp[30 + j] = nx[j];
            if (og < 7) {
#pragma unroll
                for (int j = 0; j < 16; ++j) nx[j] = *(const unsigned*)(ub + (size_t)(t0 + 16 * (og + 1) + j) * D); }
            f32x2 ac[16];
#pragma unroll
            for (int r = 0; r < 16; ++r) ac[r] = bia;
#define CS(J) conv_step<J>(ac, wv2, inp[J]);
            CS(0) CS(1) CS(2) CS(3) CS(4) CS(5) CS(6) CS(7) CS(8) CS(9) CS(10) CS(11) CS(12) CS(13) CS(14) CS(15) CS(16) CS(17) CS(18) CS(19) CS(20) CS(21) CS(22) CS(23) CS(24) CS(25) CS(26) CS(27) CS(28) CS(29) CS(30) CS(31) CS(32) CS(33) CS(34) CS(35) CS(36) CS(37) CS(38) CS(39) CS(40) CS(41) CS(42) CS(43) CS(44) CS(45)
#undef CS
#pragma unroll
            for (int j = 0; j < 30; ++j) inp[j] = inp[j + 16];
            float a0[16], a1[16];
#pragma unroll
            for (int r = 0; r < 16; ++r) { a0[r] = ac[r][0]; a1[r] = ac[r][1]; }
            { float st[16];
#pragma unroll
                for (int r = 0; r < 16; ++r) st[r] = a0[r] + a1[r];
                xreduce<16>(st, lane);
                if ((lane & 3) == 0) PART[wave * 32 + (lane >> 2)] = st[0];
#pragma unroll
                for (int r = 0; r < 16; ++r) st[r] = a0[r] * a0[r] + a1[r] * a1[r];
                xreduce<16>(st, lane);
                if ((lane & 3) == 0) PART[wave * 32 + 16 + (lane >> 2)] = st[0]; }
            __syncthreads();
            if (tid < 16) { float s1 = 0.f, s2 = 0.f;
#pragma unroll
                for (int w8 = 0; w8 < 8; ++w8) { s1 += PART[w8 * 32 + tid]; s2 += PART[w8 * 32 + 16 + tid]; }
                const float mean = s1 * (1.0f / D); const float var = fmaxf(s2 * (1.0f / D) - mean * mean, 0.f);
                STAT[2 * tid] = mean; STAT[2 * tid + 1] = __builtin_amdgcn_rsqf(var + EPS); }
            __syncthreads();
#pragma unroll
            for (int r = 0; r < 16; ++r) { const float mean = STAT[2 * r], rs = STAT[2 * r + 1];
                const float y0 = (a0[r] - mean) * rs * gam[0] + bet[0], y1 = (a1[r] - mean) * rs * gam[1] + bet[1];
                *(unsigned*)(A2 + ((size_t)b * SEQ + t0 + 16 * og + r) * D + 2 * tid) = pk2(fast_silu(y0), fast_silu(y1)); }
            __syncthreads();
        }
    }
}

__device__ __forceinline__ void fox_attn_naive(LAS unsigned char* lds, const bf16_t* Q, const bf16_t* Kb, const bf16_t* V, const bf16_t* OG, const float* lf, bf16_t* A2, int vcu, int G) {
    const int tid = opaque_tid(), ql = tid >> 1, hf = tid & 1;
    LAS float* CUM = (LAS float*)lds;
    LAS float* Ks = (LAS float*)(lds + 16384);
    LAS float* Vs = (LAS float*)(lds + 32768);
    LAS float* SCN = (LAS float*)(lds + 49152);
    for (int pu = vcu; pu < NB * 16 * 8; pu += G) {
        const int bh = pu >> 3, b = bh >> 4, h = bh & 15, pr = pu & 7;
        { float loc[8]; float s = 0.f;
#pragma unroll
            for (int i = 0; i < 8; ++i) { s += lf[((size_t)b * SEQ + 8 * tid + i) * 16 + h]; loc[i] = s; }
            __syncthreads();
            SCN[tid] = s; __syncthreads();
            for (int off = 1; off < NTHR; off <<= 1) { const float t = (tid >= off) ? SCN[tid - off] : 0.f; __syncthreads(); SCN[tid] += t; __syncthreads(); }
            const float base = (tid > 0) ? SCN[tid - 1] : 0.f;
#pragma unroll
            for (int i = 0; i < 8; ++i) CUM[8 * tid + i] = (base + loc[i]) * LOG2E;
            __syncthreads(); }
        for (int half = 0; half < 2; ++half) {
            const int qt = half ? 15 - pr : pr; const int qi = qt * 256 + ql; const size_t qrow = (size_t)b * SEQ + qi;
            float q[32], o[32];
#pragma unroll
            for (int c = 0; c < 4; ++c) { const u32x4 w = *(const u32x4*)(Q + qrow * D + h * 64 + hf * 32 + c * 8);
                q[8 * c] = bf_lo(w.x); q[8 * c + 1] = bf_hi(w.x); q[8 * c + 2] = bf_lo(w.y); q[8 * c + 3] = bf_hi(w.y); q[8 * c + 4] = bf_lo(w.z); q[8 * c + 5] = bf_hi(w.z); q[8 * c + 6] = bf_lo(w.w); q[8 * c + 7] = bf_hi(w.w); }
#pragma unroll
            for (int d = 0; d < 32; ++d) o[d] = 0.f;
            float mx = -3.0e38f, l = 0.f; const float cq = CUM[qi];
            const int ntile = (qt * 256 + 256) / 64;
            for (int kt = 0; kt < ntile; ++kt) {
                __syncthreads();
                { const int r = tid >> 3, c = tid & 7; const size_t krow = (size_t)b * SEQ + kt * 64 + r;
                    const u32x4 kw = *(const u32x4*)(Kb + krow * D + h * 64 + c * 8), vw = *(const u32x4*)(V + krow * D + h * 64 + c * 8);
                    *(LAS f32x4*)(Ks + r * 64 + c * 8) = (f32x4){bf_lo(kw.x), bf_hi(kw.x), bf_lo(kw.y), bf_hi(kw.y)}; *(LAS f32x4*)(Ks + r * 64 + c * 8 + 4) = (f32x4){bf_lo(kw.z), bf_hi(kw.z), bf_lo(kw.w), bf_hi(kw.w)};
                    *(LAS f32x4*)(Vs + r * 64 + c * 8) = (f32x4){bf_lo(vw.x), bf_hi(vw.x), bf_lo(vw.y), bf_hi(vw.y)}; *(LAS f32x4*)(Vs + r * 64 + c * 8 + 4) = (f32x4){bf_lo(vw.z), bf_hi(vw.z), bf_lo(vw.w), bf_hi(vw.w)}; }
                __syncthreads();
#pragma unroll 1
                for (int j = 0; j < 64; ++j) {
                    const int kj = kt * 64 + j;
                    float acc = 0.f;
#pragma unroll
                    for (int d4 = 0; d4 < 8; ++d4) { const f32x4 kv = *(const LAS f32x4*)(Ks + j * 64 + hf * 32 + d4 * 4); acc += q[4 * d4] * kv[0] + q[4 * d4 + 1] * kv[1] + q[4 * d4 + 2] * kv[2] + q[4 * d4 + 3] * kv[3]; }
                    acc += __shfl_xor(acc, 1);
                    acc += cq - CUM[kj];
                    if (kj <= qi) {
                        const float mn = fmaxf(mx, acc), sc = __builtin_amdgcn_exp2f(mx - mn), p = __builtin_amdgcn_exp2f(acc - mn); mx = mn; l = l * sc + p;
#pragma unroll
                        for (int d4 = 0; d4 < 8; ++d4) { const f32x4 vv = *(const LAS f32x4*)(Vs + j * 64 + hf * 32 + d4 * 4);
                            o[4 * d4] = o[4 * d4] * sc + p * vv[0]; o[4 * d4 + 1] = o[4 * d4 + 1] * sc + p * vv[1]; o[4 * d4 + 2] = o[4 * d4 + 2] * sc + p * vv[2]; o[4 * d4 + 3] = o[4 * d4 + 3] * sc + p * vv[3]; }
                    }
                }
            }
            const float il = 1.0f / l;
#pragma unroll
            for (int c = 0; c < 4; ++c) { const u32x4 gw = *(const u32x4*)(OG + qrow * D + h * 64 + hf * 32 + c * 8); u32x4 w;
                w.x = pk2(o[8 * c] * il * bf_lo(gw.x), o[8 * c + 1] * il * bf_hi(gw.x)); w.y = pk2(o[8 * c + 2] * il * bf_lo(gw.y), o[8 * c + 3] * il * bf_hi(gw.y));
                w.z = pk2(o[8 * c + 4] * il * bf_lo(gw.z), o[8 * c + 5] * il * bf_hi(gw.z)); w.w = pk2(o[8 * c + 6] * il * bf_lo(gw.w), o[8 * c + 7] * il * bf_hi(gw.w));
                *(u32x4*)(A2 + qrow * D + h * 64 + hf * 32 + c * 8) = w; }
        }
        __syncthreads();
    }
}

#include <hip/hip_bf16.h>
namespace attn_body {
using bf16=__hip_bfloat16;
using bf16x8=__attribute__((ext_vector_type(8)))short;
using s16x4=__attribute__((ext_vector_type(4)))short;
using f32x16=__attribute__((ext_vector_type(16)))float;
using u32x4=__attribute__((ext_vector_type(4)))unsigned;
constexpr int BATCH=8,NHEAD=16,SEQ=4096,D=64,DM=NHEAD*D;
constexpr int NW=8,QBLK=32,QB=QBLK*NW,KVBLK=64,NQB=SEQ/QB;
constexpr int ATTN_PITCH=DM, ATTN_UNIT_ROWS=QB;
__device__ __forceinline__ int crow(int r,int hi){return (r&3)+8*(r>>2)+4*hi;}
#define SBAR() __builtin_amdgcn_sched_barrier(0)
__device__ __forceinline__ void cmask(f32x16&p0,f32x16&p1,int jb,int qrel,int hi){
  const float NEG=-INFINITY; int kb=64*jb+4*hi;
  #pragma unroll
  for(int r=0;r<16;++r){int kv=kb+(r&3)+8*(r>>2); if(kv>qrel)p0[r]=NEG; if(kv+32>qrel)p1[r]=NEG;}
}

constexpr int NSLOT=3, SLOTB=8192;
constexpr int LDS_K=0, LDS_V=NSLOT*SLOTB, LDS_WS=2*NSLOT*SLOTB, LDS_OST=LDS_WS+NW*64*4, LDS_CUM=LDS_OST+NW*4096, LDS_BYTES=LDS_CUM+SEQ*4;
constexpr float C2=0.125f*1.4426950408889634f;
__device__ __forceinline__ void glds16(const void*gsrc,unsigned lds_dst){unsigned keep;
  asm volatile("s_mov_b32 %0, m0\n\ts_mov_b32 m0, %2\n\ts_nop 0\n\tglobal_load_lds_dwordx4 %1, off\n\ts_mov_b32 m0, %0":"=&s"(keep):"v"(gsrc),"s"(lds_dst):"memory");}
__device__ __forceinline__ float max3f(float a,float b,float c){float r;asm("v_max3_f32 %0, %1, %2, %3":"=v"(r):"v"(a),"v"(b),"v"(c));return r;}
__device__ __forceinline__ float max2f(float a,float b){float r;asm("v_max_f32_e32 %0, %1, %2":"=v"(r):"v"(a),"v"(b));return r;}
__device__ __forceinline__ float fadd_s(float a,float b){float r;asm("v_add_f32_e32 %0, %1, %2":"=v"(r):"v"(a),"v"(b));return r;}
__device__ __forceinline__ float fsub_s(float a,float b){float r;asm("v_sub_f32_e32 %0, %1, %2":"=v"(r):"v"(a),"v"(b));return r;}
typedef float f32x2_t __attribute__((ext_vector_type(2))); typedef float f32x4_t __attribute__((ext_vector_type(4))); typedef __bf16 bf16x2_t __attribute__((ext_vector_type(2)));
__device__ __forceinline__ unsigned cvtpk_s(float lo,float hi){f32x2_t v={lo,hi};bf16x2_t b=__builtin_convertvector(v,bf16x2_t);return __builtin_bit_cast(unsigned,b);}
#define WAIT_BAR(N) asm volatile("s_waitcnt vmcnt(" #N ") lgkmcnt(0)\n\ts_barrier":::"memory")

__device__ __forceinline__ void qkt(f32x16&p0,f32x16&p1,const char*Kslot,const bf16x8*qr,const f32x16&negm,int r32,int hi){
  const char*kb=Kslot+hi*1024+r32*16;
  #pragma unroll
  for(int d0=0;d0<4;++d0){
    const bf16x8 b0=*reinterpret_cast<const bf16x8*>(kb+d0*2048);
    const bf16x8 b1=*reinterpret_cast<const bf16x8*>(kb+d0*2048+512);
    if(d0==0){p0=__builtin_amdgcn_mfma_f32_32x32x16_bf16(b0,qr[0],negm,0,0,0);p1=__builtin_amdgcn_mfma_f32_32x32x16_bf16(b1,qr[0],negm,0,0,0);}
    else{p0=__builtin_amdgcn_mfma_f32_32x32x16_bf16(b0,qr[d0],p0,0,0,0);p1=__builtin_amdgcn_mfma_f32_32x32x16_bf16(b1,qr[d0],p1,0,0,0);}}
}
typedef __attribute__((address_space(3))) const char* lds_cptr;
typedef short v4i16_t __attribute__((ext_vector_type(4)));
__device__ __forceinline__ void kload8(bf16x8*kf,lds_cptr kp){
  kf[0]=*(const __attribute__((address_space(3))) bf16x8*)(kp);      kf[1]=*(const __attribute__((address_space(3))) bf16x8*)(kp+512);
  kf[2]=*(const __attribute__((address_space(3))) bf16x8*)(kp+2048); kf[3]=*(const __attribute__((address_space(3))) bf16x8*)(kp+2560);
  kf[4]=*(const __attribute__((address_space(3))) bf16x8*)(kp+4096); kf[5]=*(const __attribute__((address_space(3))) bf16x8*)(kp+4608);
  kf[6]=*(const __attribute__((address_space(3))) bf16x8*)(kp+6144); kf[7]=*(const __attribute__((address_space(3))) bf16x8*)(kp+6656);
}
__device__ __forceinline__ void kload2(bf16x8*kf,lds_cptr kp,int j){ kf[2*j]=*(const __attribute__((address_space(3))) bf16x8*)(kp+j*2048); kf[2*j+1]=*(const __attribute__((address_space(3))) bf16x8*)(kp+j*2048+512); }
__device__ __forceinline__ s16x4 vtr(lds_cptr p){ return __builtin_bit_cast(s16x4,__builtin_amdgcn_ds_read_tr16_b64_v4i16((__attribute__((address_space(3))) v4i16_t*)p)); }
__device__ __forceinline__ float rowmax(const f32x16&p0,const f32x16&p1){
  float a=max3f(p0[0],p0[1],p1[0]),b=max3f(p0[2],p0[3],p1[1]);a=max3f(a,p1[2],p1[3]);
  #pragma unroll
  for(int r=4;r<16;r+=4){a=max3f(a,p0[r],p0[r+1]);b=max3f(b,p0[r+2],p0[r+3]);a=max3f(a,p1[r],p1[r+1]);b=max3f(b,p1[r+2],p1[r+3]);}
  const float m=max2f(a,b);
  auto rr=__builtin_amdgcn_permlane32_swap(__float_as_uint(m),__float_as_uint(m),false,false);
  return max2f(__uint_as_float(rr[0]),__uint_as_float(rr[1]));
}
__device__ __forceinline__ void pv(f32x16*o,int vb,bf16x8 pa0,bf16x8 pa1,bf16x8 pa2,bf16x8 pa3){
  #pragma unroll
  for(int d0=0;d0<2;++d0){s16x4 lo[4],hi[4];
    #pragma unroll
    for(int ks=0;ks<4;++ks){
      asm volatile("ds_read_b64_tr_b16 %0,%1 offset:%c2":"=&v"(lo[ks]):"v"(vb),"i"(d0*4096+ks*1024):"memory");
      asm volatile("ds_read_b64_tr_b16 %0,%1 offset:%c2":"=&v"(hi[ks]):"v"(vb),"i"(d0*4096+ks*1024+512):"memory");}
    asm volatile("s_waitcnt lgkmcnt(0)":::"memory");SBAR();
    #define PK(k) (bf16x8){lo[k][0],lo[k][1],lo[k][2],lo[k][3],hi[k][0],hi[k][1],hi[k][2],hi[k][3]}
    o[d0]=__builtin_amdgcn_mfma_f32_32x32x16_bf16(pa0,PK(0),o[d0],0,0,0);
    o[d0]=__builtin_amdgcn_mfma_f32_32x32x16_bf16(pa1,PK(1),o[d0],0,0,0);
    o[d0]=__builtin_amdgcn_mfma_f32_32x32x16_bf16(pa2,PK(2),o[d0],0,0,0);
    o[d0]=__builtin_amdgcn_mfma_f32_32x32x16_bf16(pa3,PK(3),o[d0],0,0,0);
    #undef PK
  }
}

#ifndef ATTN_STORE16
#define ATTN_STORE16(p,v) (*(u32x4*)(p)=(v))
#endif
constexpr float MFLOOR=-24.0f;
template<int THRL> __device__ __forceinline__ void attn_unit(int b,int h,int qb,int ts,const bf16*Q,const bf16*__restrict__ K,const bf16*__restrict__ V,const bf16*__restrict__ OG,bf16*O,char*shm){
  int tid=threadIdx.x; asm volatile("":"+v"(tid));
  const int lane=tid&63,r32=lane&31,hi=lane>>5; const int wid=__builtin_amdgcn_readfirstlane(tid>>6);
  const long rowbase=(long)b*SEQ; const int q0=qb*QB;
  const bf16*Qw=Q+(rowbase+q0+wid*QBLK)*DM+h*D;
  const bf16*Kh=K+(rowbase+(long)ts*KVBLK)*DM+h*D,*Vh=V+(rowbase+(long)ts*KVBLK)*DM+h*D;
  const lds_cptr shm3=(lds_cptr)shm;
  const unsigned lds0=(unsigned)(uintptr_t)shm;
  float*wsf=(float*)(shm+LDS_WS)+wid*64;
  const bf16*ksrc=Kh+(long)lane*DM+wid*8;
  const bf16*vsrc=Vh+(long)(16*(wid&3)+(lane>>2))*DM+(wid>>2)*32+(lane&3)*8;
  const unsigned kdst=lds0+LDS_K+wid*1024, vdst=lds0+LDS_V+wid*1024;
  #define DMA_K(t,slot) glds16(ksrc+(long)(t)*KVBLK*DM,(unsigned)__builtin_amdgcn_readfirstlane(kdst+(slot)))
  #define DMA_V(t,slot) glds16(vsrc+(long)(t)*KVBLK*DM,(unsigned)__builtin_amdgcn_readfirstlane(vdst+(slot)))
  const int vb0=(int)(lds0+LDS_V)+((lane>>4)&1)*32+(lane&3)*8+(4*hi+((lane&15)>>2))*64;
  const char*Kbase=shm+LDS_K; bf16x8 kf[8];
  const lds_cptr kp0=shm3+LDS_K+hi*1024+r32*16; const lds_cptr vp0=shm3+LDS_V+((lane>>4)&1)*32+(lane&3)*8+(4*hi+((lane&15)>>2))*64;
  const int NT=(q0+QB)/KVBLK-ts;
  DMA_K(0,0);DMA_V(0,0);DMA_K(1,SLOTB);
  bf16x8 qr[4];
  #pragma unroll
  for(int d0=0;d0<4;++d0)qr[d0]=*reinterpret_cast<const bf16x8*>(&Qw[(long)r32*DM+d0*16+hi*8]);
  const int qrel=wid*QBLK+r32;
  const __attribute__((address_space(3))) float* cum3=(const __attribute__((address_space(3))) float*)(shm3+LDS_CUM);
  const float cqv=cum3[q0+qrel];
  float mhat=0.f,l_reg=0.f;f32x16 o[2];o[0]=f32x16{};o[1]=f32x16{};f32x16 negm;
  _Pragma("unroll") for(int r=0;r<16;++r)negm[r]=cqv; asm volatile("":"+v"(negm));
  #define FBIAS(P0,P1,t) do{ const __attribute__((address_space(3))) float* cp_=cum3+((t)+ts)*KVBLK+4*hi; \
    _Pragma("unroll") for(int g_=0;g_<4;++g_){ const f32x4_t a_=*(const __attribute__((address_space(3))) f32x4_t*)(cp_+8*g_), b_=*(const __attribute__((address_space(3))) f32x4_t*)(cp_+32+8*g_); \
      P0[4*g_]-=a_[0];P0[4*g_+1]-=a_[1];P0[4*g_+2]-=a_[2];P0[4*g_+3]-=a_[3]; P1[4*g_]-=b_[0];P1[4*g_+1]-=b_[1];P1[4*g_+2]-=b_[2];P1[4*g_+3]-=b_[3]; } }while(0)
  #define CMASK(P0,P1,t) do{int jb_=(t)-(NT-4); if(jb_>=0)cmask(P0,P1,jb_,qrel,hi);}while(0)
  bool resc=false;
  #define START(P0,P1) do{ const float rm=rowmax(P0,P1); resc=false; \
    { const float dl=max2f(rm,MFLOOR); mhat=fadd_s(mhat,dl); \
      _Pragma("unroll") for(int r=0;r<16;++r){P0[r]=fsub_s(P0[r],dl);P1[r]=fsub_s(P1[r],dl);} \
      _Pragma("unroll") for(int r=0;r<16;++r)negm[r]=cqv-mhat; asm volatile("":"+v"(negm)); } \
    _Pragma("unroll") for(int r=0;r<16;++r)P0[r]=__builtin_amdgcn_exp2f(P0[r]); }while(0)
  #define RESC() do{ if(resc){ asm volatile("s_waitcnt lgkmcnt(0)":::"memory"); \
      _Pragma("unroll") for(int d_=0;d_<2;++d_) _Pragma("unroll") for(int r=0;r<16;++r)o[d_][r]*=wsf[crow(r,hi)]; } }while(0)
  f32x16 pA0,pA1,pB0,pB1;
  int sl_prev=0,sl_cur=0,sl_next=SLOTB;
  #define ROT() do{sl_prev=sl_cur;sl_cur=sl_next;sl_next=(sl_next==(NSLOT-1)*SLOTB)?0:sl_next+SLOTB;}while(0)
  DMA_K(2,2*SLOTB);
  WAIT_BAR(3);
  qkt(pA0,pA1,Kbase,qr,negm,r32,hi);asm volatile("s_nop 15\n\ts_nop 7":"+v"(pA0),"+v"(pA1));FBIAS(pA0,pA1,0);CMASK(pA0,pA1,0);
  START(pA0,pA1);
  _Pragma("unroll") for(int r=0;r<16;++r)pA1[r]=__builtin_amdgcn_exp2f(pA1[r]);
  WAIT_BAR(0);
  DMA_K(3,0);DMA_V(1,SLOTB);
  ROT();
  kload8(kf,kp0+sl_cur);
  WAIT_BAR(2);
  s16x4 vlo[8],vhi[8]; u32x4 pw0,pw1,pw2,pw3;
  #define PKW(P,B) cvtpk_s(P[B],P[B+1])
  #define PAF(k) __builtin_bit_cast(bf16x8,pw##k)
  #define VFR(i) (bf16x8){vlo[i][0],vlo[i][1],vlo[i][2],vlo[i][3],vhi[i][0],vhi[i][1],vhi[i][2],vhi[i][3]}
  #define PIN(x) asm volatile("":"+v"(x))
  #define MX3(a,b,c) __builtin_fmaxf(__builtin_fmaxf((a),(b)),(c))
  #define GAPA(MF,A0,A1,A2,A3,W0,W1,PW) do{ MF; sacc+=A0; sacc+=A1; sacc+=A2; sacc+=A3; PIN(sacc); W0; W1; PIN(PW); SBAR(); }while(0)
  #define EX(v) __builtin_amdgcn_exp2f(v)
  #define GAPB(MF,X,B) do{ MF; X[B]=EX(X[B]); X[B+1]=EX(X[B+1]); X[B+2]=EX(X[B+2]); X[B+3]=EX(X[B+3]); PIN(X); SBAR(); }while(0)
  #define VRD(i) do{ vlo[i]=vtr(vp_+(((i)>>2)*4096+((i)&3)*1024)); vhi[i]=vtr(vp_+(((i)>>2)*4096+((i)&3)*1024+512)); }while(0)
  #define KRD(G,j) do{ if(G){ kload2(kf,kp0+sl_next,j); SBAR(); } }while(0)
  #define STEP(C0,C1,P0,P1,t,GK,GV,GL) do{ SBAR(); \
    const lds_cptr vp_=vp0+sl_prev; \
    VRD(0); SBAR(); float sacc=(P0[0]+P0[1]); \
    GAPA(C0=__builtin_amdgcn_mfma_f32_32x32x16_bf16(kf[0],qr[0],negm,0,0,0), P0[2],P0[3],P0[4],P0[5],     pw0[0]=PKW(P0,0), pw0[1]=PKW(P0,2), pw0); \
    VRD(4); SBAR(); GAPA(C1=__builtin_amdgcn_mfma_f32_32x32x16_bf16(kf[1],qr[0],negm,0,0,0), P0[6],P0[7],P0[8],P0[9],     pw0[2]=PKW(P0,4), pw0[3]=PKW(P0,6), pw0); \
    VRD(1); SBAR(); GAPA(C0=__builtin_amdgcn_mfma_f32_32x32x16_bf16(kf[2],qr[1],C0,0,0,0),   P0[10],P0[11],P0[12],P0[13], pw1[0]=PKW(P0,8), pw1[1]=PKW(P0,10), pw1); \
    VRD(5); SBAR(); GAPA(C1=__builtin_amdgcn_mfma_f32_32x32x16_bf16(kf[3],qr[1],C1,0,0,0),   P0[14],P0[15],P1[0],P1[1],   pw1[2]=PKW(P0,12),pw1[3]=PKW(P0,14), pw1); \
    VRD(2); SBAR(); GAPA(C0=__builtin_amdgcn_mfma_f32_32x32x16_bf16(kf[4],qr[2],C0,0,0,0),   P1[2],P1[3],P1[4],P1[5],     pw2[0]=PKW(P1,0), pw2[1]=PKW(P1,2), pw2); \
    VRD(6); SBAR(); GAPA(C1=__builtin_amdgcn_mfma_f32_32x32x16_bf16(kf[5],qr[2],C1,0,0,0),   P1[6],P1[7],P1[8],P1[9],     pw2[2]=PKW(P1,4), pw2[3]=PKW(P1,6), pw2); \
    VRD(3); SBAR(); GAPA(C0=__builtin_amdgcn_mfma_f32_32x32x16_bf16(kf[6],qr[3],C0,0,0,0),   P1[10],P1[11],P1[12],P1[13], pw3[0]=PKW(P1,8), pw3[1]=PKW(P1,10), pw3); \
    VRD(7); SBAR(); GAPA(C1=__builtin_amdgcn_mfma_f32_32x32x16_bf16(kf[7],qr[3],C1,0,0,0),   P1[14],P1[15],0.f,0.f,       pw3[2]=PKW(P1,12),pw3[3]=PKW(P1,14), pw3); \
    l_reg+=sacc; \
    if(GK){DMA_K((t)+3,sl_cur);} if(GV){DMA_V((t)+1,sl_next);} \
    FBIAS(C0,C1,t); CMASK(C0,C1,t); \
    { float a=MX3(C0[0],C0[1],C1[0]),b=MX3(C0[2],C0[3],C1[1]); a=MX3(a,C1[2],C1[3]); \
      _Pragma("unroll") for(int r=4;r<16;r+=4){a=MX3(a,C0[r],C0[r+1]);b=MX3(b,C0[r+2],C0[r+3]);a=MX3(a,C1[r],C1[r+1]);b=MX3(b,C1[r+2],C1[r+3]);} \
      float rm=__builtin_fmaxf(a,b); { auto rr=__builtin_amdgcn_permlane32_swap(__float_as_uint(rm),__float_as_uint(rm),false,false); rm=__builtin_fmaxf(__uint_as_float(rr[0]),__uint_as_float(rr[1])); } \
      resc=false; \
      if(__builtin_expect(__any(rm>(float)THRL),0)){ const float dl=__builtin_fmaxf(rm,0.f); mhat+=dl; \
        _Pragma("unroll") for(int r=0;r<16;++r){C0[r]-=dl;C1[r]-=dl;} \
        _Pragma("unroll") for(int r=0;r<16;++r)negm[r]=cqv-mhat; asm volatile("":"+v"(negm)); \
        const float f=__builtin_amdgcn_exp2f(-dl); l_reg*=f; if(hi==0)wsf[r32]=f; resc=true; } } \
    SBAR(); \
    GAPB(o[0]=__builtin_amdgcn_mfma_f32_32x32x16_bf16(PAF(0),VFR(0),o[0],0,0,0), C0,0); \
    GAPB(o[1]=__builtin_amdgcn_mfma_f32_32x32x16_bf16(PAF(0),VFR(4),o[1],0,0,0), C0,4); \
    KRD(GL,0); GAPB(o[0]=__builtin_amdgcn_mfma_f32_32x32x16_bf16(PAF(1),VFR(1),o[0],0,0,0), C0,8); \
    KRD(GL,1); GAPB(o[1]=__builtin_amdgcn_mfma_f32_32x32x16_bf16(PAF(1),VFR(5),o[1],0,0,0), C0,12); \
    KRD(GL,2); GAPB(o[0]=__builtin_amdgcn_mfma_f32_32x32x16_bf16(PAF(2),VFR(2),o[0],0,0,0), C1,0); \
    KRD(GL,3); GAPB(o[1]=__builtin_amdgcn_mfma_f32_32x32x16_bf16(PAF(2),VFR(6),o[1],0,0,0), C1,4); \
    GAPB(o[0]=__builtin_amdgcn_mfma_f32_32x32x16_bf16(PAF(3),VFR(3),o[0],0,0,0), C1,8); \
    GAPB(o[1]=__builtin_amdgcn_mfma_f32_32x32x16_bf16(PAF(3),VFR(7),o[1],0,0,0), C1,12); \
    }while(0)
  int t=1;
  #undef CMASK
  #define CMASK(P0,P1,t) do{}while(0)
  for(;t+5<NT;t+=2){
    STEP(pB0,pB1,pA0,pA1,t,true,true,true);     WAIT_BAR(2); RESC(); ROT();
    STEP(pA0,pA1,pB0,pB1,t+1,true,true,true);   WAIT_BAR(2); RESC(); ROT();
  }
  #undef CMASK
  #define CMASK(P0,P1,t) do{int jb_=(t)-(NT-4); if(jb_>=0)cmask(P0,P1,jb_,qrel,hi);}while(0)
  #define ENDW(tt) do{ if((tt)+3<NT){WAIT_BAR(2);} else if((tt)+2<NT){WAIT_BAR(1);} else {WAIT_BAR(0);} }while(0)
  for(;t+1<NT;t+=2){
    STEP(pB0,pB1,pA0,pA1,t,(t+3<NT),(t+1<NT),(t+1<NT));       ENDW(t);   RESC(); ROT();
    STEP(pA0,pA1,pB0,pB1,t+1,(t+4<NT),(t+2<NT),(t+2<NT));     ENDW(t+1); RESC(); ROT();
  }
  STEP(pB0,pB1,pA0,pA1,NT-1,false,false,false); RESC();
  { float sacc=pB0[0]+pB0[1]; _Pragma("unroll") for(int r=2;r<16;++r)sacc+=pB0[r]; _Pragma("unroll") for(int r=0;r<16;++r)sacc+=pB1[r]; l_reg+=sacc;
    pw0=(u32x4){PKW(pB0,0),PKW(pB0,2),PKW(pB0,4),PKW(pB0,6)};pw1=(u32x4){PKW(pB0,8),PKW(pB0,10),PKW(pB0,12),PKW(pB0,14)};pw2=(u32x4){PKW(pB1,0),PKW(pB1,2),PKW(pB1,4),PKW(pB1,6)};pw3=(u32x4){PKW(pB1,8),PKW(pB1,10),PKW(pB1,12),PKW(pB1,14)};
    SBAR(); pv(o,vb0+sl_cur,PAF(0),PAF(1),PAF(2),PAF(3)); }
  #undef PKW
  #undef PAF
  #undef VFR
  #undef PIN
  #undef MX3
  #undef GAPA
  #undef GAPB
  #undef EX
  #undef VRD
  #undef KRD
  #undef STEP
  #undef ENDW
  {auto rr=__builtin_amdgcn_permlane32_swap(__float_as_uint(l_reg),__float_as_uint(l_reg),false,false);l_reg=__uint_as_float(rr[0])+__uint_as_float(rr[1]);}
  if(hi==0)wsf[32+r32]=l_reg;asm volatile("s_waitcnt lgkmcnt(0)":::"memory");
  float rli[16];
  #pragma unroll
  for(int r=0;r<16;++r)rli[r]=__builtin_amdgcn_rcpf(wsf[32+crow(r,hi)]);
  bf16*Ow=O+(rowbase+q0+wid*QBLK)*DM+h*D;
  { bf16*stg=(bf16*)(shm+LDS_OST)+wid*2048;
    #pragma unroll
    for(int r=0;r<16;++r){const int orow=crow(r,hi);
      #pragma unroll
      for(int d0=0;d0<2;++d0)stg[orow*64+d0*32+r32]=__float2bfloat16(o[d0][r]*rli[r]);}
    asm volatile("s_waitcnt lgkmcnt(0)":::"memory");
    const bf16*Gw=OG+(rowbase+q0+wid*QBLK)*DM+h*D;
    #pragma unroll
    for(int i=0;i<4;++i){const int row=i*8+(lane>>3),ch=lane&7; const u32x4 v=*(const u32x4*)(stg+row*64+ch*8); const u32x4 g=*(const u32x4*)(Gw+(long)row*DM+ch*8); u32x4 w;
      _Pragma("unroll") for(int e=0;e<4;++e){ const float lo=__uint_as_float(v[e]<<16)*__uint_as_float(g[e]<<16), hi2=__uint_as_float(v[e]&0xffff0000u)*__uint_as_float(g[e]&0xffff0000u); w[e]=cvtpk_s(lo,hi2); }
      ATTN_STORE16(Ow+(long)row*DM+ch*8,w);} }
  asm volatile("s_waitcnt lgkmcnt(0)\n\ts_barrier":::"memory");
  #undef DMA_K
  #undef DMA_V
  #undef CMASK
  #undef FBIAS
  #undef START
  #undef RESC
  #undef ROT
}
constexpr int ATTN_LDS_BYTES=LDS_BYTES;
struct AttnTensors { const bf16* Q; const bf16* K; const bf16* V; const bf16* G; bf16* O; };
struct AttnUnit { int bh; int qb; };
struct StaticOrder {
  int vcu;
  __device__ __forceinline__ explicit StaticOrder(int grid,int block):vcu((block%8)*(grid/8)+block/8){}
  __device__ __forceinline__ bool next(int i,AttnUnit&u)const{ if(i>=8)return false; const int s=2*(i>>1)+(vcu&1); u.bh=vcu>>1; u.qb=(i&1)?15-s:s; return true; }
  __device__ __forceinline__ void a_ready(const AttnUnit&)const{}
  __device__ __forceinline__ void done(const AttnUnit&)const{}
};
template<class Sched,int THRL=8> __device__ __forceinline__ void attn_phase(char*lds,const AttnTensors&T,const Sched&S){
  AttnUnit u;
  for(int i=0;S.next(i,u);++i){ S.a_ready(u); attn_unit<THRL>(u.bh/NHEAD,u.bh%NHEAD,u.qb,0,T.Q,T.K,T.V,T.G,T.O,lds); S.done(u); }
}
#undef SBAR
#undef WAIT_BAR
}

__device__ __forceinline__ void fox_cum_phase(LAS unsigned char* lds, const float* lf, float* cumg, int G) {
    const int tid = opaque_tid();
    LAS float* SCN = (LAS float*)lds;
    for (int bh = blockIdx.x; bh < NB * 16; bh += G) {
        const int b = bh >> 4, h = bh & 15;
        float loc[8]; float s = 0.f;
#pragma unroll
        for (int i = 0; i < 8; ++i) { s += lf[((size_t)b * SEQ + 8 * tid + i) * 16 + h]; loc[i] = s; }
        float ws_ = s;
        asm volatile("s_nop 1\n\t"
                     "v_add_f32_dpp %0, %0, %0 row_shr:1 row_mask:0xf bank_mask:0xf bound_ctrl:1\n\ts_nop 1\n\t"
                     "v_add_f32_dpp %0, %0, %0 row_shr:2 row_mask:0xf bank_mask:0xf bound_ctrl:1\n\ts_nop 1\n\t"
                     "v_add_f32_dpp %0, %0, %0 row_shr:4 row_mask:0xf bank_mask:0xf bound_ctrl:1\n\ts_nop 1\n\t"
                     "v_add_f32_dpp %0, %0, %0 row_shr:8 row_mask:0xf bank_mask:0xf bound_ctrl:1\n\ts_nop 1\n\t"
                     "v_add_f32_dpp %0, %0, %0 row_bcast:15 row_mask:0xa bank_mask:0xf\n\ts_nop 1\n\t"
                     "v_add_f32_dpp %0, %0, %0 row_bcast:31 row_mask:0xc bank_mask:0xf\n\ts_nop 1" : "+v"(ws_));
        __syncthreads();
        if ((tid & 63) == 63) SCN[tid >> 6] = ws_;
        __syncthreads();
        float base = ws_ - s;
        for (int w8 = 0; w8 < (tid >> 6); ++w8) base += SCN[w8];
        f32x4 o0, o1;
#pragma unroll
        for (int i = 0; i < 4; ++i) { o0[i] = (base + loc[i]) * LOG2E; o1[i] = (base + loc[4 + i]) * LOG2E; }
        *(f32x4*)(cumg + (size_t)bh * SEQ + 8 * tid) = o0; *(f32x4*)(cumg + (size_t)bh * SEQ + 8 * tid + 4) = o1;
    }
    __syncthreads();
}
__device__ __forceinline__ void fox_attn_phase(unsigned char* ldsg, LAS unsigned char* lds, const float* qg, const float* kg) {
    LAS float* CUM = (LAS float*)(lds + attn_body::LDS_CUM);
    LAS int* BC = (LAS int*)(lds + LDS_TAB);
    float gq = 0.f, gk = 0.f;
    for (int i = 0; i < 64; ++i) { gq = fmaxf(gq, fabsf(qg[i])); gk = fmaxf(gk, fabsf(kg[i])); }
    if (opaque_tid() == 0) ((LAS float*)BC)[2] = 2.0f * 64.0f * attn_body::C2 * gq * gk + 48.0f;
    __syncthreads();
#define Tskip (((const LAS float*)BC)[2])
    int cur_bh = -1;
    for (;;) {
        const int tid = opaque_tid();
        unsigned char* const wsb = karg_ws();
        const float* cumg = (const float*)(wsb + WS_CUMG);
        if (tid == 0) BC[0] = (int)atomicAdd((unsigned*)(wsb + WS_CTL) + CW_ATTQ, 1u);
        __syncthreads();
        const int u = __builtin_amdgcn_readfirstlane(BC[0]);
        if (u >= NB * 16 * 16) break;
        const int qb = 15 - (u >> 7), bh = u & 127;
        if (bh != cur_bh) { cur_bh = bh;
            *(LAS f32x4*)(CUM + 8 * tid) = *(const f32x4*)(cumg + (size_t)bh * SEQ + 8 * tid); *(LAS f32x4*)(CUM + 8 * tid + 4) = *(const f32x4*)(cumg + (size_t)bh * SEQ + 8 * tid + 4); }
        __syncthreads();
        if (tid < 64) { const int ntf = 4 * qb + 4; const bool dead = (tid < ntf) && (CUM[qb * 256] - CUM[64 * tid + 63] < -Tskip);
            const unsigned long long m = __ballot(dead);
            if (tid == 0) { int ts = __popcll(m) & ~1; ts = ts > ntf - 4 ? ntf - 4 : ts; BC[1] = ts; } }
        __syncthreads();
        const int ts = __builtin_amdgcn_readfirstlane(BC[1]);
        unsigned char* const sb = wsb + WS_SCR;
        attn_body::attn_unit<8>(bh >> 4, bh & 15, qb, ts, (const attn_body::bf16*)(sb + S_FQ), (const attn_body::bf16*)(sb + S_FK), (const attn_body::bf16*)(sb + S_FV), (const attn_body::bf16*)(sb + S_FG), (attn_body::bf16*)(sb + S_A2), (char*)ldsg);
    }
#undef Tskip
}

constexpr int PH_PER_LAYER = 8, N_PHASES = 1 + DEPTH * PH_PER_LAYER + 1;

__device__ __forceinline__ void moe_tab(LAS unsigned char* lds, const unsigned* cnt) {
    LAS int* TAB = (LAS int*)(lds + LDS_TAB);
    if (threadIdx.x == 0) { int s = 0; for (int e = 0; e < NE; ++e) { const int c = (int)cnt[e]; TAB[e] = s; TAB[16 + e] = c; s += (c + 255) >> 8; } TAB[8] = s; }
    __syncthreads();
}

__global__ void __launch_bounds__(NTHR, 2) mk_fwd(Args args) {
#define bWS (karg_ws())
#define bCTL ((unsigned*)(bWS + WS_CTL))
#define bMOD ((float*)(bWS + WS_MOD))
#define bX ((bf16_t*)(bWS + WS_X))
#define bH ((bf16_t*)(bWS + WS_H))
#define bY ((bf16_t*)(bWS + WS_Y))
#define bTOK ((int*)(bWS + WS_TOK))
#define bTINFO ((u32x4*)(bWS + WS_TINFO))
#define bLF ((float*)(bWS + WS_LF))
#define bSCR (bWS + WS_SCR)
#define bA2 ((bf16_t*)(bSCR + S_A2))
    extern __shared__ __attribute__((aligned(16))) unsigned char lds_raw[];
    LAS unsigned char* lds = (LAS unsigned char*)lds_raw;
    const int tid = threadIdx.x, G = gridDim.x;
    const int vcu = (G % 8 == 0) ? ((int)blockIdx.x % 8) * (G / 8) + (int)blockIdx.x / 8 : (int)blockIdx.x;
    if (tid < 8) ((volatile LAS unsigned*)(lds + LDS_MISC))[tid] = 0u;
    __syncthreads();
#if MK_N_LAUNCHES == 1
    XcdBarrier bar = xcd_barrier_post(bCTL + CW_BAR, (volatile LAS unsigned*)(lds + LDS_MISC));
#define SEAM() xcd_barrier(bar)
#else
#define SEAM() do { } while (0)
#endif
    const int lo = args.ph_lo, hi = args.ph_hi;
#define IN(k) (lo <= (k) && (k) < hi)
#define BOTH(k) (IN(k) && IN((k) + 1))

    if (IN(0)) for (int rep = 0; rep < NREP(0); ++rep) { phase_prologue(lds, args, vcu, G); if (BOTH(0)) SEAM(); }

    for (int L = 0; L < DEPTH; ++L) {
        const int pb = 1 + PH_PER_LAYER * L, mixer = L % 3, mj = L / 3, fj = L >> 1; const bool moe = (L & 1) != 0, prev_moe = (L > 0) && (((L - 1) & 1) != 0);
#define modL (bMOD + (size_t)L * NB * MOD_W)
#define modP (bMOD + (size_t)(L > 0 ? L - 1 : 0) * NB * MOD_W)
#define xin_first ((L == 0) ? karg_in(I_X) : (const float*)bX)
        if (IN(pb + 0)) for (int rep = 0; rep < NREP(pb + 0); ++rep) {
            NormArgs na{}; na.xin = xin_first; na.xout = (float*)bX; na.H = bH; na.sc = modL + D; na.sh = modL; na.combine = prev_moe; na.cscale = (float)(int)(ABLATE != 2 * (L - 1) + 1); na.Y = bY; na.tinfo = bTINFO; na.g2p = modP + 5 * D; na.cntp = bCTL + CW_CNT + 64 * ((L - 1) >> 1);
            if (mixer == 0) { na.wx = karg_in(I_GLA_WIN) + (size_t)mj * D * GLA_IN + 3072; na.wx_pitch = GLA_IN; na.w2 = karg_in(I_GLA_WG2) + (size_t)mj * 16 * 512; na.bvec = karg_in(I_GLA_BG) + mj * 512;
                na.Dk = (float*)(bSCR + S_DK); na.dref = (float*)(bSCR + S_DR); na.etot = (float*)(bSCR + S_ET); if (L == 0) norm_mfma2<1, true>(lds, na, opq(G)); else norm_mfma2<1, false>(lds, na, opq(G)); }
            else if (mixer == 1) { na.wx_pitch = CONV_FP8 ? -1 : 0; norm_phase<0>(lds, na, opq(G)); }
            else { na.wx = karg_in(I_FOX_WIN) + 3072; na.wx_pitch = FOX_IN; na.bvec = karg_in(I_FOX_BF); na.lf = bLF; norm_mfma2<2>(lds, na, opq(G)); }
            if (BOTH(pb + 0)) SEAM();
        }
        if (IN(pb + 1)) for (int rep = 0; rep < NREP(pb + 1); ++rep) {
            if (mixer == 0) {
                pg8::DenseSched S{NTOK / 256, 3072 / 256, opq(G), opq((int)blockIdx.x), 2 * D, (const char*)(bWS + W_GLA_IN + mj * SZ_GLA_IN)};
                pg8::EpiGlaIn E{(bf16_t*)(bSCR + S_QG), (bf16_t*)(bSCR + S_KD), (bf16_t*)(bSCR + S_V), (bf16_t*)(bSCR + S_R), (const float*)(bSCR + S_DK), (const float*)(bSCR + S_DR)};
                pg8::gemm_phase(lds, (const char*)bH, S, E);
            } else if (mixer == 1) {
                pg8::DenseSched S{NTOK / 256, 2048 / 256, opq(G), opq((int)blockIdx.x), CONV_FP8 ? D : 2 * D, (const char*)(bWS + W_CONV_IN)};
                pg8::EpiGated<1> E{(bf16_t*)bSCR, D, karg_in(I_CONV_BIN), 1024, CONV_FP8 ? 1.0f / F8_W13 : 1.0f, 1.0f};
                pg8::gemm_phase<pg8::EpiGated<1>, pg8::DenseSched, CONV_FP8 != 0>(lds, (const char*)bH, S, E);
            } else {
                if (rep == 0) fox_cum_phase(lds, bLF, (float*)(bWS + WS_CUMG), opq(G));
                { pg8::DenseSched S{NTOK / 256, 3072 / 256, opq(G), opq((int)blockIdx.x), 2 * D, (const char*)(bWS + W_FOX_IN)};
                  pg8::EpiFoxIn E{(bf16_t*)(bSCR + S_FQ), (bf16_t*)(bSCR + S_FK), (bf16_t*)(bSCR + S_FV), (bf16_t*)(bSCR + S_FG), karg_in(I_FOX_QN), karg_in(I_FOX_KN), 0, 1.0f};
                  pg8::gemm_phase(lds, (const char*)bH, S, E); }
                { pg8::DenseSched S{NTOK / 256, 1024 / 256, opq(G), opq((int)blockIdx.x), FOXG_FP8 ? D : 2 * D, (const char*)(bWS + W_FOX_IN + (size_t)3072 * D * 2)};
                  pg8::EpiFoxIn E{(bf16_t*)(bSCR + S_FQ), (bf16_t*)(bSCR + S_FK), (bf16_t*)(bSCR + S_FV), (bf16_t*)(bSCR + S_FG), karg_in(I_FOX_QN), karg_in(I_FOX_KN), 12, FOXG_FP8 ? 1.0f / F8_W13 : 1.0f};
                  pg8::gemm_phase<pg8::EpiFoxIn, pg8::DenseSched, FOXG_FP8 != 0>(lds, FOXG_FP8 ? (const char*)(bWS + WS_H8) : (const char*)bH, S, E); }
            }
            if (BOTH(pb + 1)) SEAM();
        }
        if (IN(pb + 2)) for (int rep = 0; rep < NREP(pb + 2); ++rep) {
            if (mixer == 0) gla_scan_mfma(lds, (const bf16_t*)(bSCR + S_QG), (const bf16_t*)(bSCR + S_KD), (const bf16_t*)(bSCR + S_V), (const float*)(bSCR + S_ET), (bf16_t*)(bSCR + S_O), opq(vcu), opq(G));
            else if (mixer == 1) conv_phase(lds, (const bf16_t*)bSCR, karg_in(I_CONV_DW), karg_in(I_CONV_DWB), karg_in(I_CONV_LNG), karg_in(I_CONV_LNB), bA2, opq(vcu), opq(G));
            else fox_attn_phase(lds_raw, lds, karg_in(I_FOX_QN), karg_in(I_FOX_KN));
            if (BOTH(pb + 2)) SEAM();
        }
        if (IN(pb + 3)) for (int rep = 0; rep < NREP(pb + 3); ++rep) {
            if (mixer == 0) { gla_gn_phase((const bf16_t*)(bSCR + S_O), (const bf16_t*)(bSCR + S_R), karg_in(I_GLA_GN) + mj * D, bA2, opq(vcu), opq(G)); if (BOTH(pb + 3)) SEAM(); }
        }
        if (IN(pb + 4)) for (int rep = 0; rep < NREP(pb + 4); ++rep) {
            const float* wsrc = nullptr; const float* bias = nullptr; size_t woff = 0;
            if (mixer == 0) woff = W_GLA_OUT + mj * SZ_SQ; else if (mixer == 1) { woff = W_CONV_OUT; bias = karg_in(I_CONV_BOUT); } else woff = W_FOX_OUT;
            (void)wsrc;
            pg8::DenseSched S{NTOK / 256, D / 256, opq(G), opq((int)blockIdx.x), 2 * D, (const char*)(bWS + woff)};
            pg8::EpiOut E{(L == 0) ? karg_in(I_X) : (const float*)nullptr, bX, bX, modL + 2 * D, bias, (float)(int)(ABLATE != 2 * L)};
            pg8::gemm_phase(lds, (const char*)bA2, S, E);
            if (BOTH(pb + 4)) SEAM();
        }
        if (IN(pb + 5)) for (int rep = 0; rep < NREP(pb + 5); ++rep) {
            NormArgs na{}; na.xin = (const float*)bX; na.xout = (float*)bX; na.H = bH; na.sc = modL + 4 * D; na.sh = modL + 3 * D; na.combine = false;
            if (!moe) { na.wx_pitch = FFN_FP8 ? -1 : 0; norm_phase<0>(lds, na, opq(G)); if (DUP_NORM == 1) { __syncthreads(); norm_phase<0>(lds, na, opq(G)); } }
            else { na.wx = karg_in(I_MOE_R) + (size_t)fj * D * NE; na.wx_pitch = NE; na.tok = bTOK; na.tinfo_out = bTINFO; na.cnt = bCTL + CW_CNT + 64 * fj; norm_mfma2<3>(lds, na, opq(G)); }
            if (BOTH(pb + 5)) SEAM();
        }
        if (IN(pb + 6)) for (int rep = 0; rep < NREP(pb + 6); ++rep) {
            if (!moe) {
                pg8::DenseSched S{NTOK / 256, 2 * DFF / 256, opq(G), opq((int)blockIdx.x), FFN_FP8 ? D : 2 * D, (const char*)(bWS + W_FFN13 + fj * SZ_FFN13)};
                pg8::EpiGated<0> E{(bf16_t*)bSCR, DFF, nullptr, DFF, FFN_FP8 ? 1.0f / F8_W13 : 1.0f, 1.0f};
                pg8::gemm_phase<pg8::EpiGated<0>, pg8::DenseSched, FFN_FP8 != 0>(lds, (const char*)bH, S, E);
            } else {
                moe_tab(lds, bCTL + CW_CNT + 64 * fj);
                const LAS int* TAB = (const LAS int*)(lds + LDS_TAB);
                pg8::MoeSched S{TAB[8], 2 * DFE / 256, opq(G), opq((int)blockIdx.x), MOE_FP8 ? D : 2 * D, (const char*)(bWS + W_MOE13 + (size_t)fj * 8 * MOE13_STRIDE), MOE13_STRIDE, bTOK, TAB};
                pg8::EpiGated<0, MOE_FP8 != 0> E{(bf16_t*)bSCR, DFE, nullptr, DFE, MOE_FP8 ? 1.0f / F8_W13 : 1.0f, F8_HID};
                pg8::gemm_phase<pg8::EpiGated<0, MOE_FP8 != 0>, pg8::MoeSched, MOE_FP8 != 0>(lds, (const char*)bH, S, E);
            }
            if (BOTH(pb + 6)) SEAM();
        }
        if (IN(pb + 7)) for (int rep = 0; rep < NREP(pb + 7); ++rep) {
            if (!moe) {
                pg8::DenseSched S{NTOK / 256, D / 256, opq(G), opq((int)blockIdx.x), 2 * DFF, (const char*)(bWS + W_FFN2 + fj * SZ_FFN2)};
                pg8::EpiOut E{nullptr, bX, bX, modL + 5 * D, nullptr, (float)(int)(ABLATE != 2 * L + 1)};
                pg8::gemm_phase(lds, (const char*)bSCR, S, E);
            } else {
                moe_tab(lds, bCTL + CW_CNT + 64 * fj);
                const LAS int* TAB = (const LAS int*)(lds + LDS_TAB);
                pg8::MoeSched S{TAB[8], D / 256, opq(G), opq((int)blockIdx.x), MOE_FP8 ? DFE : 2 * DFE, (const char*)(bWS + W_MOE2 + (size_t)fj * 8 * MOE2_STRIDE), MOE2_STRIDE, nullptr, TAB};
                pg8::EpiBf16 E{bY, D, MOE_FP8 ? 1.0f / (F8_HID * F8_W2) : 1.0f};
                pg8::gemm_phase<pg8::EpiBf16, pg8::MoeSched, MOE_FP8 != 0>(lds, (const char*)bSCR, S, E);
            }
            if (BOTH(pb + 7)) SEAM();
        }
    }
    if (IN(N_PHASES - 1)) {
        NormArgs na{}; na.xin = (const float*)bX; na.xout = (float*)bX; na.combine = true; na.cscale = (ABLATE == 7) ? 0.f : 1.f; na.Y = bY; na.tinfo = bTINFO; na.g2p = bMOD + (size_t)3 * NB * MOD_W + 5 * D; na.cntp = bCTL + CW_CNT + 64 * 1;
        na.gamma = karg_in(I_NORMF); na.out = args.out;
        norm_phase<4>(lds, na, G);
        if (DUP_NORM == 4) { __syncthreads(); norm_phase<4>(lds, na, G); }
    }
#undef IN
#undef BOTH
#undef SEAM
#undef bWS
#undef bCTL
#undef bMOD
#undef bX
#undef bH
#undef bY
#undef bTOK
#undef bTINFO
#undef bLF
#undef bSCR
#undef bA2
#undef modL
#undef modP
#undef xin_first
}


#ifdef DBG_CHECK
constexpr int CW_DBG = 20000;
__global__ void dbg_check_router(const float* X, const float* mod  , const float* router, const u32x4* tinfo, const int* tok, unsigned* flags) {
    const int row = blockIdx.x * blockDim.x + threadIdx.x; if (row >= NTOK) return;
    const int b = row / SEQ; const float* x = X + (size_t)row * D; const float* sc = mod + (size_t)b * MOD_W + 4 * D; const float* sh = mod + (size_t)b * MOD_W + 3 * D;
    float ss = 0.f; for (int k = 0; k < D; ++k) ss += x[k] * x[k];
    const float rstd = 1.0f / sqrtf(ss / D + EPS);
    float lg[8]; for (int n = 0; n < 8; ++n) lg[n] = 0.f;
    for (int k = 0; k < D; ++k) { const float h = x[k] * rstd * (1.0f + sc[k]) + sh[k]; for (int n = 0; n < 8; ++n) lg[n] += h * router[k * 8 + n]; }
    int e0 = 0; for (int n = 1; n < 8; ++n) if (lg[n] > lg[e0]) e0 = n;
    int e1 = -1; for (int n = 0; n < 8; ++n) if (n != e0 && (e1 < 0 || lg[n] > lg[e1])) e1 = n;
    float l2 = -1e30f; for (int n = 0; n < 8; ++n) if (n != e0 && n != e1 && lg[n] > l2) l2 = lg[n];
    const float g0 = 1.0f / (1.0f + expf(lg[e1] - lg[e0]));
    const u32x4 ti = tinfo[row]; const int k0 = ti.x >> 15, k1 = ti.y >> 15;
    const bool safe = (lg[e0] - lg[e1] > 1e-3f) && (lg[e1] - l2 > 1e-3f);
    if (safe && (k0 != e0 || k1 != e1)) atomicAdd(flags + 0, 1u);
    if (safe && fabsf(__uint_as_float(ti.z) - g0) > 2e-3f) atomicAdd(flags + 1, 1u);
    if (safe && fabsf(__uint_as_float(ti.w) - (1.0f - g0)) > 2e-3f) atomicAdd(flags + 1, 1u);
    if (tok[ti.x] != row || tok[ti.y] != row) atomicAdd(flags + 2, 1u);
}
#ifndef DBG_FLAG
#define DBG_FLAG 0
#endif
__global__ void dbg_report(const unsigned* flags, float* out) {
    if (threadIdx.x == 0 && blockIdx.x == 0) out[0] = 50.0f + (float)flags[DBG_FLAG];
}
#endif
extern "C" void kernel_launch(void* const* d_in, const int* in_sizes, int n_in, void* d_out, int out_size, void* d_ws, size_t ws_size, hipStream_t stream) {
    static int grid = 0;
    if (grid == 0) {
        if (n_in != 28 || in_sizes[0] != NTOK * D || out_size != NTOK * D || ws_size < WS_END) {
            fprintf(stderr, "kernel_launch: unexpected shapes (n_in %d, in0 %d, out %d, ws %zu, need %zu); nothing launched\n", n_in, n_in > 0 ? in_sizes[0] : -1, out_size, ws_size, (size_t)WS_END); grid = -1; return; }
        int dev = 0, cus = 0, per_cu = 0;
        if (hipGetDevice(&dev) != hipSuccess || hipDeviceGetAttribute(&cus, hipDeviceAttributeMultiprocessorCount, dev) != hipSuccess) { grid = -1; return; }
        if (hipFuncSetAttribute((const void*)mk_fwd, hipFuncAttributeMaxDynamicSharedMemorySize, LDS_BYTES) != hipSuccess) { fprintf(stderr, "kernel_launch: hipFuncSetAttribute failed\n"); grid = -1; return; }
        if (hipOccupancyMaxActiveBlocksPerMultiprocessor(&per_cu, (const void*)mk_fwd, NTHR, LDS_BYTES) != hipSuccess || per_cu < 1)
            fprintf(stderr, "kernel_launch: note: occupancy query reports %d workgroups per CU\n", per_cu);
        (void)hipGetLastError();
        grid = cus;
    }
    if (grid < 0) return;
    if (hipMemsetAsync((char*)d_ws + WS_CTL, 0, CTL_ZERO_BYTES, stream) != hipSuccess) return;
    Args a{};
    for (int i = 0; i < 28; ++i) a.in[i] = (const float*)d_in[i];
    a.out = (float*)d_out; a.ws = (unsigned char*)d_ws;
#if MK_N_LAUNCHES == 1
    a.ph_lo = 0; a.ph_hi = N_PHASES;
    hipLaunchKernelGGL(mk_fwd, dim3(grid), dim3(NTHR), LDS_BYTES, stream, a);
#else
    for (int p = 0; p < N_PHASES; ++p) {
        const int L = (p - 1) / PH_PER_LAYER, slot = (p - 1) % PH_PER_LAYER;
        if (p >= 1 && p < N_PHASES - 1 && slot == 3 && (L % 3) != 0) continue;
        a.ph_lo = p; a.ph_hi = p + 1;
        hipLaunchKernelGGL(mk_fwd, dim3(grid), dim3(NTHR), LDS_BYTES, stream, a);
#ifdef DBG_CHECK
        if (p >= 1 && p < N_PHASES - 1 && slot == 5 && (L & 1)) {
            unsigned char* ws = (unsigned char*)d_ws;
            hipLaunchKernelGGL(dbg_check_router, dim3(NTOK / 256), dim3(256), 0, stream, (const float*)(ws + WS_X), (const float*)(ws + WS_MOD) + (size_t)L * NB * MOD_W, a.in[I_MOE_R] + (size_t)(L >> 1) * D * NE,
                               (const u32x4*)(ws + WS_TINFO), (const int*)(ws + WS_TOK), (unsigned*)(ws + WS_CTL) + CW_DBG + 4 * (L >> 1));
        }
#endif
    }
#ifdef DBG_CHECK
    hipLaunchKernelGGL(dbg_report, dim3(1), dim3(64), 0, stream, (const unsigned*)((unsigned char*)d_ws + WS_CTL) + CW_DBG, (float*)d_out);
#endif
#endif
}
```

```cpp
#include <hip/hip_runtime.h>
#include <cstdio>
#include <cstdint>
#include <utility>

#ifndef MK_N_LAUNCHES
#define MK_N_LAUNCHES 1
#endif
#ifndef DUP_PH
#define DUP_PH -1
#endif
#define NREP(p) ((DUP_PH == (p)) ? 2 : 1)
#ifndef DUP_NORM
#define DUP_NORM 0
#endif
#ifndef MOE_FP8
#define MOE_FP8 1
#endif
#ifndef FFN_FP8
#ifndef FOXG_FP8
#define FOXG_FP8 1
#endif
#ifndef FOX_BF_COLS
#define FOX_BF_COLS 2048
#endif
#ifndef CONV_FP8
#define CONV_FP8 1
#endif
#define FFN_FP8 1
#endif
#ifndef ABLATE
#define ABLATE -1
#endif

#define LAS __attribute__((address_space(3)))
#define GAS __attribute__((address_space(1)))
typedef unsigned short bf16_t;
typedef short bf16x8 __attribute__((ext_vector_type(8)));
typedef float f32x4 __attribute__((ext_vector_type(4)));
typedef float f32x2 __attribute__((ext_vector_type(2)));
typedef unsigned u32x4 __attribute__((ext_vector_type(4)));
typedef unsigned u32x2 __attribute__((ext_vector_type(2)));
typedef __bf16 bf16x2_t __attribute__((ext_vector_type(2)));

constexpr int NB = 8, SEQ = 4096, D = 1024, NTOK = NB * SEQ, DEPTH = 4;
constexpr int GLA_IN = 3088, FOX_IN = 4112, DFF = 2816, DFE = 3584, NE = 8, MOD_W = 6 * D;
constexpr int CONVW = 31;
constexpr float EPS = 1e-6f;
constexpr float LOG2E = 1.4426950408889634f;
constexpr float QSCALE = 0.125f * LOG2E;
constexpr int NTHR = 512, NWAVES = 8;
constexpr int MOE_CAP = NTOK;
constexpr int MOE_MAXT = NTOK * 2 / 256 + NE;

constexpr size_t MiB = 1u << 20;
constexpr size_t WS_CTL = 0, CTL_ZERO_BYTES = 128 * 1024;
constexpr size_t WS_MOD = 1 * MiB;
constexpr size_t WS_W = 2 * MiB;
constexpr size_t SZ_GLA_IN = (size_t)3072 * D * 2, SZ_SQ = (size_t)D * D * 2, SZ_CONV_IN = (size_t)2048 * D * 2, SZ_FOX_IN = (size_t)4096 * D * 2;
constexpr size_t SZ_FFN13 = (size_t)2 * DFF * D * 2, SZ_FFN2 = (size_t)D * DFF * 2, SZ_MOE13 = (size_t)2 * DFE * D * 2, SZ_MOE2 = (size_t)D * DFE * 2;
constexpr size_t W_GLA_IN = WS_W, W_GLA_OUT = W_GLA_IN + 2 * SZ_GLA_IN, W_CONV_IN = W_GLA_OUT + 2 * SZ_SQ, W_CONV_OUT = W_CONV_IN + SZ_CONV_IN;
constexpr size_t W_FOX_IN = W_CONV_OUT + SZ_SQ, W_FOX_OUT = W_FOX_IN + SZ_FOX_IN, W_FFN13 = W_FOX_OUT + SZ_SQ, W_FFN2 = W_FFN13 + 2 * SZ_FFN13;
constexpr size_t W_MOE13 = W_FFN2 + 2 * SZ_FFN2, W_MOE2 = W_MOE13 + 16 * SZ_MOE13, W_END = W_MOE2 + 16 * SZ_MOE2;
constexpr size_t MOE13_STRIDE = MOE_FP8 ? SZ_MOE13 / 2 : SZ_MOE13, MOE2_STRIDE = MOE_FP8 ? SZ_MOE2 / 2 : SZ_MOE2;
constexpr size_t WS_X = (W_END + MiB - 1) / MiB * MiB;
constexpr size_t WS_H = WS_X + (size_t)NTOK * D * 4;
constexpr size_t WS_Y = WS_H + (size_t)NTOK * D * 2;
constexpr size_t WS_TOK = WS_Y + (size_t)MOE_MAXT * 256 * D * 2;
constexpr size_t WS_TINFO = WS_TOK + (size_t)NE * MOE_CAP * 4;
constexpr size_t WS_LF = WS_TINFO + (size_t)NTOK * 16;
constexpr size_t WS_CUMG = WS_LF + (size_t)NTOK * 16 * 4;
constexpr size_t WS_SCR = WS_CUMG + (size_t)NB * 16 * SEQ * 4;
constexpr size_t SCR_BYTES = (size_t)MOE_MAXT * 256 * DFE * 2;
constexpr size_t WS_H8 = WS_SCR + SCR_BYTES;
constexpr size_t WS_END = WS_H8 + (size_t)NTOK * D;
constexpr size_t S_QG = 0, S_KD = S_QG + (size_t)NTOK * 512 * 2, S_V = S_KD + (size_t)NTOK * 512 * 2, S_R = S_V + (size_t)NTOK * D * 2;
constexpr size_t S_DK = S_R + (size_t)NTOK * D * 2, S_ET = S_DK + (size_t)NTOK * 512 * 4, S_DR = S_ET + (size_t)512 * 512 * 4, S_O = S_DR + (size_t)512 * 8 * 512 * 4, S_A2 = S_O + (size_t)NTOK * D * 2;
static_assert(S_A2 + (size_t)NTOK * D * 2 <= SCR_BYTES, "GLA scratch");
constexpr size_t S_FQ = 0, S_FK = (size_t)NTOK * D * 2, S_FV = 2 * S_FK, S_FG = 3 * S_FK;
static_assert(4 * S_FK <= S_A2, "fox scratch");
constexpr int CW_BAR = 4096;
constexpr int CW_ATTQ = 16384 + 512;
constexpr int CW_CNT = 16384;

__device__ __forceinline__ int opaque_tid() { int t = threadIdx.x; asm volatile("" : "+v"(t)); return t; }
#define FENCE() do { asm volatile("" ::: "memory"); __builtin_amdgcn_sched_barrier(0); } while (0)
__device__ __forceinline__ unsigned pk2(float lo, float hi) { f32x2 v = {lo, hi}; bf16x2_t b = __builtin_convertvector(v, bf16x2_t); return __builtin_bit_cast(unsigned, b); }
constexpr float F8_W13 = 32.0f, F8_HID = 4.0f, F8_W2 = 64.0f;
__device__ __forceinline__ float f8clamp(float x) { return __builtin_amdgcn_fmed3f(x, -448.0f, 448.0f); }
__device__ __forceinline__ unsigned pk4_fp8(float a, float b, float c, float d) { int w = __builtin_amdgcn_cvt_pk_fp8_f32(f8clamp(a), f8clamp(b), 0, false); w = __builtin_amdgcn_cvt_pk_fp8_f32(f8clamp(c), f8clamp(d), w, true); return (unsigned)w; }
__device__ __forceinline__ float bf_lo(unsigned w) { return __uint_as_float(w << 16); }
__device__ __forceinline__ float bf_hi(unsigned w) { return __uint_as_float(w & 0xffff0000u); }
__device__ __forceinline__ float wave_sum(float v) {
    asm volatile("s_nop 1\n\t"
                 "v_add_f32_dpp %0, %0, %0 quad_perm:[1,0,3,2] row_mask:0xf bank_mask:0xf\n\ts_nop 1\n\t"
                 "v_add_f32_dpp %0, %0, %0 quad_perm:[2,3,0,1] row_mask:0xf bank_mask:0xf\n\ts_nop 1\n\t"
                 "v_add_f32_dpp %0, %0, %0 row_half_mirror row_mask:0xf bank_mask:0xf\n\ts_nop 1\n\t"
                 "v_add_f32_dpp %0, %0, %0 row_mirror row_mask:0xf bank_mask:0xf\n\ts_nop 1\n\t"
                 "v_add_f32_dpp %0, %0, %0 row_bcast:15 row_mask:0xa bank_mask:0xf\n\ts_nop 1\n\t"
                 "v_add_f32_dpp %0, %0, %0 row_bcast:31 row_mask:0xc bank_mask:0xf\n\ts_nop 1" : "+v"(v));
    return __uint_as_float((unsigned)__builtin_amdgcn_readlane((int)__float_as_uint(v), 63));
}
template <int N> __device__ __forceinline__ void xreduce(float (&v)[N], int lane) {
    constexpr int LG = (N == 64) ? 6 : (N == 32) ? 5 : (N == 16) ? 4 : (N == 8) ? 3 : 0;
    static_assert(LG > 0, "xreduce N");
#pragma unroll
    for (int s = 0; s < LG; ++s) {
        const int off = 32 >> s, n = N >> (s + 1);
        const bool hi = (lane & off) != 0;
#pragma unroll
        for (int i = 0; i < n; ++i) { float lo_v = v[i], hi_v = v[i + n]; asm volatile("" : "+v"(lo_v), "+v"(hi_v));
            const float keep = hi ? hi_v : lo_v; const float send = hi ? lo_v : hi_v; v[i] = keep + __shfl_xor(send, off); }
    }
#pragma unroll
    for (int off = (32 >> LG); off >= 1; off >>= 1) v[0] += __shfl_xor(v[0], off);
}
__device__ __forceinline__ float fast_sigmoid(float x) { return __builtin_amdgcn_rcpf(1.0f + __expf(-x)); }
__device__ __forceinline__ float fast_silu(float x) { return x * fast_sigmoid(x); }
__device__ __forceinline__ float log_sigmoid(float z) { return fminf(z, 0.f) - 0.6931471805599453f * __builtin_amdgcn_logf(1.0f + __builtin_amdgcn_exp2f(-LOG2E * fabsf(z))); }

#define XB_TMO      128
#define XB_XCNT(j)  (256  + 64 * (j))
#define XB_XSUB(j)  (1280 + 64 * (j))
#define XB_XGEN(j)  (2304 + 64 * (j))
#define XB_TOP      3328
#define XB_TOPGEN   3392
#define XCD_BAR_WORDS 3456
#define XB_SPIN_CAP (1u << 22)
__device__ __forceinline__ unsigned xb_ld(unsigned* p)              { return __hip_atomic_load(p, __ATOMIC_RELAXED, __HIP_MEMORY_SCOPE_AGENT); }
__device__ __forceinline__ unsigned xb_add(unsigned* p, unsigned v) { return __hip_atomic_fetch_add(p, v, __ATOMIC_RELAXED, __HIP_MEMORY_SCOPE_AGENT); }
__device__ __forceinline__ unsigned xb_xcc_id() { return (unsigned)__builtin_amdgcn_s_getreg((3 << 11) | 20) & 0xFu; }
#define XB_SPIN(cond, bar) do { unsigned _sp = 0; while (cond) { __builtin_amdgcn_s_sleep(1); \
    if ((++_sp & 255u) == 0u) { if (xb_ld(&(bar)[XB_TMO])) break; if (_sp > XB_SPIN_CAP) { atomicAdd(&(bar)[XB_TMO], 1u); break; } } } } while (0)
struct XcdBarrier { unsigned* bar; unsigned x; volatile LAS unsigned* st; };
__device__ __forceinline__ XcdBarrier xcd_barrier_post(unsigned* bar, volatile LAS unsigned* st) {
    XcdBarrier b; b.bar = bar; b.x = xb_xcc_id(); b.st = st;
    if (threadIdx.x == 0) (void)xb_add(&bar[XB_XCNT(b.x)], 1u);
    return b;
}
__device__ __forceinline__ void xcd_barrier_complete(unsigned* bar, unsigned x, unsigned& nloc, unsigned& nx) {
    const unsigned G = gridDim.x * gridDim.y * gridDim.z;
    unsigned sum, cnt, mine, sp = 0u;
    for (;;) {
        sum = 0u; cnt = 0u; mine = 0u;
#pragma unroll
        for (unsigned j = 0; j < 16; ++j) { const unsigned c = xb_ld(&bar[XB_XCNT(j)]); sum += c; cnt += (c > 0u) ? 1u : 0u; mine = (j == x) ? c : mine; }
        if (sum == G) break;
        __builtin_amdgcn_s_sleep(1);
        if ((++sp & 255u) == 0u) { if (xb_ld(&bar[XB_TMO])) break; if (sp > XB_SPIN_CAP) { atomicAdd(&bar[XB_TMO], 1u); break; } }
    }
    nloc = mine > 0u ? mine : 1u; nx = cnt > 0u ? cnt : 1u;
}
__device__ __forceinline__ void xcd_barrier(const XcdBarrier& b) {
    asm volatile("s_waitcnt vmcnt(0)" ::: "memory");
    __syncthreads();
    if (threadIdx.x == 0) {
        unsigned* bar = b.bar; unsigned bx = b.x;
        asm volatile("" : "+s"(bar), "+s"(bx));
        __builtin_amdgcn_s_waitcnt(0);
        unsigned nloc = b.st[0], nx = b.st[1];
        if (nloc == 0u) { xcd_barrier_complete(bar, bx, nloc, nx); b.st[0] = nloc; b.st[1] = nx; }
        const unsigned old = xb_add(&bar[XB_XSUB(bx)], 1u);
        const unsigned gen = old / nloc;
        if (old + 1u == (gen + 1u) * nloc) {
            __builtin_amdgcn_fence(__ATOMIC_RELEASE, "agent");
            asm volatile("s_waitcnt vmcnt(0)" ::: "memory");
            const unsigned og = xb_add(&bar[XB_TOP], 1u);
            const unsigned tg = og / nx;
            if (og + 1u == (tg + 1u) * nx) xb_add(&bar[XB_TOPGEN], 1u);
            else XB_SPIN(xb_ld(&bar[XB_TOPGEN]) == tg, bar);
            __builtin_amdgcn_fence(__ATOMIC_ACQUIRE, "agent");
            xb_add(&bar[XB_XGEN(bx)], 1u);
            asm volatile("s_waitcnt vmcnt(0)" ::: "memory");
        } else {
            XB_SPIN(xb_ld(&bar[XB_XGEN(bx)]) == gen, bar);
            __builtin_amdgcn_fence(__ATOMIC_ACQUIRE, "agent");
            asm volatile("s_waitcnt vmcnt(0)" ::: "memory");
        }
    }
    __syncthreads();
}

namespace pg8 {
constexpr int BM = 256, BK = 64, HALF = 128, HTB = HALF * BK * 2, STAGE_BYTES = 8 * HTB, NXCD = 8, WGM = 8;
__host__ __device__ __forceinline__ int lds_byte(int r, int c) { const int st = (r >> 4) * 2 + (c >> 5), rr = r & 15, cc = c & 31, ob = rr * 64 + cc * 2; return st * 1024 + (ob ^ (((ob >> 9) & 1) << 5)); }
__host__ __device__ __forceinline__ void stage_rc(int b, int& R, int& C) { const int st = b / 1024, sb = b % 1024, swz = sb ^ (((sb >> 9) & 1) << 5); R = (st >> 1) * 16 + swz / 64; C = (st & 1) * 32 + (swz % 64) / 2; }
__host__ __device__ __forceinline__ int perm32(int rho) { const int n = rho >> 4, i = rho & 15; return 8 * (i >> 2) + 4 * n + (i & 3); }
struct Unit { int pm, pn, e; };

__device__ __forceinline__ bool order_next(int i, int G, int c, int nM, int nN, int& pm, int& pn) {
    const int nwg = nM * nN; const long L = (long)i * G + c; if (L >= nwg) return false;
    int wgid = (int)L; { const int q = nwg / NXCD, r = nwg % NXCD, xcd = wgid % NXCD, off = wgid / NXCD; wgid = (xcd < r ? xcd * (q + 1) : r * (q + 1) + (xcd - r) * q) + off; }
    const int nig = WGM * nN, gid = wgid / nig, fm = gid * WGM, gsz = (nM - fm) < WGM ? (nM - fm) : WGM;
    pm = fm + ((wgid % nig) % gsz); pn = (wgid % nig) / gsz; return true;
}
struct DenseSched {
    int nM, nN, G, c, KB; const char* Bt;
    __device__ __forceinline__ bool next(int i, Unit& u) const { u.e = 0; return order_next(i, G, c, nM, nN, u.pm, u.pn); }
    __device__ __forceinline__ int row(const Unit& u, int lr) const { return u.pm * BM + lr; }
    __device__ __forceinline__ const char* b_tile(const Unit& u) const { return Bt + (size_t)u.pn * BM * KB; }
};
struct MoeSched {
    int nM, nN, G, c, KB; const char* Bt; size_t estride; const int* tok; const LAS int* tab;
    __device__ __forceinline__ bool next(int i, Unit& u) const {
        if (!order_next(i, G, c, nM, nN, u.pm, u.pn)) return false;
        int e = 0;
#pragma unroll
        for (int j = 1; j < NE; ++j) e = (u.pm >= tab[j]) ? j : e;
        u.e = e; return true;
    }
    __device__ __forceinline__ int row(const Unit& u, int lr) const {
        if (tok == nullptr) return u.pm * BM + lr;
        const int pos = (u.pm - tab[u.e]) * BM + lr;
        return pos < tab[16 + u.e] ? tok[u.e * MOE_CAP + pos] : 0;
    }
    __device__ __forceinline__ const char* b_tile(const Unit& u) const { return Bt + (size_t)u.e * estride + (size_t)u.pn * BM * KB; }
};

typedef int v8i32 __attribute__((ext_vector_type(8)));
__device__ __forceinline__ const char* uni_ptr(const char* p) { const unsigned long long v = (unsigned long long)p; const unsigned lo = (unsigned)__builtin_amdgcn_readfirstlane((int)(unsigned)v), hi = (unsigned)__builtin_amdgcn_readfirstlane((int)(unsigned)(v >> 32)); return (const char*)(((unsigned long long)hi << 32) | lo); }
__device__ __forceinline__ v8i32 cat8(bf16x8 lo, bf16x8 hi) { const u32x4 a = __builtin_bit_cast(u32x4, lo), b = __builtin_bit_cast(u32x4, hi); return (v8i32){(int)a.x, (int)a.y, (int)a.z, (int)a.w, (int)b.x, (int)b.y, (int)b.z, (int)b.w}; }
template <class Epi, class Sched, bool FP8 = false>
__device__ __forceinline__ void gemm_phase(LAS unsigned char* lds, const char* Abase, const Sched& S, const Epi& E) {
    const int tid = opaque_tid(), wid = __builtin_amdgcn_readfirstlane(tid >> 6), lane = tid & 63, wr = wid >> 2, wc = wid & 3, fr = lane & 15, fq = lane >> 4;
    const int KB = S.KB, nt = KB / (BK * 2);
    int Rp[2], Cp[2]; unsigned voffB[2];
#pragma unroll
    for (int i = 0; i < 2; ++i) { int R, C; stage_rc(tid * 16 + i * 8192, R, C); Rp[i] = R; Cp[i] = C; const int Rb = Epi::PERM ? ((R & ~31) + perm32(R & 31)) : R; voffB[i] = (unsigned)(Rb * KB + C * 2); }
    const size_t kstep = (size_t)(BK * 2);
    const size_t hstep = (size_t)HALF * KB;
    const unsigned ldsw = (unsigned)wid * 1024u;
    const unsigned lds0 = (unsigned)__builtin_amdgcn_readfirstlane((int)((unsigned)(size_t)lds + ldsw));
    const int aoff = lds_byte(wr * 64 + fr, fq * 8), boff = lds_byte(wc * 32 + fr, fq * 8);
#define PG8_SA(b, h) (((b) * 2 + (h)) * HTB)
#define PG8_SB(b, h) ((4 + (b) * 2 + (h)) * HTB)
#define PG8_GLDS(sbase, voff32, ldsdst) do { unsigned _keep; asm volatile("s_mov_b32 %0, m0\n\ts_mov_b32 m0, %3\n\ts_nop 0\n\tglobal_load_lds_dwordx4 %1, %2\n\ts_mov_b32 m0, %0" \
        : "=&s"(_keep) : "v"(voff32), "s"(sbase), "s"(ldsdst) : "memory"); } while (0)
#define PG8_STAGE(bufoff, gbase, voff) do { const char* _sb = uni_ptr((const char*)(gbase)); _Pragma("unroll") for (int _i = 0; _i < 2; ++_i) \
        PG8_GLDS(_sb, (voff)[_i], lds0 + (unsigned)((bufoff) + _i * 8192)); } while (0)
#define PG8_STAGEA(bufoff, ra2, koff) do { const char* _sb = uni_ptr(Abase + (size_t)(koff)); _Pragma("unroll") for (int _i = 0; _i < 2; ++_i) \
        PG8_GLDS(_sb, (ra2)[_i], lds0 + (unsigned)((bufoff) + _i * 8192)); } while (0)
#define PG8_LDA(dst, b, h) do { _Pragma("unroll") for (int m = 0; m < 4; ++m) _Pragma("unroll") for (int k = 0; k < 2; ++k) dst[m][k] = *(const LAS bf16x8*)(lds + PG8_SA(b, h) + aoff + m * 2048 + k * 1024); } while (0)
#define PG8_LDB(dst, b, h) do { _Pragma("unroll") for (int n = 0; n < 2; ++n) _Pragma("unroll") for (int k = 0; k < 2; ++k) dst[n][k] = *(const LAS bf16x8*)(lds + PG8_SB(b, h) + boff + n * 2048 + k * 1024); } while (0)
#define PG8_MMA(ai, bj, At, Bt) do { __builtin_amdgcn_s_setprio(1); _Pragma("unroll") for (int m = 0; m < 4; ++m) _Pragma("unroll") for (int n = 0; n < 2; ++n) { \
        if constexpr (FP8) { const v8i32 _b8 = cat8(Bt[n][0], Bt[n][1]), _a8 = cat8(At[m][0], At[m][1]); \
            asm volatile("v_mfma_scale_f32_16x16x128_f8f6f4 %0, %1, %2, %0, %3, %3 op_sel_hi:[0,0,0]" : "+v"(acc[ai][bj][m][n]) : "v"(_b8), "v"(_a8), "v"(f8one)); } \
        else { _Pragma("unroll") for (int k = 0; k < 2; ++k) acc[ai][bj][m][n] = __builtin_amdgcn_mfma_f32_16x16x32_bf16(Bt[n][k], At[m][k], acc[ai][bj][m][n], 0, 0, 0); } } \
        __builtin_amdgcn_s_setprio(0); } while (0)
#define PG8_WAIT_V(n) asm volatile("s_waitcnt vmcnt(" #n ")" ::: "memory")
#define PG8_WAIT_L(n) asm volatile("s_waitcnt lgkmcnt(" #n ")" ::: "memory")
#define PG8_BAR __builtin_amdgcn_s_barrier()
#define PG8_SCHED __builtin_amdgcn_sched_barrier(0)
#define PG8_ROWS(u, ra) do { _Pragma("unroll") for (int _h = 0; _h < 2; ++_h) _Pragma("unroll") for (int _i = 0; _i < 2; ++_i) \
        ra[_h][_i] = (unsigned)(S.row(u, _h * HALF + Rp[_i]) * KB + Cp[_i] * 2); } while (0)
    unsigned f8one = 0x7F7F7F7Fu; asm volatile("" : "+v"(f8one));
    Unit cur, nxt; int ui = 0;
    if (!S.next(0, cur)) return;
    bool has_next = S.next(1, nxt);
    unsigned ra_cur[2][2], ra_nxt[2][2];
    PG8_ROWS(cur, ra_cur);
    if (has_next) { PG8_ROWS(nxt, ra_nxt); } else {
#pragma unroll
        for (int h = 0; h < 2; ++h) { ra_nxt[h][0] = ra_cur[h][0]; ra_nxt[h][1] = ra_cur[h][1]; } }
    f32x4 acc[2][2][4][2];
#pragma unroll
    for (int a = 0; a < 2; ++a)
#pragma unroll
        for (int b = 0; b < 2; ++b)
#pragma unroll
            for (int m = 0; m < 4; ++m)
#pragma unroll
                for (int n = 0; n < 2; ++n) acc[a][b][m][n] = (f32x4){0.f, 0.f, 0.f, 0.f};
    bf16x8 At[4][2], B0[2][2], B1[2][2];
    const char* cB = S.b_tile(cur);
    PG8_STAGE(PG8_SB(0, 0), cB, voffB); PG8_STAGE(PG8_SB(0, 1), cB + hstep, voffB); PG8_STAGEA(PG8_SA(0, 0), ra_cur[0], 0); PG8_STAGEA(PG8_SA(0, 1), ra_cur[1], 0);
    if (wr == 1) PG8_BAR;
    PG8_WAIT_V(2); PG8_BAR;
    PG8_STAGE(PG8_SB(1, 0), cB + kstep, voffB); PG8_STAGEA(PG8_SA(1, 0), ra_cur[0], kstep); PG8_STAGE(PG8_SB(1, 1), cB + hstep + kstep, voffB);
    PG8_WAIT_V(6); PG8_BAR;
    for (;;) {
        const char* nB = has_next ? S.b_tile(nxt) : cB;
        for (int t = 0; t < nt; t += 2) {
            const bool last = (t == nt - 2);
            const size_t k1 = (size_t)(t + 1) * kstep;
            const size_t k2 = last ? (size_t)0 : (size_t)(t + 2) * kstep; const char* b2 = last ? nB : cB + (size_t)(t + 2) * kstep;
            const size_t k3 = k2 + kstep; const char* b3 = b2 + kstep;
            unsigned r2[2][2];
#pragma unroll
            for (int h = 0; h < 2; ++h) { r2[h][0] = last ? ra_nxt[h][0] : ra_cur[h][0]; r2[h][1] = last ? ra_nxt[h][1] : ra_cur[h][1]; }
            PG8_LDB(B0, 0, 0); PG8_LDB(B1, 0, 1); PG8_SCHED; PG8_LDA(At, 0, 0); PG8_STAGEA(PG8_SA(1, 1), ra_cur[1], k1);
            PG8_WAIT_V(8); PG8_WAIT_L(0); PG8_BAR; PG8_MMA(0, 0, At, B0); PG8_MMA(0, 1, At, B1); PG8_BAR; PG8_SCHED;
            PG8_LDA(At, 0, 1); PG8_STAGE(PG8_SB(0, 0), b2, voffB); PG8_STAGE(PG8_SB(0, 1), b2 + hstep, voffB); PG8_STAGEA(PG8_SA(0, 0), r2[0], k2);
            PG8_WAIT_V(8); PG8_WAIT_L(0); PG8_BAR; PG8_MMA(1, 0, At, B0); PG8_MMA(1, 1, At, B1); PG8_BAR; PG8_SCHED;
            PG8_LDB(B0, 1, 0); PG8_LDB(B1, 1, 1); PG8_SCHED; PG8_LDA(At, 1, 0); PG8_STAGEA(PG8_SA(0, 1), r2[1], k2);
            PG8_WAIT_V(8); PG8_WAIT_L(0); PG8_BAR; PG8_MMA(0, 0, At, B0); PG8_MMA(0, 1, At, B1); PG8_BAR; PG8_SCHED;
            PG8_LDA(At, 1, 1); PG8_STAGE(PG8_SB(1, 0), b3, voffB); PG8_STAGE(PG8_SB(1, 1), b3 + hstep, voffB); PG8_STAGEA(PG8_SA(1, 0), r2[0], k3);
            PG8_WAIT_V(8); PG8_WAIT_L(0); PG8_BAR; PG8_MMA(1, 0, At, B0); PG8_MMA(1, 1, At, B1); PG8_BAR; PG8_SCHED;
        }
        if (wr == 0) PG8_BAR;
        if constexpr (FP8) asm volatile("s_nop 15\n\ts_nop 7" ::: "memory");
        Unit nx2; const bool hn2 = has_next && S.next(ui + 2, nx2); int rr2[2][2];
        if (hn2) {
#pragma unroll
            for (int h = 0; h < 2; ++h) { rr2[h][0] = S.row(nx2, h * HALF + Rp[0]); rr2[h][1] = S.row(nx2, h * HALF + Rp[1]); } }
        asm volatile("" ::: "memory");
        E(acc, cur, wr, wc, fr, fq);
        if (!has_next) break;
#pragma unroll
        for (int a = 0; a < 2; ++a)
#pragma unroll
            for (int b = 0; b < 2; ++b)
#pragma unroll
                for (int m = 0; m < 4; ++m)
#pragma unroll
                    for (int n = 0; n < 2; ++n) acc[a][b][m][n] = (f32x4){0.f, 0.f, 0.f, 0.f};
        cur = nxt; cB = nB; ++ui;
#pragma unroll
        for (int h = 0; h < 2; ++h) { ra_cur[h][0] = ra_nxt[h][0]; ra_cur[h][1] = ra_nxt[h][1]; }
        has_next = hn2; nxt = nx2;
        if (has_next) {
#pragma unroll
            for (int h = 0; h < 2; ++h) { ra_nxt[h][0] = (unsigned)(rr2[h][0] * KB + Cp[0] * 2); ra_nxt[h][1] = (unsigned)(rr2[h][1] * KB + Cp[1] * 2); } }
        if (wr == 1) PG8_BAR;
    }
    PG8_WAIT_V(0);
    PG8_BAR;
#undef PG8_SA
#undef PG8_SB
#undef PG8_STAGE
#undef PG8_STAGEA
#undef PG8_LDA
#undef PG8_LDB
#undef PG8_MMA
#undef PG8_WAIT_V
#undef PG8_WAIT_L
#undef PG8_BAR
#undef PG8_SCHED
#undef PG8_ROWS
}

typedef const f32x4 (&AccRef)[2][2][4][2];
struct EpiOut {
    static constexpr bool PERM = true;
    const float* xin32; const bf16_t* xin; bf16_t* xout; const float* gate; const float* bias; float gscale;
    __device__ __forceinline__ void operator()(AccRef acc, const Unit& u, int wr, int wc, int fr, int fq) const {
        const int row0 = u.pm * BM + wr * 64 + fr, col0 = u.pn * BM + wc * 32 + 8 * fq, b = (u.pm * BM) / SEQ;
        f32x4 gv[2][2], bv[2][2];
#pragma unroll
        for (int bj = 0; bj < 2; ++bj)
#pragma unroll
            for (int n = 0; n < 2; ++n) { gv[bj][n] = *(const f32x4*)(gate + (size_t)b * MOD_W + col0 + bj * HALF + n * 4) * gscale;
                bv[bj][n] = bias ? *(const f32x4*)(bias + col0 + bj * HALF + n * 4) : (f32x4){0.f, 0.f, 0.f, 0.f}; }
        if (xin32 != nullptr) {
#pragma unroll
            for (int ai = 0; ai < 2; ++ai)
#pragma unroll
                for (int m = 0; m < 4; ++m) { const size_t off = (size_t)(row0 + ai * HALF + m * 16) * D + col0;
#pragma unroll
                    for (int bj = 0; bj < 2; ++bj) { const f32x4 x0 = *(const f32x4*)(xin32 + off + bj * HALF), x1 = *(const f32x4*)(xin32 + off + bj * HALF + 4);
                        const f32x4 v0 = x0 + gv[bj][0] * (acc[ai][bj][m][0] + bv[bj][0]), v1 = x1 + gv[bj][1] * (acc[ai][bj][m][1] + bv[bj][1]);
                        u32x4 w; w.x = pk2(v0[0], v0[1]); w.y = pk2(v0[2], v0[3]); w.z = pk2(v1[0], v1[1]); w.w = pk2(v1[2], v1[3]);
                        *(u32x4*)(xout + off + bj * HALF) = w; }
                    asm volatile("" ::: "memory"); }
        } else {
#pragma unroll
            for (int ai = 0; ai < 2; ++ai)
#pragma unroll
                for (int m = 0; m < 4; ++m) { const size_t off = (size_t)(row0 + ai * HALF + m * 16) * D + col0;
#pragma unroll
                    for (int bj = 0; bj < 2; ++bj) { const u32x4 xw = *(const u32x4*)(xin + off + bj * HALF);
                        const f32x4 x0 = {bf_lo(xw.x), bf_hi(xw.x), bf_lo(xw.y), bf_hi(xw.y)}, x1 = {bf_lo(xw.z), bf_hi(xw.z), bf_lo(xw.w), bf_hi(xw.w)};
                        const f32x4 v0 = x0 + gv[bj][0] * (acc[ai][bj][m][0] + bv[bj][0]), v1 = x1 + gv[bj][1] * (acc[ai][bj][m][1] + bv[bj][1]);
                        u32x4 w; w.x = pk2(v0[0], v0[1]); w.y = pk2(v0[2], v0[3]); w.z = pk2(v1[0], v1[1]); w.w = pk2(v1[2], v1[3]);
                        *(u32x4*)(xout + off + bj * HALF) = w; }
                    asm volatile("" ::: "memory"); }
        }
    }
};
template <int MODE, bool F8OUT = false> struct EpiGated {
    static constexpr bool PERM = true;
    bf16_t* O; int ldc; const float* bias; int hid; float ascale, oscale;
    __device__ __forceinline__ void operator()(AccRef acc, const Unit& u, int wr, int wc, int fr, int fq) const {
        const int row0 = u.pm * BM + wr * 64 + fr, col0 = u.pn * HALF + wc * 32 + 8 * fq;
        f32x4 ba[2], bb[2];
#pragma unroll
        for (int n = 0; n < 2; ++n) { ba[n] = (MODE == 1) ? *(const f32x4*)(bias + col0 + 4 * n) : (f32x4){0.f, 0.f, 0.f, 0.f}; bb[n] = (MODE == 1) ? *(const f32x4*)(bias + hid + col0 + 4 * n) : (f32x4){0.f, 0.f, 0.f, 0.f}; }
#pragma unroll
        for (int ai = 0; ai < 2; ++ai)
#pragma unroll
            for (int m = 0; m < 4; ++m) { bf16_t* rowp = O + (size_t)(row0 + ai * HALF + m * 16) * ldc + col0; float o[8];
#pragma unroll
                for (int n = 0; n < 2; ++n) {
                    if constexpr (MODE == 0) {
                        const f32x4 A4 = acc[ai][0][m][n], U4 = acc[ai][1][m][n]; const float c1 = -LOG2E * ascale, kk = 1.0f / (ascale * ascale * (F8OUT ? oscale : 1.0f));
                        const f32x4 t = A4 * c1; f32x4 e;
#pragma unroll
                        for (int i = 0; i < 4; ++i) e[i] = __builtin_amdgcn_exp2f(t[i]);
                        const f32x4 d = e * kk + kk; f32x4 r;
#pragma unroll
                        for (int i = 0; i < 4; ++i) r[i] = __builtin_amdgcn_rcpf(d[i]);
                        const f32x4 ov = (A4 * U4) * r;
#pragma unroll
                        for (int i = 0; i < 4; ++i) o[4 * n + i] = ov[i];
                        continue; }
                    const f32x4 a = acc[ai][0][m][n] * ascale + ba[n], g = acc[ai][1][m][n] * ascale + bb[n];
                    const f32x4 t = ((MODE == 0) ? a : g) * (-LOG2E); f32x4 e;
#pragma unroll
                    for (int i = 0; i < 4; ++i) e[i] = __builtin_amdgcn_exp2f(t[i]);
                    const f32x4 d = e + 1.0f; f32x4 r;
#pragma unroll
                    for (int i = 0; i < 4; ++i) r[i] = __builtin_amdgcn_rcpf(d[i]);
                    const f32x4 ov = (a * r) * ((MODE == 0) ? g : (f32x4){1.f, 1.f, 1.f, 1.f}) * (F8OUT ? oscale : 1.0f);
#pragma unroll
                    for (int i = 0; i < 4; ++i) o[4 * n + i] = ov[i]; }
                if constexpr (F8OUT) { u32x2 w; w.x = pk4_fp8(o[0], o[1], o[2], o[3]); w.y = pk4_fp8(o[4], o[5], o[6], o[7]);
                    *(u32x2*)((unsigned char*)O + (size_t)(row0 + ai * HALF + m * 16) * ldc + col0) = w; }
                else { u32x4 w; w.x = pk2(o[0], o[1]); w.y = pk2(o[2], o[3]); w.z = pk2(o[4], o[5]); w.w = pk2(o[6], o[7]);
                    *(u32x4*)rowp = w; } }
    }
};
struct EpiBf16 {
    static constexpr bool PERM = true;
    bf16_t* O; int ldc; float scale;
    __device__ __forceinline__ void operator()(AccRef acc, const Unit& u, int wr, int wc, int fr, int fq) const {
        const int row0 = u.pm * BM + wr * 64 + fr, col0 = u.pn * BM + wc * 32 + 8 * fq;
#pragma unroll
        for (int ai = 0; ai < 2; ++ai)
#pragma unroll
            for (int m = 0; m < 4; ++m) { bf16_t* rowp = O + (size_t)(row0 + ai * HALF + m * 16) * ldc + col0;
#pragma unroll
                for (int bj = 0; bj < 2; ++bj) { const f32x4 v0 = acc[ai][bj][m][0] * scale, v1 = acc[ai][bj][m][1] * scale;
                    u32x4 w; w.x = pk2(v0[0], v0[1]); w.y = pk2(v0[2], v0[3]); w.z = pk2(v1[0], v1[1]); w.w = pk2(v1[2], v1[3]);
                    *(u32x4*)(rowp + bj * HALF) = w; } }
    }
};
struct EpiGlaIn {
    static constexpr bool PERM = true;
    bf16_t *Q, *KD, *V, *R; const float* Dk; const float* dref;
    __device__ __forceinline__ void operator()(AccRef acc, const Unit& u, int wr, int wc, int fr, int fq) const {
        const int row0 = u.pm * BM + wr * 64 + fr, cw = wc * 32 + 8 * fq;
        const int type = (u.pn < 2) ? 0 : (u.pn < 4) ? 1 : (u.pn < 8) ? 2 : 3;
        const int tcol = (type == 0) ? u.pn * BM : (type == 1) ? (u.pn - 2) * BM : (type == 2) ? (u.pn - 4) * BM : (u.pn - 8) * BM;
        bf16_t* base = (type == 0) ? Q : (type == 1) ? KD : (type == 2) ? V : R; const int ldc = (type < 2) ? 512 : D;
#pragma unroll
        for (int ai = 0; ai < 2; ++ai)
#pragma unroll
            for (int m = 0; m < 4; ++m) { const int row = row0 + ai * HALF + m * 16;
#pragma unroll
                for (int bj = 0; bj < 2; ++bj) { const int col = tcol + bj * HALF + cw; f32x4 v0 = acc[ai][bj][m][0], v1 = acc[ai][bj][m][1];
                    if (type == 0) { v0 = v0 * 0.08838834764831845f; v1 = v1 * 0.08838834764831845f; }
                    else if (type == 1) { const float* rp = dref + (size_t)(row >> 4) * 512 + col;
                        const u32x4 cw = *(const u32x4*)((const bf16_t*)Dk + (size_t)row * 512 + col); const f32x4 c0 = (f32x4){bf_lo(cw.x), bf_hi(cw.x), bf_lo(cw.y), bf_hi(cw.y)}, c1 = (f32x4){bf_lo(cw.z), bf_hi(cw.z), bf_lo(cw.w), bf_hi(cw.w)}, r0 = *(const f32x4*)rp, r1 = *(const f32x4*)(rp + 4);
#pragma unroll
                        for (int i = 0; i < 4; ++i) { v0[i] *= __expf(r0[i] - c0[i]); v1[i] *= __expf(r1[i] - c1[i]); } }
                    else if (type == 3) {
#pragma unroll
                        for (int i = 0; i < 4; ++i) { v0[i] = fast_silu(v0[i]); v1[i] = fast_silu(v1[i]); } }
                    u32x4 w; w.x = pk2(v0[0], v0[1]); w.y = pk2(v0[2], v0[3]); w.z = pk2(v1[0], v1[1]); w.w = pk2(v1[2], v1[3]);
                    *(u32x4*)(base + (size_t)row * ldc + col) = w; } }
    }
};
struct EpiFoxIn {
    static constexpr bool PERM = true;
    bf16_t *Q, *Kb, *V, *G; const float *qg, *kg; int pn0; float ascale;
    __device__ __forceinline__ void operator()(AccRef acc, const Unit& u, int wr, int wc, int fr, int fq) const {
        const int pn = u.pn + pn0; const int row0 = u.pm * BM + wr * 64 + fr, type = pn >> 2;
        bf16_t* base = (type == 0) ? Q : (type == 1) ? Kb : (type == 2) ? V : G;
        const int colw = (pn & 3) * BM + 64 * wc + 8 * fq;
        f32x4 gn[2][2];
#pragma unroll
        for (int bj = 0; bj < 2; ++bj)
#pragma unroll
            for (int n = 0; n < 2; ++n) { const f32x4 gq = *(const f32x4*)(qg + 32 * bj + 8 * fq + 4 * n) * QSCALE, gk = *(const f32x4*)(kg + 32 * bj + 8 * fq + 4 * n);
                gn[bj][n] = (type == 0) ? gq : gk; }
#pragma unroll
        for (int ai = 0; ai < 2; ++ai)
#pragma unroll
            for (int m = 0; m < 4; ++m) { const int row = row0 + ai * HALF + m * 16; float rs = 1.f;
                if (type < 2) { float ss = 0.f;
#pragma unroll
                    for (int bj = 0; bj < 2; ++bj)
#pragma unroll
                        for (int n = 0; n < 2; ++n) { const f32x4 x = acc[ai][bj][m][n]; ss += (x[0] * x[0] + x[1] * x[1]) + (x[2] * x[2] + x[3] * x[3]); }
                    ss += __shfl_xor(ss, 16); ss += __shfl_xor(ss, 32);
                    rs = __builtin_amdgcn_rsqf(ss * (1.0f / 64.0f) + EPS); }
#pragma unroll
                for (int bj = 0; bj < 2; ++bj) { f32x4 v0 = acc[ai][bj][m][0] * ascale, v1 = acc[ai][bj][m][1] * ascale;
                    if (type < 2) { v0 = v0 * rs * gn[bj][0]; v1 = v1 * rs * gn[bj][1]; }
                    else if (type == 3) {
#pragma unroll
                        for (int i = 0; i < 4; ++i) { v0[i] = fast_sigmoid(v0[i]); v1[i] = fast_sigmoid(v1[i]); } }
                    u32x4 w; w.x = pk2(v0[0], v0[1]); w.y = pk2(v0[2], v0[3]); w.z = pk2(v1[0], v1[1]); w.w = pk2(v1[2], v1[3]);
                    *(u32x4*)(base + (size_t)row * D + colw + 32 * bj) = w; } }
    }
};
}

constexpr int RING_BYTES = 131072;
constexpr int LDS_TAB = 135168;
constexpr int LDS_MISC = LDS_TAB + 256;
constexpr int LDS_BYTES = 147456;

struct Args { const float* in[28]; float* out; unsigned char* ws; int ph_lo, ph_hi; };
enum { I_X = 0, I_C, I_ADA_W, I_ADA_B, I_GLA_WIN, I_GLA_WG2, I_GLA_BG, I_GLA_GN, I_GLA_WOUT, I_CONV_WIN, I_CONV_BIN, I_CONV_DW, I_CONV_DWB, I_CONV_LNG, I_CONV_LNB, I_CONV_WOUT, I_CONV_BOUT,
       I_FOX_WIN, I_FOX_BF, I_FOX_QN, I_FOX_KN, I_FOX_WOUT, I_FFN_W13, I_FFN_W2, I_MOE_R, I_MOE_W13, I_MOE_W2, I_NORMF };

__device__ __forceinline__ const float* karg_in(int i) {
    asm volatile("" : "+s"(i));
    const __attribute__((address_space(4))) char* ka = (const __attribute__((address_space(4))) char*)__builtin_amdgcn_kernarg_segment_ptr();
    return *(const float* const __attribute__((address_space(4)))*)(ka + 8 * i);
}
__device__ __forceinline__ int opq(int x) { asm volatile("" : "+s"(x)); return x; }
__device__ __forceinline__ unsigned char* karg_ws() {
    int i = 29; asm volatile("" : "+s"(i));
    const __attribute__((address_space(4))) char* ka = (const __attribute__((address_space(4))) char*)__builtin_amdgcn_kernarg_segment_ptr();
    return *(unsigned char* const __attribute__((address_space(4)))*)(ka + 8 * i);
}
template <int MODE, bool F8 = false>
__device__ __forceinline__ void tr_item(const float* W, int K, int pitch, int ncols, bf16_t* WT, LAS float* scr, int item, int lane, int hid, float f8scale = 1.0f, int l0base = 0) {
    constexpr int KD = F8 ? 128 : 64;
    const int nblk = ncols / 32, kb = item / nblk, nb = item % nblk, k0 = KD * kb, L0 = l0base + 32 * nb;
    int src0 = L0, dst0 = L0;
    if (MODE == 1) { if (L0 < hid) dst0 = 256 * (L0 / 128) + (L0 % 128); else { const int n = L0 - hid; dst0 = 256 * (n / 128) + 128 + (n % 128); } }
    if (MODE == 2) { src0 = (L0 < 3072) ? L0 : L0 + 16; const int tile = L0 / 256, within = L0 % 256, wc = within / 64, bj = (within % 64) / 32; dst0 = tile * 256 + 128 * bj + 32 * wc; }
#pragma unroll 8
    for (int i = 0; i < KD / 2; ++i) { const int kk = 2 * i + (lane >> 5); scr[kk * 33 + (lane & 31)] = W[(size_t)(k0 + kk) * pitch + src0 + (lane & 31)]; }
    asm volatile("s_waitcnt lgkmcnt(0)" ::: "memory");
    const int c = lane & 7;
#pragma unroll
    for (int j = 0; j < 4; ++j) { const int n = (lane >> 3) + 8 * j; const LAS float* s = scr + ((KD / 8) * c) * 33 + n;
        if constexpr (F8) { u32x4 o; o.x = pk4_fp8(s[0 * 33] * f8scale, s[1 * 33] * f8scale, s[2 * 33] * f8scale, s[3 * 33] * f8scale); o.y = pk4_fp8(s[4 * 33] * f8scale, s[5 * 33] * f8scale, s[6 * 33] * f8scale, s[7 * 33] * f8scale);
            o.z = pk4_fp8(s[8 * 33] * f8scale, s[9 * 33] * f8scale, s[10 * 33] * f8scale, s[11 * 33] * f8scale); o.w = pk4_fp8(s[12 * 33] * f8scale, s[13 * 33] * f8scale, s[14 * 33] * f8scale, s[15 * 33] * f8scale);
            *(u32x4*)((unsigned char*)WT + (size_t)(dst0 + n) * K + k0 + 16 * c) = o; }
        else { u32x4 o; o.x = pk2(s[0 * 33], s[1 * 33]); o.y = pk2(s[2 * 33], s[3 * 33]); o.z = pk2(s[4 * 33], s[5 * 33]); o.w = pk2(s[6 * 33], s[7 * 33]);
            *(u32x4*)(WT + (size_t)(dst0 + n) * K + k0 + 8 * c) = o; } }
    asm volatile("s_waitcnt lgkmcnt(0)" ::: "memory");
}

__device__ __forceinline__ void phase_prologue(LAS unsigned char* lds, const Args& a, int vcu, int G) {
    const int tid = opaque_tid(), lane = tid & 63, wave = __builtin_amdgcn_readfirstlane(tid >> 6);
    unsigned char* ws = a.ws;
    LAS float* cond = (LAS float*)lds;
    LAS float* part = (LAS float*)(lds + 32768);
    for (int i = tid; i < NB * D; i += NTHR) { const int b = i / D, k = i % D; const float v = karg_in(I_C)[i]; cond[k * 8 + b] = v * fast_sigmoid(v); }
    __syncthreads();
    float* mod = (float*)(ws + WS_MOD);
    for (int task = blockIdx.x; task < DEPTH * MOD_W / 32; task += G) {
        const int J0 = task * 32, L = J0 / MOD_W, j0 = J0 % MOD_W, col = lane & 31, kp = lane >> 5;
        const float* w = karg_in(I_ADA_W) + (size_t)L * D * MOD_W + j0 + col;
        float acc[8];
#pragma unroll
        for (int b = 0; b < 8; ++b) acc[b] = 0.f;
#pragma unroll 8
        for (int i = 0; i < 64; ++i) { const int k = wave * 128 + 2 * i + kp; const float wv = w[(size_t)k * MOD_W];
            const f32x4 c0 = *(const LAS f32x4*)(cond + k * 8), c1 = *(const LAS f32x4*)(cond + k * 8 + 4);
            acc[0] += wv * c0[0]; acc[1] += wv * c0[1]; acc[2] += wv * c0[2]; acc[3] += wv * c0[3]; acc[4] += wv * c1[0]; acc[5] += wv * c1[1]; acc[6] += wv * c1[2]; acc[7] += wv * c1[3]; }
#pragma unroll
        for (int b = 0; b < 8; ++b) acc[b] += __shfl_xor(acc[b], 32);
        if (kp == 0) {
#pragma unroll
            for (int b = 0; b < 8; ++b) part[(wave * 8 + b) * 32 + col] = acc[b]; }
        __syncthreads();
        if (tid < 256) { const int b = tid >> 5, cc = tid & 31; float s = karg_in(I_ADA_B)[L * MOD_W + j0 + cc];
#pragma unroll
            for (int w8 = 0; w8 < 8; ++w8) s += part[(w8 * 8 + b) * 32 + cc];
            mod[((size_t)L * NB + b) * MOD_W + j0 + cc] = s; }
        __syncthreads();
    }
    LAS float* scr = (LAS float*)(lds + wave * 16896);
    const int gw = vcu * NWAVES + wave, NGW = G * NWAVES;
    constexpr int IT_GLA_IN = (D / 64) * (3072 / 32), IT_SQ = (D / 64) * (D / 32), IT_CONV_IN = (D / (CONV_FP8 ? 128 : 64)) * (2048 / 32), IT_FOX_QKV = (D / 64) * (FOX_BF_COLS / 32), IT_FOX_G = FOXG_FP8 ? (D / 128) * ((4096 - FOX_BF_COLS) / 32) : (D / 64) * ((4096 - FOX_BF_COLS) / 32), IT_FOX_IN = IT_FOX_QKV + IT_FOX_G;
    constexpr int IT_FFN13 = (D / (FFN_FP8 ? 128 : 64)) * (2 * DFF / 32), IT_FFN2 = (DFF / 64) * (D / 32), IT_MOE13 = (D / (MOE_FP8 ? 128 : 64)) * (2 * DFE / 32), IT_MOE2 = (DFE / (MOE_FP8 ? 128 : 64)) * (D / 32);
    constexpr int NITEMS = 2 * IT_GLA_IN + 2 * IT_SQ + IT_CONV_IN + IT_SQ + IT_FOX_IN + IT_SQ + 2 * IT_FFN13 + 2 * IT_FFN2 + 16 * IT_MOE13 + 16 * IT_MOE2;
    for (int it = gw; it < NITEMS; it += NGW) {
        int r = it;
        if (r < 2 * IT_GLA_IN) { const int j = r / IT_GLA_IN; r %= IT_GLA_IN; tr_item<0>(karg_in(I_GLA_WIN) + (size_t)j * D * GLA_IN, D, GLA_IN, 3072, (bf16_t*)(ws + W_GLA_IN + j * SZ_GLA_IN), scr, r, lane, 0); continue; } r -= 2 * IT_GLA_IN;
        if (r < 2 * IT_SQ) { const int j = r / IT_SQ; r %= IT_SQ; tr_item<0>(karg_in(I_GLA_WOUT) + (size_t)j * D * D, D, D, D, (bf16_t*)(ws + W_GLA_OUT + j * SZ_SQ), scr, r, lane, 0); continue; } r -= 2 * IT_SQ;
        if (r < IT_CONV_IN) { tr_item<1, CONV_FP8 != 0>(karg_in(I_CONV_WIN), D, 2048, 2048, (bf16_t*)(ws + W_CONV_IN), scr, r, lane, 1024, F8_W13); continue; } r -= IT_CONV_IN;
        if (r < IT_SQ) { tr_item<0>(karg_in(I_CONV_WOUT), D, D, D, (bf16_t*)(ws + W_CONV_OUT), scr, r, lane, 0); continue; } r -= IT_SQ;
        if (r < IT_FOX_IN) {
            if (r < IT_FOX_QKV) tr_item<2>(karg_in(I_FOX_WIN), D, FOX_IN, FOX_BF_COLS, (bf16_t*)(ws + W_FOX_IN), scr, r, lane, 0);
            else if (FOXG_FP8) tr_item<2, true>(karg_in(I_FOX_WIN), D, FOX_IN, 4096 - FOX_BF_COLS, (bf16_t*)(ws + W_FOX_IN + (size_t)FOX_BF_COLS * D * 2 - (size_t)FOX_BF_COLS * D), scr, r - IT_FOX_QKV, lane, 0, F8_W13, FOX_BF_COLS);
            else tr_item<2>(karg_in(I_FOX_WIN), D, FOX_IN, 4096 - FOX_BF_COLS, (bf16_t*)(ws + W_FOX_IN), scr, r - IT_FOX_QKV, lane, 0, 1.0f, FOX_BF_COLS);
            continue; } r -= IT_FOX_IN;
        if (r < IT_SQ) { tr_item<0>(karg_in(I_FOX_WOUT), D, D, D, (bf16_t*)(ws + W_FOX_OUT), scr, r, lane, 0); continue; } r -= IT_SQ;
        if (r < 2 * IT_FFN13) { const int j = r / IT_FFN13; r %= IT_FFN13; tr_item<1, FFN_FP8 != 0>(karg_in(I_FFN_W13) + (size_t)j * D * 2 * DFF, D, 2 * DFF, 2 * DFF, (bf16_t*)(ws + W_FFN13 + j * SZ_FFN13), scr, r, lane, DFF, F8_W13); continue; } r -= 2 * IT_FFN13;
        if (r < 2 * IT_FFN2) { const int j = r / IT_FFN2; r %= IT_FFN2; tr_item<0>(karg_in(I_FFN_W2) + (size_t)j * DFF * D, DFF, D, D, (bf16_t*)(ws + W_FFN2 + j * SZ_FFN2), scr, r, lane, 0); continue; } r -= 2 * IT_FFN2;
        if (r < 16 * IT_MOE13) { const int j = r / IT_MOE13; r %= IT_MOE13; tr_item<1, MOE_FP8 != 0>(karg_in(I_MOE_W13) + (size_t)j * D * 2 * DFE, D, 2 * DFE, 2 * DFE, (bf16_t*)(ws + W_MOE13 + j * MOE13_STRIDE), scr, r, lane, DFE, F8_W13); continue; } r -= 16 * IT_MOE13;
        { const int j = r / IT_MOE2; r %= IT_MOE2; tr_item<0, MOE_FP8 != 0>(karg_in(I_MOE_W2) + (size_t)j * DFE * D, DFE, D, D, (bf16_t*)(ws + W_MOE2 + j * MOE2_STRIDE), scr, r, lane, 0, F8_W2); }
    }
}

struct NormArgs {
    const float* xin; float* xout; bf16_t* H; const float* sc; const float* sh;
    int combine; const bf16_t* Y; const u32x4* tinfo; const float* g2p; const unsigned* cntp;
    const float* wx; int wx_pitch; float cscale;
    const float* w2; const float* bvec;
    float* Dk; float* dref; float* etot; float* lf;
    int* tok; u32x4* tinfo_out; unsigned* cnt;
    const float* gamma; float* out;
};
template <int VAR>
__device__ __forceinline__ void norm_phase(LAS unsigned char* lds, const NormArgs& a, int G) {
    const int tid = opaque_tid(), lane = tid & 63, wave = __builtin_amdgcn_readfirstlane(tid >> 6);
    constexpr int NX = (VAR == 1 || VAR == 2) ? 16 : (VAR == 3) ? 8 : 0;
    LAS float* WX = (LAS float*)lds;
    LAS float* W2 = (LAS float*)(lds + 65536);
    LAS float* BG = (LAS float*)(lds + 98304);
    LAS float* TOTW = (LAS float*)(lds + 100352);
    LAS int* SEL_E = (LAS int*)(lds + 65536);
    LAS float* SEL_G = (LAS float*)(lds + 65536 + 512);
    LAS int* BASE = (LAS int*)(lds + 65536 + 1024);
    LAS int* TAB = (LAS int*)(lds + LDS_TAB);
    if constexpr (NX > 0) {
        for (int idx = tid; idx < D * NX; idx += NTHR) { const int k = idx / NX, n = idx % NX; const float v = a.wx[(size_t)k * a.wx_pitch + n];
            const int l = (k & 255) >> 2, j = k >> 8, i = k & 3; WX[((((j * 4 + i) * (NX / 4) + (n >> 2)) * 64 + l) << 2) + (n & 3)] = v; }
    }
    if (VAR == 1) { for (int idx = tid; idx < 16 * 512; idx += NTHR) W2[idx] = a.w2[idx]; for (int idx = tid; idx < 512; idx += NTHR) BG[idx] = a.bvec[idx]; }
    if (a.combine && tid == 0) { int s = 0; for (int e = 0; e < NE; ++e) { TAB[e] = s; s += ((int)a.cntp[e] + 255) >> 8; } TAB[8] = s; }
    __syncthreads();
    for (int g = blockIdx.x; g < NTOK / 64; g += G) {
        const int b = g / (SEQ / 64);
        f32x4 scv[4], shv[4], g2v[4], gmv[4];
#pragma unroll
        for (int j = 0; j < 4; ++j) {
            if (VAR != 4) { scv[j] = *(const f32x4*)(a.sc + (size_t)b * MOD_W + 4 * lane + 256 * j) + 1.0f; shv[j] = *(const f32x4*)(a.sh + (size_t)b * MOD_W + 4 * lane + 256 * j); }
            else gmv[j] = *(const f32x4*)(a.gamma + 4 * lane + 256 * j);
            if (a.combine) g2v[j] = *(const f32x4*)(a.g2p + (size_t)b * MOD_W + 4 * lane + 256 * j) * a.cscale; }
        float run[8];
        if (VAR == 1) {
#pragma unroll
            for (int c = 0; c < 8; ++c) run[c] = 0.f; }
        const bf16_t* xin16 = (const bf16_t*)a.xin; bf16_t* xout16 = (bf16_t*)a.xout;
        u32x2 xn[4];
#pragma unroll
        for (int j = 0; j < 4; ++j) xn[j] = *(const u32x2*)(xin16 + (size_t)(g * 64 + wave * 8) * D + 4 * lane + 256 * j);
#pragma unroll 1
        for (int r = 0; r < 8; ++r) {
            const int row = g * 64 + wave * 8 + r;
            f32x4 x[4];
#pragma unroll
            for (int j = 0; j < 4; ++j) x[j] = (f32x4){bf_lo(xn[j].x), bf_hi(xn[j].x), bf_lo(xn[j].y), bf_hi(xn[j].y)};
            if (r < 7) {
#pragma unroll
                for (int j = 0; j < 4; ++j) xn[j] = *(const u32x2*)(xin16 + (size_t)(row + 1) * D + 4 * lane + 256 * j); }
            if (a.combine) {
                const u32x4 ti = a.tinfo[row];
                const int e0 = ti.x >> 15, e1 = ti.y >> 15; const size_t r0 = (size_t)TAB[e0] * 256 + (ti.x & 32767u), r1 = (size_t)TAB[e1] * 256 + (ti.y & 32767u);
                const float ga = __uint_as_float(ti.z), gb = __uint_as_float(ti.w);
#pragma unroll
                for (int j = 0; j < 4; ++j) { const u32x2 y0 = *(const u32x2*)(a.Y + r0 * D + 4 * lane + 256 * j), y1 = *(const u32x2*)(a.Y + r1 * D + 4 * lane + 256 * j);
                    f32x4 m; m[0] = ga * bf_lo(y0.x) + gb * bf_lo(y1.x); m[1] = ga * bf_hi(y0.x) + gb * bf_hi(y1.x); m[2] = ga * bf_lo(y0.y) + gb * bf_lo(y1.y); m[3] = ga * bf_hi(y0.y) + gb * bf_hi(y1.y);
                    x[j] = x[j] + g2v[j] * m; if (VAR != 4) { u32x2 xw; xw.x = pk2(x[j][0], x[j][1]); xw.y = pk2(x[j][2], x[j][3]); *(u32x2*)(xout16 + (size_t)row * D + 4 * lane + 256 * j) = xw; } }
            }
            float ss = 0.f;
#pragma unroll
            for (int j = 0; j < 4; ++j) ss += (x[j][0] * x[j][0] + x[j][1] * x[j][1]) + (x[j][2] * x[j][2] + x[j][3] * x[j][3]);
            const float rstd = __builtin_amdgcn_rsqf(wave_sum(ss) * (1.0f / D) + EPS);
            if (VAR == 4) {
#pragma unroll
                for (int j = 0; j < 4; ++j) *(f32x4*)(a.out + (size_t)row * D + 4 * lane + 256 * j) = x[j] * rstd * gmv[j];
                continue;
            }
            f32x4 h[4];
#pragma unroll
            for (int j = 0; j < 4; ++j) { h[j] = x[j] * rstd * scv[j] + shv[j];
                if ((VAR == 3 && MOE_FP8) || (VAR == 0 && a.wx_pitch < 0)) {        *(unsigned*)((unsigned char*)a.H + (size_t)row * D + 4 * lane + 256 * j) = pk4_fp8(h[j][0], h[j][1], h[j][2], h[j][3]); }
                else { u32x2 w; w.x = pk2(h[j][0], h[j][1]); w.y = pk2(h[j][2], h[j][3]); *(u32x2*)(a.H + (size_t)row * D + 4 * lane + 256 * j) = w; } }
            if constexpr (NX > 0) {
                float p[NX];
#pragma unroll
                for (int n = 0; n < NX; ++n) p[n] = 0.f;
#pragma unroll
                for (int j = 0; j < 4; ++j)
#pragma unroll
                    for (int i = 0; i < 4; ++i)
                    {
#pragma unroll
                        for (int n4 = 0; n4 < NX / 4; ++n4) { const f32x4 w = *(const LAS f32x4*)(WX + ((((j * 4 + i) * (NX / 4) + n4) * 64 + lane) << 2));
                            p[4 * n4 + 0] += h[j][i] * w[0]; p[4 * n4 + 1] += h[j][i] * w[1]; p[4 * n4 + 2] += h[j][i] * w[2]; p[4 * n4 + 3] += h[j][i] * w[3]; }
                        if (i & 1) { if constexpr (NX == 16) asm volatile("" : "+v"(p[0]), "+v"(p[1]), "+v"(p[2]), "+v"(p[3]), "+v"(p[4]), "+v"(p[5]), "+v"(p[6]), "+v"(p[7]), "+v"(p[8]), "+v"(p[9]), "+v"(p[10]), "+v"(p[11]), "+v"(p[12]), "+v"(p[13]), "+v"(p[14]), "+v"(p[15]) :: "memory");
                            else asm volatile("" : "+v"(p[0]), "+v"(p[1]), "+v"(p[2]), "+v"(p[3]), "+v"(p[4]), "+v"(p[5]), "+v"(p[6]), "+v"(p[7]) :: "memory");
                            __builtin_amdgcn_sched_barrier(0); } }
                xreduce<NX>(p, lane);
                const float red = p[0];
                if (VAR == 1) {
                    float gl[16];
#pragma unroll
                    for (int n = 0; n < 16; ++n) gl[n] = __uint_as_float(__builtin_amdgcn_readlane(__float_as_uint(red), 4 * n));
#pragma unroll
                    for (int jj = 0; jj < 2; ++jj) { f32x4 z = *(const LAS f32x4*)(BG + 256 * jj + 4 * lane);
#pragma unroll
                        for (int n = 0; n < 16; ++n) { z = z + gl[n] * *(const LAS f32x4*)(W2 + n * 512 + 256 * jj + 4 * lane); if ((n & 3) == 3) { asm volatile("" : "+v"(z) :: "memory"); __builtin_amdgcn_sched_barrier(0); } }
#pragma unroll
                        for (int i = 0; i < 4; ++i) run[4 * jj + i] += log_sigmoid(z[i]) * (1.0f / 16.0f);
                        *(f32x4*)(a.Dk + (size_t)row * 512 + 256 * jj + 4 * lane) = (f32x4){run[4 * jj], run[4 * jj + 1], run[4 * jj + 2], run[4 * jj + 3]}; }
                }
                if (VAR == 2) { if ((lane & 3) == 0) { const int n = lane >> 2; a.lf[(size_t)row * 16 + n] = log_sigmoid(red + a.bvec[n]); } }
                if (VAR == 3) {
                    float lg[8];
#pragma unroll
                    for (int n = 0; n < 8; ++n) lg[n] = __uint_as_float(__builtin_amdgcn_readlane(__float_as_uint(red), 8 * n));
                    int e0 = 0; float l0 = lg[0];
#pragma unroll
                    for (int n = 1; n < 8; ++n) if (lg[n] > l0) { l0 = lg[n]; e0 = n; }
                    int e1 = -1; float l1 = -3.0e38f;
#pragma unroll
                    for (int n = 0; n < 8; ++n) if (n != e0 && lg[n] > l1) { l1 = lg[n]; e1 = n; }
                    const float g0 = 1.0f / (1.0f + __expf(l1 - l0));
                    if (lane == 0) { const int lr = wave * 8 + r; SEL_E[lr * 2] = e0; SEL_E[lr * 2 + 1] = e1; SEL_G[lr * 2] = g0; SEL_G[lr * 2 + 1] = 1.0f - g0; }
                }
            }
            FENCE();
        }
        if (VAR == 1) {
#pragma unroll
            for (int jj = 0; jj < 2; ++jj) { f32x4 t; t[0] = run[4 * jj]; t[1] = run[4 * jj + 1]; t[2] = run[4 * jj + 2]; t[3] = run[4 * jj + 3]; *(LAS f32x4*)(TOTW + wave * 512 + 256 * jj + 4 * lane) = t; }
            __syncthreads();
#pragma unroll
            for (int jj = 0; jj < 2; ++jj) { f32x4 off = (f32x4){0.f, 0.f, 0.f, 0.f}, tot = (f32x4){0.f, 0.f, 0.f, 0.f};
#pragma unroll
                for (int w8 = 0; w8 < 8; ++w8) { const f32x4 t = *(const LAS f32x4*)(TOTW + w8 * 512 + 256 * jj + 4 * lane); tot = tot + t; if (w8 < wave) off = off + t; }
                *(f32x4*)(a.dref + ((size_t)g * 8 + wave) * 512 + 256 * jj + 4 * lane) = tot - off;
                if (wave == 0) { f32x4 e;
#pragma unroll
                    for (int i = 0; i < 4; ++i) e[i] = __expf(tot[i]);
                    *(f32x4*)(a.etot + (size_t)g * 512 + 256 * jj + 4 * lane) = e; } }
            __syncthreads();
        }
        if (VAR == 3) {
            __syncthreads();
            if (tid < NE) { int c = 0; for (int q = 0; q < 128; ++q) c += (SEL_E[q] == tid) ? 1 : 0; BASE[tid] = c ? (int)atomicAdd(a.cnt + tid, (unsigned)c) : 0; }
            __syncthreads();
            if (tid < 128) { const int e = SEL_E[tid]; int pos = BASE[e]; for (int q = 0; q < tid; ++q) pos += (SEL_E[q] == e) ? 1 : 0;
                const int row = g * 64 + (tid >> 1); a.tok[e * MOE_CAP + pos] = row;
                unsigned* ti = (unsigned*)(a.tinfo_out + row); ti[tid & 1] = (unsigned)(e * MOE_CAP + pos); ti[2 + (tid & 1)] = __float_as_uint(SEL_G[tid]); }
            __syncthreads();
        }
    }
}


template <int VAR>
__device__ __forceinline__ void norm_mfma(LAS unsigned char* lds, const NormArgs& a, int G) {
    const int tid = opaque_tid(), lane = tid & 63, wave = __builtin_amdgcn_readfirstlane(tid >> 6), r = lane & 15, g = lane >> 4;
    constexpr int NXv = (VAR == 3) ? 8 : 16, WP = 1032;
    LAS bf16_t* WT = (LAS bf16_t*)lds; LAS bf16_t* WTL = (LAS bf16_t*)(lds + 33024);
    LAS float* SC = (LAS float*)(lds + 66048); LAS float* SH = SC + 1024; LAS float* G2 = SH + 1024;
    LAS bf16_t* W2T = (LAS bf16_t*)(lds + 78336); LAS float* BG = (LAS float*)(lds + 94720); LAS float* GL = (LAS float*)(lds + 96768); LAS float* TOT = (LAS float*)(lds + 105472);
    LAS float* LG = (LAS float*)(lds + 78336); LAS int* SEL_E = (LAS int*)(lds + 82432); LAS float* SEL_G = (LAS float*)(lds + 83456); LAS int* BASE = (LAS int*)(lds + 84480);
    LAS int* TAB = (LAS int*)(lds + LDS_TAB);
    for (int idx = tid; idx < D * 16; idx += NTHR) { const int k = idx >> 4, n = idx & 15; const float v = (n < NXv) ? a.wx[(size_t)k * a.wx_pitch + n] : 0.f;
        const unsigned hi = pk2(v, 0.f) & 0xffffu; WT[n * WP + k] = (bf16_t)hi;
        if (VAR == 3) WTL[n * WP + k] = (bf16_t)(pk2(v - __uint_as_float(hi << 16), 0.f) & 0xffffu); }
    if (VAR == 1) { for (int idx = tid; idx < 16 * 512; idx += NTHR) { const int rr = idx >> 9, col = idx & 511; W2T[col * 16 + rr] = (bf16_t)(pk2(a.w2[idx], 0.f) & 0xffffu); }
        for (int idx = tid; idx < 512; idx += NTHR) BG[idx] = a.bvec[idx]; }
    if (a.combine && tid == 0) { int sx = 0; for (int e = 0; e < NE; ++e) { TAB[e] = sx; sx += ((int)a.cntp[e] + 255) >> 8; } TAB[8] = sx; }
    for (int rb = blockIdx.x; rb < NTOK / 128; rb += G) {
        const int b = rb / (SEQ / 128), row = rb * 128 + wave * 16 + r;
        __syncthreads();
        for (int k = tid; k < D; k += NTHR) { SC[k] = a.sc[(size_t)b * MOD_W + k] + 1.0f; SH[k] = a.sh[(size_t)b * MOD_W + k]; if (a.combine) G2[k] = a.g2p[(size_t)b * MOD_W + k] * a.cscale; }
        __syncthreads();
        const float* xr = a.xin + (size_t)row * D + 8 * g; float* xw = a.xout + (size_t)row * D + 8 * g;
        float ss = 0.f;
        if (a.combine) {
            const u32x4 ti = a.tinfo[row];
            const size_t r0 = (size_t)TAB[ti.x >> 15] * 256 + (ti.x & 32767u), r1 = (size_t)TAB[ti.y >> 15] * 256 + (ti.y & 32767u);
            const float ga = __uint_as_float(ti.z), gb = __uint_as_float(ti.w);
            const bf16_t* y0p = a.Y + r0 * D + 8 * g; const bf16_t* y1p = a.Y + r1 * D + 8 * g;
#pragma unroll 4
            for (int sK = 0; sK < 32; ++sK) { f32x4 x0 = *(const f32x4*)(xr + 32 * sK), x1 = *(const f32x4*)(xr + 32 * sK + 4);
                const u32x4 y0 = *(const u32x4*)(y0p + 32 * sK), y1 = *(const u32x4*)(y1p + 32 * sK);
                const f32x4 g0 = *(const LAS f32x4*)(G2 + 32 * sK + 8 * g), g1 = *(const LAS f32x4*)(G2 + 32 * sK + 8 * g + 4);
                f32x4 m0, m1; m0[0] = ga * bf_lo(y0.x) + gb * bf_lo(y1.x); m0[1] = ga * bf_hi(y0.x) + gb * bf_hi(y1.x); m0[2] = ga * bf_lo(y0.y) + gb * bf_lo(y1.y); m0[3] = ga * bf_hi(y0.y) + gb * bf_hi(y1.y);
                m1[0] = ga * bf_lo(y0.z) + gb * bf_lo(y1.z); m1[1] = ga * bf_hi(y0.z) + gb * bf_hi(y1.z); m1[2] = ga * bf_lo(y0.w) + gb * bf_lo(y1.w); m1[3] = ga * bf_hi(y0.w) + gb * bf_hi(y1.w);
                x0 = x0 + g0 * m0; x1 = x1 + g1 * m1; *(f32x4*)(xw + 32 * sK) = x0; *(f32x4*)(xw + 32 * sK + 4) = x1;
                ss += (x0[0] * x0[0] + x0[1] * x0[1]) + (x0[2] * x0[2] + x0[3] * x0[3]) + (x1[0] * x1[0] + x1[1] * x1[1]) + (x1[2] * x1[2] + x1[3] * x1[3]); }
        } else {
#pragma unroll 8
            for (int sK = 0; sK < 32; ++sK) { const f32x4 x0 = *(const f32x4*)(xr + 32 * sK), x1 = *(const f32x4*)(xr + 32 * sK + 4);
                ss += (x0[0] * x0[0] + x0[1] * x0[1]) + (x0[2] * x0[2] + x0[3] * x0[3]) + (x1[0] * x1[0] + x1[1] * x1[1]) + (x1[2] * x1[2] + x1[3] * x1[3]); }
        }
        ss += __shfl_xor(ss, 16); ss += __shfl_xor(ss, 32);
        const float rstd = __builtin_amdgcn_rsqf(ss * (1.0f / D) + EPS);
        const float* x2 = (a.combine ? (const float*)a.xout : a.xin) + (size_t)row * D + 8 * g;
        f32x4 acc = (f32x4){0.f, 0.f, 0.f, 0.f};
#pragma unroll 4
        for (int sK = 0; sK < 32; ++sK) { const f32x4 x0 = *(const f32x4*)(x2 + 32 * sK), x1 = *(const f32x4*)(x2 + 32 * sK + 4);
            const f32x4 c0 = *(const LAS f32x4*)(SC + 32 * sK + 8 * g), c1 = *(const LAS f32x4*)(SC + 32 * sK + 8 * g + 4), s0 = *(const LAS f32x4*)(SH + 32 * sK + 8 * g), s1 = *(const LAS f32x4*)(SH + 32 * sK + 8 * g + 4);
            const f32x4 h0 = x0 * rstd * c0 + s0, h1 = x1 * rstd * c1 + s1;
            u32x4 hw; hw.x = pk2(h0[0], h0[1]); hw.y = pk2(h0[2], h0[3]); hw.z = pk2(h1[0], h1[1]); hw.w = pk2(h1[2], h1[3]);
            if (VAR == 3 && MOE_FP8) { u32x2 w8; w8.x = pk4_fp8(h0[0], h0[1], h0[2], h0[3]); w8.y = pk4_fp8(h1[0], h1[1], h1[2], h1[3]); *(u32x2*)((unsigned char*)a.H + (size_t)row * D + 32 * sK + 8 * g) = w8; }
            else *(u32x4*)(a.H + (size_t)row * D + 32 * sK + 8 * g) = hw;
            const bf16x8 af = __builtin_bit_cast(bf16x8, hw), bw = *(const LAS bf16x8*)(WT + r * WP + 32 * sK + 8 * g);
            acc = __builtin_amdgcn_mfma_f32_16x16x32_bf16(af, bw, acc, 0, 0, 0);
            if (VAR == 3) {
                u32x4 lw; lw.x = pk2(h0[0] - bf_lo(hw.x), h0[1] - bf_hi(hw.x)); lw.y = pk2(h0[2] - bf_lo(hw.y), h0[3] - bf_hi(hw.y)); lw.z = pk2(h1[0] - bf_lo(hw.z), h1[1] - bf_hi(hw.z)); lw.w = pk2(h1[2] - bf_lo(hw.w), h1[3] - bf_hi(hw.w));
                const bf16x8 bl = *(const LAS bf16x8*)(WTL + r * WP + 32 * sK + 8 * g);
                acc = __builtin_amdgcn_mfma_f32_16x16x32_bf16(__builtin_bit_cast(bf16x8, lw), bw, acc, 0, 0, 0);
                acc = __builtin_amdgcn_mfma_f32_16x16x32_bf16(af, bl, acc, 0, 0, 0); } }
        const int grow0 = rb * 128 + wave * 16;
        if (VAR == 2) {
            const float bfv = a.bvec[r];
#pragma unroll
            for (int i = 0; i < 4; ++i) a.lf[(size_t)(grow0 + 4 * g + i) * 16 + r] = log_sigmoid(acc[i] + bfv);
        }
        if (VAR == 3) {
            if (r < 8) {
#pragma unroll
                for (int i = 0; i < 4; ++i) LG[(wave * 16 + 4 * g + i) * 8 + r] = acc[i]; }
            asm volatile("s_waitcnt lgkmcnt(0)" ::: "memory");
            if (lane < 16) { const int lr = wave * 16 + lane; float lg[8];
                const f32x4 la = *(const LAS f32x4*)(LG + lr * 8), lb = *(const LAS f32x4*)(LG + lr * 8 + 4);
                lg[0] = la[0]; lg[1] = la[1]; lg[2] = la[2]; lg[3] = la[3]; lg[4] = lb[0]; lg[5] = lb[1]; lg[6] = lb[2]; lg[7] = lb[3];
                int e0 = 0; float l0 = lg[0];
#pragma unroll
                for (int n = 1; n < 8; ++n) { const bool up = lg[n] > l0; l0 = up ? lg[n] : l0; e0 = up ? n : e0; }
                int e1 = 0; float l1 = -3.0e38f;
#pragma unroll
                for (int n = 0; n < 8; ++n) { const bool up = (n != e0) && (lg[n] > l1); l1 = up ? lg[n] : l1; e1 = up ? n : e1; }
                const float g0 = 1.0f / (1.0f + __expf(l1 - l0));
                SEL_E[lr * 2] = e0; SEL_E[lr * 2 + 1] = e1; SEL_G[lr * 2] = g0; SEL_G[lr * 2 + 1] = 1.0f - g0; }
            __syncthreads();
            if (tid < NE) { int c = 0; for (int q = 0; q < 256; ++q) c += (SEL_E[q] == tid) ? 1 : 0; BASE[tid] = c ? (int)atomicAdd(a.cnt + tid, (unsigned)c) : 0; }
            __syncthreads();
            if (tid < 256) { const int e = SEL_E[tid]; int pos = BASE[e]; for (int q = 0; q < tid; ++q) pos += (SEL_E[q] == e) ? 1 : 0;
                const int trow = rb * 128 + (tid >> 1); a.tok[e * MOE_CAP + pos] = trow;
                unsigned* ti = (unsigned*)(a.tinfo_out + trow); ti[tid & 1] = (unsigned)(e * MOE_CAP + pos); ti[2 + (tid & 1)] = __float_as_uint(SEL_G[tid]); }
        }
        if (VAR == 1) {
            LAS float* GLw = GL + wave * (16 * 17);
#pragma unroll
            for (int i = 0; i < 4; ++i) GLw[(4 * g + i) * 17 + r] = acc[i];
            asm volatile("s_waitcnt lgkmcnt(0)" ::: "memory");
            bf16x8 bg8; { float t[8];
#pragma unroll
                for (int j = 0; j < 8; ++j) t[j] = (g < 2) ? GLw[r * 17 + 8 * (g & 1) + j] : 0.f;
                u32x4 tw; tw.x = pk2(t[0], t[1]); tw.y = pk2(t[2], t[3]); tw.z = pk2(t[4], t[5]); tw.w = pk2(t[6], t[7]); bg8 = __builtin_bit_cast(bf16x8, tw); }
#pragma unroll 2
            for (int cb = 0; cb < 32; ++cb) {
                u32x4 aw = *(const LAS u32x4*)(W2T + (16 * cb + r) * 16 + 8 * (g & 1)); if (g >= 2) aw = (u32x4){0u, 0u, 0u, 0u};
                const f32x4 z = __builtin_amdgcn_mfma_f32_16x16x32_bf16(__builtin_bit_cast(bf16x8, aw), bg8, (f32x4){0.f, 0.f, 0.f, 0.f}, 0, 0, 0);
                const f32x4 bgv = *(const LAS f32x4*)(BG + 16 * cb + 4 * g);
                f32x4 la;
#pragma unroll
                for (int i = 0; i < 4; ++i) la[i] = log_sigmoid(z[i] + bgv[i]) * (1.0f / 16.0f);
#pragma unroll
                for (int off = 1; off < 16; off <<= 1) {
#pragma unroll
                    for (int i = 0; i < 4; ++i) { const float t = __shfl_up(la[i], off, 16); la[i] += (r >= off) ? t : 0.f; } }
                *(f32x4*)(a.Dk + (size_t)row * 512 + 16 * cb + 4 * g) = la;
                if (r == 15) *(LAS f32x4*)(TOT + wave * 512 + 16 * cb + 4 * g) = la;
            }
            __syncthreads();
            const int w0 = wave & ~3;
#pragma unroll
            for (int j = 0; j < 8; ++j) { const int c = lane + 64 * j; float tot = 0.f, off = 0.f;
#pragma unroll
                for (int w4 = 0; w4 < 4; ++w4) { const float t = TOT[(w0 + w4) * 512 + c]; tot += t; off += (w0 + w4 < wave) ? t : 0.f; }
                a.dref[((size_t)rb * 8 + wave) * 512 + c] = tot - off;
                if ((wave & 3) == 0) a.etot[((size_t)rb * 2 + (wave >> 2)) * 512 + c] = __expf(tot); }
        }
    }
}


template <int VAR, bool XF32 = false>
__device__ __forceinline__ void norm_mfma2(LAS unsigned char* lds, const NormArgs& a, int G) {
    const int tid = opaque_tid(), lane = tid & 63, wave = __builtin_amdgcn_readfirstlane(tid >> 6), r = lane & 15, g = lane >> 4;
    constexpr int NXv = (VAR == 3) ? 8 : 16, WP = 1032;
    LAS bf16_t* WT = (LAS bf16_t*)lds; LAS bf16_t* WTL = (LAS bf16_t*)(lds + 33024);
    LAS float* SC = (LAS float*)(lds + 66048); LAS float* SH = SC + 1024; LAS float* G2 = SH + 1024;
    LAS bf16_t* W2T = (LAS bf16_t*)(lds + 78336); LAS float* BG = (LAS float*)(lds + 94720); LAS float* TOT = (LAS float*)(lds + 96768);
    LAS float* PS = (LAS float*)(lds + 113152);
    LAS float* PA = (LAS float*)(lds + 113664);
    LAS float* OUTS = (LAS float*)(lds + 121856);
    LAS int* SEL_E = (LAS int*)(lds + 123008); LAS float* SEL_G = (LAS float*)(lds + 124032); LAS int* BASE = (LAS int*)(lds + 125056);
    LAS int* TAB = (LAS int*)(lds + LDS_TAB);
    for (int idx = tid; idx < D * 16; idx += NTHR) { const int k = idx >> 4, n = idx & 15; const float v = (n < NXv) ? a.wx[(size_t)k * a.wx_pitch + n] : 0.f;
        const unsigned hi = pk2(v, 0.f) & 0xffffu; WT[n * WP + k] = (bf16_t)hi;
        if (VAR == 3) WTL[n * WP + k] = (bf16_t)(pk2(v - __uint_as_float(hi << 16), 0.f) & 0xffffu); }
    if (VAR == 1) { for (int idx = tid; idx < 16 * 512; idx += NTHR) { const int rr = idx >> 9, col = idx & 511; W2T[col * 16 + rr] = (bf16_t)(pk2(a.w2[idx], 0.f) & 0xffffu); }
        for (int idx = tid; idx < 512; idx += NTHR) BG[idx] = a.bvec[idx]; }
    if (a.combine && tid == 0) { int sx = 0; for (int e = 0; e < NE; ++e) { TAB[e] = sx; sx += ((int)a.cntp[e] + 255) >> 8; } TAB[8] = sx; }
    const int kw = 128 * wave + 8 * g;
    for (int rb = blockIdx.x; rb < NTOK / 128; rb += G) {
        const int b = rb / (SEQ / 128);
        __syncthreads();
        for (int k = tid; k < D; k += NTHR) { SC[k] = a.sc[(size_t)b * MOD_W + k] + 1.0f; SH[k] = a.sh[(size_t)b * MOD_W + k]; if (a.combine) G2[k] = a.g2p[(size_t)b * MOD_W + k] * a.cscale; }
        __syncthreads();
        f32x4 xa[4][2]; u32x4 xb[4];
#define NM2_LOAD(ROW) do { if constexpr (XF32) { const float* xr = a.xin + (size_t)(ROW) * D + kw; \
            _Pragma("unroll") for (int sK = 0; sK < 4; ++sK) { xa[sK][0] = *(const f32x4*)(xr + 32 * sK); xa[sK][1] = *(const f32x4*)(xr + 32 * sK + 4); } } \
        else { const bf16_t* xr = (const bf16_t*)a.xin + (size_t)(ROW) * D + kw; \
            _Pragma("unroll") for (int sK = 0; sK < 4; ++sK) xb[sK] = *(const u32x4*)(xr + 32 * sK); } } while (0)
        NM2_LOAD(rb * 128 + r);
#pragma unroll 1
        for (int gi = 0; gi < 8; ++gi) {
            const int row = rb * 128 + gi * 16 + r;
            f32x4 x[4][2];
#pragma unroll
            for (int sK = 0; sK < 4; ++sK) { if constexpr (XF32) { x[sK][0] = xa[sK][0]; x[sK][1] = xa[sK][1]; }
                else { x[sK][0] = (f32x4){bf_lo(xb[sK].x), bf_hi(xb[sK].x), bf_lo(xb[sK].y), bf_hi(xb[sK].y)}; x[sK][1] = (f32x4){bf_lo(xb[sK].z), bf_hi(xb[sK].z), bf_lo(xb[sK].w), bf_hi(xb[sK].w)}; } }
            if (gi < 7) NM2_LOAD(row + 16);
            if (a.combine) {
                const u32x4 ti = a.tinfo[row];
                const size_t r0 = (size_t)TAB[ti.x >> 15] * 256 + (ti.x & 32767u), r1 = (size_t)TAB[ti.y >> 15] * 256 + (ti.y & 32767u);
                const float ga = __uint_as_float(ti.z), gb = __uint_as_float(ti.w);
                const bf16_t* y0p = a.Y + r0 * D + kw; const bf16_t* y1p = a.Y + r1 * D + kw; bf16_t* xw = (bf16_t*)a.xout + (size_t)row * D + kw;
#pragma unroll
                for (int sK = 0; sK < 4; ++sK) { const u32x4 y0 = *(const u32x4*)(y0p + 32 * sK), y1 = *(const u32x4*)(y1p + 32 * sK);
                    const f32x4 g0 = *(const LAS f32x4*)(G2 + kw + 32 * sK), g1 = *(const LAS f32x4*)(G2 + kw + 32 * sK + 4);
                    f32x4 m0, m1; m0[0] = ga * bf_lo(y0.x) + gb * bf_lo(y1.x); m0[1] = ga * bf_hi(y0.x) + gb * bf_hi(y1.x); m0[2] = ga * bf_lo(y0.y) + gb * bf_lo(y1.y); m0[3] = ga * bf_hi(y0.y) + gb * bf_hi(y1.y);
                    m1[0] = ga * bf_lo(y0.z) + gb * bf_lo(y1.z); m1[1] = ga * bf_hi(y0.z) + gb * bf_hi(y1.z); m1[2] = ga * bf_lo(y0.w) + gb * bf_lo(y1.w); m1[3] = ga * bf_hi(y0.w) + gb * bf_hi(y1.w);
                    x[sK][0] = x[sK][0] + g0 * m0; x[sK][1] = x[sK][1] + g1 * m1;
                    u32x4 xs; xs.x = pk2(x[sK][0][0], x[sK][0][1]); xs.y = pk2(x[sK][0][2], x[sK][0][3]); xs.z = pk2(x[sK][1][0], x[sK][1][1]); xs.w = pk2(x[sK][1][2], x[sK][1][3]); *(u32x4*)(xw + 32 * sK) = xs; }
            }
            float ss = 0.f;
#pragma unroll
            for (int sK = 0; sK < 4; ++sK) { const f32x4 x0 = x[sK][0], x1 = x[sK][1];
                ss += (x0[0] * x0[0] + x0[1] * x0[1]) + (x0[2] * x0[2] + x0[3] * x0[3]) + (x1[0] * x1[0] + x1[1] * x1[1]) + (x1[2] * x1[2] + x1[3] * x1[3]); }
            ss += __shfl_xor(ss, 16); ss += __shfl_xor(ss, 32);
            if (g == 0) PS[wave * 16 + r] = ss;
            __syncthreads();
            float st = 0.f;
#pragma unroll
            for (int w8 = 0; w8 < 8; ++w8) st += PS[w8 * 16 + r];
            const float rstd = __builtin_amdgcn_rsqf(st * (1.0f / D) + EPS);
            f32x4 acc = (f32x4){0.f, 0.f, 0.f, 0.f};
#pragma unroll
            for (int sK = 0; sK < 4; ++sK) {
                const f32x4 c0 = *(const LAS f32x4*)(SC + kw + 32 * sK), c1 = *(const LAS f32x4*)(SC + kw + 32 * sK + 4), s0 = *(const LAS f32x4*)(SH + kw + 32 * sK), s1 = *(const LAS f32x4*)(SH + kw + 32 * sK + 4);
                const f32x4 h0 = x[sK][0] * rstd * c0 + s0, h1 = x[sK][1] * rstd * c1 + s1;
                u32x4 hw; hw.x = pk2(h0[0], h0[1]); hw.y = pk2(h0[2], h0[3]); hw.z = pk2(h1[0], h1[1]); hw.w = pk2(h1[2], h1[3]);
                if (VAR == 3 && MOE_FP8) { u32x2 w8; w8.x = pk4_fp8(h0[0], h0[1], h0[2], h0[3]); w8.y = pk4_fp8(h1[0], h1[1], h1[2], h1[3]); *(u32x2*)((unsigned char*)a.H + (size_t)row * D + kw + 32 * sK) = w8; }
                else *(u32x4*)(a.H + (size_t)row * D + kw + 32 * sK) = hw;
                if (VAR == 2 && FOXG_FP8) { u32x2 w8; w8.x = pk4_fp8(h0[0], h0[1], h0[2], h0[3]); w8.y = pk4_fp8(h1[0], h1[1], h1[2], h1[3]); *(u32x2*)((unsigned char*)a.H + (WS_H8 - WS_H) + (size_t)row * D + kw + 32 * sK) = w8; }
                const bf16x8 af = __builtin_bit_cast(bf16x8, hw), bw = *(const LAS bf16x8*)(WT + r * WP + kw + 32 * sK);
                acc = __builtin_amdgcn_mfma_f32_16x16x32_bf16(af, bw, acc, 0, 0, 0);
                if (VAR == 3) {
                    u32x4 lw; lw.x = pk2(h0[0] - bf_lo(hw.x), h0[1] - bf_hi(hw.x)); lw.y = pk2(h0[2] - bf_lo(hw.y), h0[3] - bf_hi(hw.y)); lw.z = pk2(h1[0] - bf_lo(hw.z), h1[1] - bf_hi(hw.z)); lw.w = pk2(h1[2] - bf_lo(hw.w), h1[3] - bf_hi(hw.w));
                    const bf16x8 bl = *(const LAS bf16x8*)(WTL + r * WP + kw + 32 * sK);
                    acc = __builtin_amdgcn_mfma_f32_16x16x32_bf16(__builtin_bit_cast(bf16x8, lw), bw, acc, 0, 0, 0);
                    acc = __builtin_amdgcn_mfma_f32_16x16x32_bf16(af, bl, acc, 0, 0, 0); } }
#pragma unroll
            for (int i = 0; i < 4; ++i) PA[(wave * 16 + 4 * g + i) * 16 + r] = acc[i];
            __syncthreads();
            if (tid < 256) { float o = 0.f;
#pragma unroll
                for (int w8 = 0; w8 < 8; ++w8) o += PA[w8 * 256 + tid];
                OUTS[(tid >> 4) * 17 + (tid & 15)] = o; }
            __syncthreads();
            const int grow0 = rb * 128 + gi * 16;
            if (VAR == 2) { if (tid < 256) { const int rr = tid >> 4, n = tid & 15; a.lf[(size_t)(grow0 + rr) * 16 + n] = log_sigmoid(OUTS[rr * 17 + n] + a.bvec[n]); } }
            if (VAR == 3) {
                if (tid < 16) { const int lr = gi * 16 + tid; float lg[8];
#pragma unroll
                    for (int n = 0; n < 8; ++n) lg[n] = OUTS[tid * 17 + n];
                    int e0 = 0; float l0 = lg[0];
#pragma unroll
                    for (int n = 1; n < 8; ++n) { const bool up = lg[n] > l0; l0 = up ? lg[n] : l0; e0 = up ? n : e0; }
                    int e1 = 0; float l1 = -3.0e38f;
#pragma unroll
                    for (int n = 0; n < 8; ++n) { const bool up = (n != e0) && (lg[n] > l1); l1 = up ? lg[n] : l1; e1 = up ? n : e1; }
                    const float g0 = 1.0f / (1.0f + __expf(l1 - l0));
                    SEL_E[lr * 2] = e0; SEL_E[lr * 2 + 1] = e1; SEL_G[lr * 2] = g0; SEL_G[lr * 2 + 1] = 1.0f - g0; } }
            if (VAR == 1) {
                bf16x8 bg8; { float t[8];
#pragma unroll
                    for (int j = 0; j < 8; ++j) t[j] = (g < 2) ? OUTS[r * 17 + 8 * (g & 1) + j] : 0.f;
                    u32x4 tw; tw.x = pk2(t[0], t[1]); tw.y = pk2(t[2], t[3]); tw.z = pk2(t[4], t[5]); tw.w = pk2(t[6], t[7]); bg8 = __builtin_bit_cast(bf16x8, tw); }
#pragma unroll
                for (int c4 = 0; c4 < 4; ++c4) { const int cb = 4 * wave + c4;
                    u32x4 aw = *(const LAS u32x4*)(W2T + (16 * cb + r) * 16 + 8 * (g & 1)); if (g >= 2) aw = (u32x4){0u, 0u, 0u, 0u};
                    const f32x4 z = __builtin_amdgcn_mfma_f32_16x16x32_bf16(__builtin_bit_cast(bf16x8, aw), bg8, (f32x4){0.f, 0.f, 0.f, 0.f}, 0, 0, 0);
                    const f32x4 bgv = *(const LAS f32x4*)(BG + 16 * cb + 4 * g);
                    f32x4 la;
#pragma unroll
                    for (int i = 0; i < 4; ++i) la[i] = log_sigmoid(z[i] + bgv[i]) * (1.0f / 16.0f);
                    { float a0 = la[0], a1 = la[1], a2 = la[2], a3 = la[3];
#define NM2_DPP(sh) "v_add_f32_dpp %0, %0, %0 row_shr:" #sh " row_mask:0xf bank_mask:0xf bound_ctrl:1\n\tv_add_f32_dpp %1, %1, %1 row_shr:" #sh " row_mask:0xf bank_mask:0xf bound_ctrl:1\n\t" \
                        "v_add_f32_dpp %2, %2, %2 row_shr:" #sh " row_mask:0xf bank_mask:0xf bound_ctrl:1\n\tv_add_f32_dpp %3, %3, %3 row_shr:" #sh " row_mask:0xf bank_mask:0xf bound_ctrl:1\n\t"
                        asm volatile("s_nop 1\n\t" NM2_DPP(1) NM2_DPP(2) NM2_DPP(4) NM2_DPP(8) "s_nop 1" : "+v"(a0), "+v"(a1), "+v"(a2), "+v"(a3));
#undef NM2_DPP
                        la[0] = a0; la[1] = a1; la[2] = a2; la[3] = a3; }
                    { u32x2 dw; dw.x = pk2(la[0], la[1]); dw.y = pk2(la[2], la[3]); *(u32x2*)((bf16_t*)a.Dk + (size_t)row * 512 + 16 * cb + 4 * g) = dw; }
                    if (r == 15) *(LAS f32x4*)(TOT + gi * 512 + 16 * cb + 4 * g) = la; } }
        }
        if (VAR == 1) {
            __syncthreads();
#pragma unroll
            for (int j = 0; j < 8; ++j) { const int idx = tid + NTHR * j, gi = idx >> 9, c = idx & 511, g0i = gi & ~3; float tot = 0.f, off = 0.f;
#pragma unroll
                for (int w4 = 0; w4 < 4; ++w4) { const float t = TOT[(g0i + w4) * 512 + c]; tot += t; off += (g0i + w4 < gi) ? t : 0.f; }
                a.dref[((size_t)rb * 8 + gi) * 512 + c] = tot - off;
                if ((gi & 3) == 0) a.etot[((size_t)rb * 2 + (gi >> 2)) * 512 + c] = __expf(tot); }
        }
        if (VAR == 3) {
            __syncthreads();
            if (tid < NE) { int c = 0; for (int q = 0; q < 256; ++q) c += (SEL_E[q] == tid) ? 1 : 0; BASE[tid] = c ? (int)atomicAdd(a.cnt + tid, (unsigned)c) : 0; }
            __syncthreads();
            if (tid < 256) { const int e = SEL_E[tid]; int pos = BASE[e]; for (int q = 0; q < tid; ++q) pos += (SEL_E[q] == e) ? 1 : 0;
                const int trow = rb * 128 + (tid >> 1); a.tok[e * MOE_CAP + pos] = trow;
                unsigned* ti = (unsigned*)(a.tinfo_out + trow); ti[tid & 1] = (unsigned)(e * MOE_CAP + pos); ti[2 + (tid & 1)] = __float_as_uint(SEL_G[tid]); }
        }
    }
}
#undef NM2_LOAD

__device__ __forceinline__ void gla_scan_phase(LAS unsigned char* lds, const bf16_t* Qg, const bf16_t* KD, const bf16_t* V, const float* etot, bf16_t* O, int vcu, int G) {
    const int tid = opaque_tid();
    constexpr int QP = 272;
    LAS unsigned char* Qs = lds; LAS unsigned char* Ks = lds + 64 * QP; LAS unsigned char* Vs = lds + 2 * 64 * QP;
    LAS float* Sl = (LAS float*)(lds + 2 * 64 * QP + 4096); LAS float* Et = Sl + 128 * 32;
    for (int u = vcu; u < NB * 4 * 8; u += G) {
        const int b = u >> 5, h = (u >> 3) & 3, vs = u & 7;
        const int kg = tid >> 5, v = tid & 31;
        const int oc = tid >> 3, ov = tid & 7;
        float S[8];
#pragma unroll
        for (int i = 0; i < 8; ++i) S[i] = 0.f;
        u32x4 pq[2], pk[2], pv; float pe = 0.f; pv = (u32x4){0u, 0u, 0u, 0u};
        auto fetch = [&](int n) {
            const size_t row0 = (size_t)b * SEQ + (size_t)n * 64;
#pragma unroll
            for (int i = 0; i < 2; ++i) { const int idx = tid + i * NTHR, r = idx >> 4, c = idx & 15;
                pq[i] = *(const u32x4*)(Qg + (row0 + r) * 512 + h * 128 + c * 8); pk[i] = *(const u32x4*)(KD + (row0 + r) * 512 + h * 128 + c * 8); }
            if (tid < 256) { const int r = tid >> 2, c = tid & 3; pv = *(const u32x4*)(V + (row0 + r) * D + h * 256 + vs * 32 + c * 8); }
            if (tid < 128) pe = etot[((size_t)b * 64 + n) * 512 + h * 128 + tid];
        };
        fetch(0);
        for (int n = 0; n < 64; ++n) {
#pragma unroll
            for (int i = 0; i < 2; ++i) { const int idx = tid + i * NTHR, r = idx >> 4, c = idx & 15; *(LAS u32x4*)(Qs + r * QP + c * 16) = pq[i]; *(LAS u32x4*)(Ks + r * QP + c * 16) = pk[i]; }
            if (tid < 256) { const int r = tid >> 2, c = tid & 3; *(LAS u32x4*)(Vs + r * 64 + c * 16) = pv; }
            if (tid < 128) Et[tid] = pe;
            __syncthreads();
            if (n + 1 < 64) fetch(n + 1);
#pragma unroll
            for (int i = 0; i < 8; ++i) S[i] *= Et[kg * 8 + i];
#pragma unroll 4
            for (int c = 0; c < 64; ++c) { const u32x4 kw = *(const LAS u32x4*)(Ks + c * QP + kg * 16); const float vv = __uint_as_float((unsigned)(*(const LAS unsigned short*)(Vs + c * 64 + v * 2)) << 16);
                S[0] += bf_lo(kw.x) * vv; S[1] += bf_hi(kw.x) * vv; S[2] += bf_lo(kw.y) * vv; S[3] += bf_hi(kw.y) * vv; S[4] += bf_lo(kw.z) * vv; S[5] += bf_hi(kw.z) * vv; S[6] += bf_lo(kw.w) * vv; S[7] += bf_hi(kw.w) * vv; }
#pragma unroll
            for (int i = 0; i < 8; ++i) Sl[(kg * 8 + i) * 32 + v] = S[i];
            __syncthreads();
            f32x4 o = (f32x4){0.f, 0.f, 0.f, 0.f};
#pragma unroll 2
            for (int k8 = 0; k8 < 16; ++k8) { const u32x4 qw = *(const LAS u32x4*)(Qs + oc * QP + k8 * 16);
                const float qf[8] = {bf_lo(qw.x), bf_hi(qw.x), bf_lo(qw.y), bf_hi(qw.y), bf_lo(qw.z), bf_hi(qw.z), bf_lo(qw.w), bf_hi(qw.w)};
#pragma unroll
                for (int i = 0; i < 8; ++i) o = o + qf[i] * *(const LAS f32x4*)(Sl + (k8 * 8 + i) * 32 + ov * 4); }
            u32x2 w; w.x = pk2(o[0], o[1]); w.y = pk2(o[2], o[3]);
            *(u32x2*)(O + ((size_t)b * SEQ + (size_t)n * 64 + oc) * D + h * 256 + vs * 32 + ov * 4) = w;
            __syncthreads();
        }
    }
}


namespace gscan {
typedef short v4i16_t __attribute__((ext_vector_type(4)));
__device__ __forceinline__ unsigned off_b(unsigned row, unsigned ch) { return 256u * row + 16u * (ch ^ (((row & 3u) << 2) | ((row >> 2) & 3u))); }
__device__ __forceinline__ unsigned off_v(unsigned row, unsigned half) { return 64u * row + 32u * (half ^ ((row >> 3) & 1u)); }
constexpr int IMG_Q = 0, IMG_K = 16384, IMG_V = 32768, IMG_E = 36864, BUFB = 37376, ST_OFF = 2 * BUFB;
__device__ __forceinline__ bf16x8 tr8(const LAS unsigned char* p0, const LAS unsigned char* p1) {
    const v4i16_t lo = __builtin_amdgcn_ds_read_tr16_b64_v4i16((LAS v4i16_t*)p0), hi = __builtin_amdgcn_ds_read_tr16_b64_v4i16((LAS v4i16_t*)p1);
    return (bf16x8){lo[0], lo[1], lo[2], lo[3], hi[0], hi[1], hi[2], hi[3]};
}
#define GS_BAR() do { asm volatile("s_waitcnt lgkmcnt(0)" ::: "memory"); __builtin_amdgcn_s_barrier(); asm volatile("" ::: "memory"); } while (0)
struct Pre { u32x4 q[2], k[2], v; float e; };
__device__ __forceinline__ void gload(Pre& r, const bf16_t* Qg, const bf16_t* KD, const bf16_t* V, const float* etot, int b, int h, int vs, int n, int tid) {
    const size_t row0 = (size_t)b * SEQ + (size_t)n * 64;
#pragma unroll
    for (int i = 0; i < 2; ++i) { const int idx = tid + i * NTHR, rr = idx >> 4, c = idx & 15;
        r.q[i] = *(const u32x4*)(Qg + (row0 + rr) * 512 + h * 128 + c * 8); r.k[i] = *(const u32x4*)(KD + (row0 + rr) * 512 + h * 128 + c * 8); }
    if (tid < 256) { const int rr = tid >> 2, c = tid & 3; r.v = *(const u32x4*)(V + (row0 + rr) * D + h * 256 + vs * 32 + c * 8); }
    if (tid < 128) r.e = etot[((size_t)b * 64 + n) * 512 + h * 128 + tid];
}
__device__ __forceinline__ void lwrite(const Pre& r, LAS unsigned char* buf, int tid) {
#pragma unroll
    for (int i = 0; i < 2; ++i) { const int idx = tid + i * NTHR, rr = idx >> 4, c = idx & 15; *(LAS u32x4*)(buf + IMG_Q + off_b(rr, c)) = r.q[i]; *(LAS u32x4*)(buf + IMG_K + off_b(rr, c)) = r.k[i]; }
    if (tid < 256) { const int rr = tid >> 2, c = tid & 3; *(LAS u32x4*)(buf + IMG_V + off_v(rr, c >> 1) + 16 * (c & 1)) = r.v; }
    if (tid < 128) *(LAS float*)(buf + IMG_E + 4 * tid) = r.e;
}
__device__ __forceinline__ void chunk(LAS unsigned char* lds, LAS unsigned char* buf, f32x4& S0, f32x4& S1, bf16_t* Orow0, int w, int lane) {
    const int g = lane >> 4, l15 = lane & 15, q = l15 >> 2, p = lane & 3;
    LAS unsigned char* ST = lds + ST_OFF;
    { const f32x4 et = *(const LAS f32x4*)(buf + IMG_E + 4 * (16 * w + 4 * g));
        S0 = S0 * et; S1 = S1 * et;
#pragma unroll
        for (int ks = 0; ks < 2; ++ks) {
            const unsigned r0 = 32 * ks + 8 * g + q, r1 = r0 + 4;
            const bf16x8 a = tr8(buf + IMG_K + off_b(r0, 2 * w + (p >> 1)) + 8 * (p & 1), buf + IMG_K + off_b(r1, 2 * w + (p >> 1)) + 8 * (p & 1));
            const bf16x8 b0 = tr8(buf + IMG_V + off_v(r0, 0) + 8 * p, buf + IMG_V + off_v(r1, 0) + 8 * p);
            const bf16x8 b1 = tr8(buf + IMG_V + off_v(r0, 1) + 8 * p, buf + IMG_V + off_v(r1, 1) + 8 * p);
            S0 = __builtin_amdgcn_mfma_f32_16x16x32_bf16(a, b0, S0, 0, 0, 0);
            S1 = __builtin_amdgcn_mfma_f32_16x16x32_bf16(a, b1, S1, 0, 0, 0);
        }
        u32x2 w0, w1; w0.x = pk2(S0[0], S0[1]); w0.y = pk2(S0[2], S0[3]); w1.x = pk2(S1[0], S1[1]); w1.y = pk2(S1[2], S1[3]);
        *(LAS u32x2*)(ST + off_b(l15, 2 * w + (g >> 1)) + 8 * (g & 1)) = w0;
        *(LAS u32x2*)(ST + off_b(16 + l15, 2 * w + (g >> 1)) + 8 * (g & 1)) = w1; }
    GS_BAR();
    { const int vt = w & 1, ct = w >> 1; f32x4 o = (f32x4){0.f, 0.f, 0.f, 0.f};
#pragma unroll
        for (int sK = 0; sK < 4; ++sK) {
            const bf16x8 a = *(const LAS bf16x8*)(ST + off_b(16 * vt + l15, 4 * sK + g));
            const bf16x8 bq = *(const LAS bf16x8*)(buf + IMG_Q + off_b(16 * ct + l15, 4 * sK + g));
            o = __builtin_amdgcn_mfma_f32_16x16x32_bf16(a, bq, o, 0, 0, 0);
        }
        u32x2 wo; wo.x = pk2(o[0], o[1]); wo.y = pk2(o[2], o[3]);
        *(u32x2*)(Orow0 + (size_t)(16 * ct + l15) * D + 16 * vt + 4 * g) = wo; }
    GS_BAR();
}
}
__device__ __forceinline__ void gla_scan_mfma(LAS unsigned char* lds, const bf16_t* Qg, const bf16_t* KD, const bf16_t* V, const float* etot, bf16_t* O, int vcu, int G) {
    using namespace gscan;
    const int tid = opaque_tid(), lane = tid & 63, w = __builtin_amdgcn_readfirstlane(tid >> 6);
    for (int u = vcu; u < NB * 4 * 8; u += G) {
        const int b = u >> 5, h = (u >> 3) & 3, vs = u & 7;
        f32x4 S0 = (f32x4){0.f, 0.f, 0.f, 0.f}, S1 = (f32x4){0.f, 0.f, 0.f, 0.f};
        Pre pa, pb; pa.v = (u32x4){0u, 0u, 0u, 0u}; pb.v = pa.v; pa.e = 0.f; pb.e = 0.f;
        gload(pa, Qg, KD, V, etot, b, h, vs, 0, tid); gload(pb, Qg, KD, V, etot, b, h, vs, 1, tid);
        lwrite(pa, lds, tid); lwrite(pb, lds + BUFB, tid);
        gload(pa, Qg, KD, V, etot, b, h, vs, 2, tid); gload(pb, Qg, KD, V, etot, b, h, vs, 3, tid);
        GS_BAR();
        bf16_t* Ob = O + ((size_t)b * SEQ) * D + h * 256 + vs * 32;
        for (int n = 0; n < 64; n += 2) {
            chunk(lds, lds, S0, S1, Ob + (size_t)n * 64 * D, w, lane);
            if (n + 2 < 64) { lwrite(pa, lds, tid); if (n + 4 < 64) gload(pa, Qg, KD, V, etot, b, h, vs, n + 4, tid); }
            chunk(lds, lds + BUFB, S0, S1, Ob + (size_t)(n + 1) * 64 * D, w, lane);
            if (n + 3 < 64) { lwrite(pb, lds + BUFB, tid); if (n + 5 < 64) gload(pb, Qg, KD, V, etot, b, h, vs, n + 5, tid); }
        }
        GS_BAR();
    }
}

__device__ __forceinline__ void gla_gn_phase(const bf16_t* O, const bf16_t* R, const float* gn, bf16_t* A2, int vcu, int G) {
    const int tid = opaque_tid(), lane = tid & 63, wave = tid >> 6;
    f32x4 g[4];
#pragma unroll
    for (int j = 0; j < 4; ++j) g[j] = *(const f32x4*)(gn + 16 * lane + 4 * j);
    for (int row = vcu * NWAVES + wave; row < NTOK; row += G * NWAVES) {
        const u32x4 o0 = *(const u32x4*)(O + (size_t)row * D + 16 * lane), o1 = *(const u32x4*)(O + (size_t)row * D + 16 * lane + 8);
        const u32x4 r0 = *(const u32x4*)(R + (size_t)row * D + 16 * lane), r1 = *(const u32x4*)(R + (size_t)row * D + 16 * lane + 8);
        float ov[16], rv[16];
        const unsigned ow[8] = {o0.x, o0.y, o0.z, o0.w, o1.x, o1.y, o1.z, o1.w}, rw[8] = {r0.x, r0.y, r0.z, r0.w, r1.x, r1.y, r1.z, r1.w};
        float ss = 0.f;
#pragma unroll
        for (int i = 0; i < 8; ++i) { ov[2 * i] = bf_lo(ow[i]); ov[2 * i + 1] = bf_hi(ow[i]); rv[2 * i] = bf_lo(rw[i]); rv[2 * i + 1] = bf_hi(rw[i]); ss += ov[2 * i] * ov[2 * i] + ov[2 * i + 1] * ov[2 * i + 1]; }
        ss += __shfl_xor(ss, 1); ss += __shfl_xor(ss, 2); ss += __shfl_xor(ss, 4); ss += __shfl_xor(ss, 8);
        const float rs = __builtin_amdgcn_rsqf(ss * (1.0f / 256.0f) + EPS);
        u32x4 w0, w1;
        w0.x = pk2(ov[0] * rs * g[0][0] * rv[0], ov[1] * rs * g[0][1] * rv[1]); w0.y = pk2(ov[2] * rs * g[0][2] * rv[2], ov[3] * rs * g[0][3] * rv[3]);
        w0.z = pk2(ov[4] * rs * g[1][0] * rv[4], ov[5] * rs * g[1][1] * rv[5]); w0.w = pk2(ov[6] * rs * g[1][2] * rv[6], ov[7] * rs * g[1][3] * rv[7]);
        w1.x = pk2(ov[8] * rs * g[2][0] * rv[8], ov[9] * rs * g[2][1] * rv[9]); w1.y = pk2(ov[10] * rs * g[2][2] * rv[10], ov[11] * rs * g[2][3] * rv[11]);
        w1.z = pk2(ov[12] * rs * g[3][0] * rv[12], ov[13] * rs * g[3][1] * rv[13]); w1.w = pk2(ov[14] * rs * g[3][2] * rv[14], ov[15] * rs * g[3][3] * rv[15]);
        *(u32x4*)(A2 + (size_t)row * D + 16 * lane) = w0; *(u32x4*)(A2 + (size_t)row * D + 16 * lane + 8) = w1;
    }
}

template <int J> __device__ __forceinline__ void conv_step(f32x2 (&ac)[16], const f32x2 (&wv2)[CONVW], unsigned packed) {
    const f32x2 uu = (f32x2){bf_lo(packed), bf_hi(packed)};
#pragma unroll
    for (int ro = 0; ro < 16; ++ro) { constexpr int dummy = 0; (void)dummy; const int w = J - ro;
        if (w >= 0 && w <= 30) {
            asm("v_fmac_f32 %0, %1, %2" : "+v"(ac[ro][0]) : "v"(wv2[w][0]), "v"(uu[0]));
            asm("v_fmac_f32 %0, %1, %2" : "+v"(ac[ro][1]) : "v"(wv2[w][1]), "v"(uu[1])); } }
}
__device__ __forceinline__ void conv_phase(LAS unsigned char* lds, const bf16_t* U, const float* dw, const float* dwb, const float* lng, const float* lnb, bf16_t* A2, int vcu, int G) {
    const int tid = opaque_tid(), lane = tid & 63, wave = __builtin_amdgcn_readfirstlane(tid >> 6);
    LAS float* PART = (LAS float*)lds;
    LAS float* STAT = PART + 512;
    f32x2 wv2[CONVW];
#pragma unroll
    for (int w = 0; w < CONVW; ++w) wv2[w] = *(const f32x2*)(dw + w * D + 2 * tid);
    const f32x2 bia = *(const f32x2*)(dwb + 2 * tid), gam = *(const f32x2*)(lng + 2 * tid), bet = *(const f32x2*)(lnb + 2 * tid);
    for (int u = vcu; u < NB * (SEQ / 128); u += G) {
        const int b = u / (SEQ / 128), t0 = (u % (SEQ / 128)) * 128;
        const bf16_t* ub = U + ((size_t)b * SEQ) * D + 2 * tid;
        unsigned inp[46], nx[16];
#pragma unroll
        for (int j = 0; j < 30; ++j) { const int sfr = t0 - 30 + j; inp[j] = (sfr >= 0) ? *(const unsigned*)(ub + (size_t)sfr * D) : 0u; }
#pragma unroll
        for (int j = 0; j < 16; ++j) nx[j] = *(const unsigned*)(ub + (size_t)(t0 + j) * D);
#pragma unroll 1
        for (int og = 0; og < 8; ++og) {
#pragma unroll
            for (int j = 0; j < 16; ++j) inp[30 + j] = nx[j];
            if (og < 7) {
#pragma unroll
                for (int j = 0; j < 16; ++j) nx[j] = *(const unsigned*)(ub + (size_t)(t0 + 16 * (og + 1) + j) * D); }
            f32x2 ac[16];
#pragma unroll
            for (int r = 0; r < 16; ++r) ac[r] = bia;
#define CS(J) conv_step<J>(ac, wv2, inp[J]);
            CS(0) CS(1) CS(2) CS(3) CS(4) CS(5) CS(6) CS(7) CS(8) CS(9) CS(10) CS(11) CS(12) CS(13) CS(14) CS(15) CS(16) CS(17) CS(18) CS(19) CS(20) CS(21) CS(22) CS(23) CS(24) CS(25) CS(26) CS(27) CS(28) CS(29) CS(30) CS(31) CS(32) CS(33) CS(34) CS(35) CS(36) CS(37) CS(38) CS(39) CS(40) CS(41) CS(42) CS(43) CS(44) CS(45)
#undef CS
#pragma unroll
            for (int j = 0; j < 30; ++j) inp[j] = inp[j + 16];
            float a0[16], a1[16];
#pragma unroll
            for (int r = 0; r < 16; ++r) { a0[r] = ac[r][0]; a1[r] = ac[r][1]; }
            { float st[16];
#pragma unroll
                for (int r = 0; r < 16; ++r) st[r] = a0[r] + a1[r];
                xreduce<16>(st, lane);
                if ((lane & 3) == 0) PART[wave * 32 + (lane >> 2)] = st[0];
#pragma unroll
                for (int r = 0; r < 16; ++r) st[r] = a0[r] * a0[r] + a1[r] * a1[r];
                xreduce<16>(st, lane);
                if ((lane & 3) == 0) PART[wave * 32 + 16 + (lane >> 2)] = st[0]; }
            __syncthreads();
            if (tid < 16) { float s1 = 0.f, s2 = 0.f;
#pragma unroll
                for (int w8 = 0; w8 < 8; ++w8) { s1 += PART[w8 * 32 + tid]; s2 += PART[w8 * 32 + 16 + tid]; }
                const float mean = s1 * (1.0f / D); const float var = fmaxf(s2 * (1.0f / D) - mean * mean, 0.f);
                STAT[2 * tid] = mean; STAT[2 * tid + 1] = __builtin_amdgcn_rsqf(var + EPS); }
            __syncthreads();
#pragma unroll
            for (int r = 0; r < 16; ++r) { const float mean = STAT[2 * r], rs = STAT[2 * r + 1];
                const float y0 = (a0[r] - mean) * rs * gam[0] + bet[0], y1 = (a1[r] - mean) * rs * gam[1] + bet[1];
                *(unsigned*)(A2 + ((size_t)b * SEQ + t0 + 16 * og + r) * D + 2 * tid) = pk2(fast_silu(y0), fast_silu(y1)); }
            __syncthreads();
        }
    }
}

__device__ __forceinline__ void fox_attn_naive(LAS unsigned char* lds, const bf16_t* Q, const bf16_t* Kb, const bf16_t* V, const bf16_t* OG, const float* lf, bf16_t* A2, int vcu, int G) {
    const int tid = opaque_tid(), ql = tid >> 1, hf = tid & 1;
    LAS float* CUM = (LAS float*)lds;
    LAS float* Ks = (LAS float*)(lds + 16384);
    LAS float* Vs = (LAS float*)(lds + 32768);
    LAS float* SCN = (LAS float*)(lds + 49152);
    for (int pu = vcu; pu < NB * 16 * 8; pu += G) {
        const int bh = pu >> 3, b = bh >> 4, h = bh & 15, pr = pu & 7;
        { float loc[8]; float s = 0.f;
#pragma unroll
            for (int i = 0; i < 8; ++i) { s += lf[((size_t)b * SEQ + 8 * tid + i) * 16 + h]; loc[i] = s; }
            __syncthreads();
            SCN[tid] = s; __syncthreads();
            for (int off = 1; off < NTHR; off <<= 1) { const float t = (tid >= off) ? SCN[tid - off] : 0.f; __syncthreads(); SCN[tid] += t; __syncthreads(); }
            const float base = (tid > 0) ? SCN[tid - 1] : 0.f;
#pragma unroll
            for (int i = 0; i < 8; ++i) CUM[8 * tid + i] = (base + loc[i]) * LOG2E;
            __syncthreads(); }
        for (int half = 0; half < 2; ++half) {
            const int qt = half ? 15 - pr : pr; const int qi = qt * 256 + ql; const size_t qrow = (size_t)b * SEQ + qi;
            float q[32], o[32];
#pragma unroll
            for (int c = 0; c < 4; ++c) { const u32x4 w = *(const u32x4*)(Q + qrow * D + h * 64 + hf * 32 + c * 8);
                q[8 * c] = bf_lo(w.x); q[8 * c + 1] = bf_hi(w.x); q[8 * c + 2] = bf_lo(w.y); q[8 * c + 3] = bf_hi(w.y); q[8 * c + 4] = bf_lo(w.z); q[8 * c + 5] = bf_hi(w.z); q[8 * c + 6] = bf_lo(w.w); q[8 * c + 7] = bf_hi(w.w); }
#pragma unroll
            for (int d = 0; d < 32; ++d) o[d] = 0.f;
            float mx = -3.0e38f, l = 0.f; const float cq = CUM[qi];
            const int ntile = (qt * 256 + 256) / 64;
            for (int kt = 0; kt < ntile; ++kt) {
                __syncthreads();
                { const int r = tid >> 3, c = tid & 7; const size_t krow = (size_t)b * SEQ + kt * 64 + r;
                    const u32x4 kw = *(const u32x4*)(Kb + krow * D + h * 64 + c * 8), vw = *(const u32x4*)(V + krow * D + h * 64 + c * 8);
                    *(LAS f32x4*)(Ks + r * 64 + c * 8) = (f32x4){bf_lo(kw.x), bf_hi(kw.x), bf_lo(kw.y), bf_hi(kw.y)}; *(LAS f32x4*)(Ks + r * 64 + c * 8 + 4) = (f32x4){bf_lo(kw.z), bf_hi(kw.z), bf_lo(kw.w), bf_hi(kw.w)};
                    *(LAS f32x4*)(Vs + r * 64 + c * 8) = (f32x4){bf_lo(vw.x), bf_hi(vw.x), bf_lo(vw.y), bf_hi(vw.y)}; *(LAS f32x4*)(Vs + r * 64 + c * 8 + 4) = (f32x4){bf_lo(vw.z), bf_hi(vw.z), bf_lo(vw.w), bf_hi(vw.w)}; }
                __syncthreads();
#pragma unroll 1
                for (int j = 0; j < 64; ++j) {
                    const int kj = kt * 64 + j;
                    float acc = 0.f;
#pragma unroll
                    for (int d4 = 0; d4 < 8; ++d4) { const f32x4 kv = *(const LAS f32x4*)(Ks + j * 64 + hf * 32 + d4 * 4); acc += q[4 * d4] * kv[0] + q[4 * d4 + 1] * kv[1] + q[4 * d4 + 2] * kv[2] + q[4 * d4 + 3] * kv[3]; }
                    acc += __shfl_xor(acc, 1);
                    acc += cq - CUM[kj];
                    if (kj <= qi) {
                        const float mn = fmaxf(mx, acc), sc = __builtin_amdgcn_exp2f(mx - mn), p = __builtin_amdgcn_exp2f(acc - mn); mx = mn; l = l * sc + p;
#pragma unroll
                        for (int d4 = 0; d4 < 8; ++d4) { const f32x4 vv = *(const LAS f32x4*)(Vs + j * 64 + hf * 32 + d4 * 4);
                            o[4 * d4] = o[4 * d4] * sc + p * vv[0]; o[4 * d4 + 1] = o[4 * d4 + 1] * sc + p * vv[1]; o[4 * d4 + 2] = o[4 * d4 + 2] * sc + p * vv[2]; o[4 * d4 + 3] = o[4 * d4 + 3] * sc + p * vv[3]; }
                    }
                }
            }
            const float il = 1.0f / l;
#pragma unroll
            for (int c = 0; c < 4; ++c) { const u32x4 gw = *(const u32x4*)(OG + qrow * D + h * 64 + hf * 32 + c * 8); u32x4 w;
                w.x = pk2(o[8 * c] * il * bf_lo(gw.x), o[8 * c + 1] * il * bf_hi(gw.x)); w.y = pk2(o[8 * c + 2] * il * bf_lo(gw.y), o[8 * c + 3] * il * bf_hi(gw.y));
                w.z = pk2(o[8 * c + 4] * il * bf_lo(gw.z), o[8 * c + 5] * il * bf_hi(gw.z)); w.w = pk2(o[8 * c + 6] * il * bf_lo(gw.w), o[8 * c + 7] * il * bf_hi(gw.w));
                *(u32x4*)(A2 + qrow * D + h * 64 + hf * 32 + c * 8) = w; }
        }
        __syncthreads();
    }
}

#include <hip/hip_bf16.h>
namespace attn_body {
using bf16=__hip_bfloat16;
using bf16x8=__attribute__((ext_vector_type(8)))short;
using s16x4=__attribute__((ext_vector_type(4)))short;
using f32x16=__attribute__((ext_vector_type(16)))float;
using u32x4=__attribute__((ext_vector_type(4)))unsigned;
constexpr int BATCH=8,NHEAD=16,SEQ=4096,D=64,DM=NHEAD*D;
constexpr int NW=8,QBLK=32,QB=QBLK*NW,KVBLK=64,NQB=SEQ/QB;
constexpr int ATTN_PITCH=DM, ATTN_UNIT_ROWS=QB;
__device__ __forceinline__ int crow(int r,int hi){return (r&3)+8*(r>>2)+4*hi;}
#define SBAR() __builtin_amdgcn_sched_barrier(0)
__device__ __forceinline__ void cmask(f32x16&p0,f32x16&p1,int jb,int qrel,int hi){
  const float NEG=-INFINITY; int kb=64*jb+4*hi;
  #pragma unroll
  for(int r=0;r<16;++r){int kv=kb+(r&3)+8*(r>>2); if(kv>qrel)p0[r]=NEG; if(kv+32>qrel)p1[r]=NEG;}
}

constexpr int NSLOT=3, SLOTB=8192;
constexpr int LDS_K=0, LDS_V=NSLOT*SLOTB, LDS_WS=2*NSLOT*SLOTB, LDS_OST=LDS_WS+NW*64*4, LDS_CUM=LDS_OST+NW*4096, LDS_BYTES=LDS_CUM+SEQ*4;
constexpr float C2=0.125f*1.4426950408889634f;
__device__ __forceinline__ void glds16(const void*gsrc,unsigned lds_dst){unsigned keep;
  asm volatile("s_mov_b32 %0, m0\n\ts_mov_b32 m0, %2\n\ts_nop 0\n\tglobal_load_lds_dwordx4 %1, off\n\ts_mov_b32 m0, %0":"=&s"(keep):"v"(gsrc),"s"(lds_dst):"memory");}
__device__ __forceinline__ float max3f(float a,float b,float c){float r;asm("v_max3_f32 %0, %1, %2, %3":"=v"(r):"v"(a),"v"(b),"v"(c));return r;}
__device__ __forceinline__ float max2f(float a,float b){float r;asm("v_max_f32_e32 %0, %1, %2":"=v"(r):"v"(a),"v"(b));return r;}
__device__ __forceinline__ float fadd_s(float a,float b){float r;asm("v_add_f32_e32 %0, %1, %2":"=v"(r):"v"(a),"v"(b));return r;}
__device__ __forceinline__ float fsub_s(float a,float b){float r;asm("v_sub_f32_e32 %0, %1, %2":"=v"(r):"v"(a),"v"(b));return r;}
typedef float f32x2_t __attribute__((ext_vector_type(2))); typedef float f32x4_t __attribute__((ext_vector_type(4))); typedef __bf16 bf16x2_t __attribute__((ext_vector_type(2)));
__device__ __forceinline__ unsigned cvtpk_s(float lo,float hi){f32x2_t v={lo,hi};bf16x2_t b=__builtin_convertvector(v,bf16x2_t);return __builtin_bit_cast(unsigned,b);}
#define WAIT_BAR(N) asm volatile("s_waitcnt vmcnt(" #N ") lgkmcnt(0)\n\ts_barrier":::"memory")

__device__ __forceinline__ void qkt(f32x16&p0,f32x16&p1,const char*Kslot,const bf16x8*qr,const f32x16&negm,int r32,int hi){
  const char*kb=Kslot+hi*1024+r32*16;
  #pragma unroll
  for(int d0=0;d0<4;++d0){
    const bf16x8 b0=*reinterpret_cast<const bf16x8*>(kb+d0*2048);
    const bf16x8 b1=*reinterpret_cast<const bf16x8*>(kb+d0*2048+512);
    if(d0==0){p0=__builtin_amdgcn_mfma_f32_32x32x16_bf16(b0,qr[0],negm,0,0,0);p1=__builtin_amdgcn_mfma_f32_32x32x16_bf16(b1,qr[0],negm,0,0,0);}
    else{p0=__builtin_amdgcn_mfma_f32_32x32x16_bf16(b0,qr[d0],p0,0,0,0);p1=__builtin_amdgcn_mfma_f32_32x32x16_bf16(b1,qr[d0],p1,0,0,0);}}
}
typedef __attribute__((address_space(3))) const char* lds_cptr;
typedef short v4i16_t __attribute__((ext_vector_type(4)));
__device__ __forceinline__ void kload8(bf16x8*kf,lds_cptr kp){
  kf[0]=*(const __attribute__((address_space(3))) bf16x8*)(kp);      kf[1]=*(const __attribute__((address_space(3))) bf16x8*)(kp+512);
  kf[2]=*(const __attribute__((address_space(3))) bf16x8*)(kp+2048); kf[3]=*(const __attribute__((address_space(3))) bf16x8*)(kp+2560);
  kf[4]=*(const __attribute__((address_space(3))) bf16x8*)(kp+4096); kf[5]=*(const __attribute__((address_space(3))) bf16x8*)(kp+4608);
  kf[6]=*(const __attribute__((address_space(3))) bf16x8*)(kp+6144); kf[7]=*(const __attribute__((address_space(3))) bf16x8*)(kp+6656);
}
__device__ __forceinline__ void kload2(bf16x8*kf,lds_cptr kp,int j){ kf[2*j]=*(const __attribute__((address_space(3))) bf16x8*)(kp+j*2048); kf[2*j+1]=*(const __attribute__((address_space(3))) bf16x8*)(kp+j*2048+512); }
__device__ __forceinline__ s16x4 vtr(lds_cptr p){ return __builtin_bit_cast(s16x4,__builtin_amdgcn_ds_read_tr16_b64_v4i16((__attribute__((address_space(3))) v4i16_t*)p)); }
__device__ __forceinline__ float rowmax(const f32x16&p0,const f32x16&p1){
  float a=max3f(p0[0],p0[1],p1[0]),b=max3f(p0[2],p0[3],p1[1]);a=max3f(a,p1[2],p1[3]);
  #pragma unroll
  for(int r=4;r<16;r+=4){a=max3f(a,p0[r],p0[r+1]);b=max3f(b,p0[r+2],p0[r+3]);a=max3f(a,p1[r],p1[r+1]);b=max3f(b,p1[r+2],p1[r+3]);}
  const float m=max2f(a,b);
  auto rr=__builtin_amdgcn_permlane32_swap(__float_as_uint(m),__float_as_uint(m),false,false);
  return max2f(__uint_as_float(rr[0]),__uint_as_float(rr[1]));
}
__device__ __forceinline__ void pv(f32x16*o,int vb,bf16x8 pa0,bf16x8 pa1,bf16x8 pa2,bf16x8 pa3){
  #pragma unroll
  for(int d0=0;d0<2;++d0){s16x4 lo[4],hi[4];
    #pragma unroll
    for(int ks=0;ks<4;++ks){
      asm volatile("ds_read_b64_tr_b16 %0,%1 offset:%c2":"=&v"(lo[ks]):"v"(vb),"i"(d0*4096+ks*1024):"memory");
      asm volatile("ds_read_b64_tr_b16 %0,%1 offset:%c2":"=&v"(hi[ks]):"v"(vb),"i"(d0*4096+ks*1024+512):"memory");}
    asm volatile("s_waitcnt lgkmcnt(0)":::"memory");SBAR();
    #define PK(k) (bf16x8){lo[k][0],lo[k][1],lo[k][2],lo[k][3],hi[k][0],hi[k][1],hi[k][2],hi[k][3]}
    o[d0]=__builtin_amdgcn_mfma_f32_32x32x16_bf16(pa0,PK(0),o[d0],0,0,0);
    o[d0]=__builtin_amdgcn_mfma_f32_32x32x16_bf16(pa1,PK(1),o[d0],0,0,0);
    o[d0]=__builtin_amdgcn_mfma_f32_32x32x16_bf16(pa2,PK(2),o[d0],0,0,0);
    o[d0]=__builtin_amdgcn_mfma_f32_32x32x16_bf16(pa3,PK(3),o[d0],0,0,0);
    #undef PK
  }
}

#ifndef ATTN_STORE16
#define ATTN_STORE16(p,v) (*(u32x4*)(p)=(v))
#endif
constexpr float MFLOOR=-24.0f;
template<int THRL> __device__ __forceinline__ void attn_unit(int b,int h,int qb,int ts,const bf16*Q,const bf16*__restrict__ K,const bf16*__restrict__ V,const bf16*__restrict__ OG,bf16*O,char*shm){
  int tid=threadIdx.x; asm volatile("":"+v"(tid));
  const int lane=tid&63,r32=lane&31,hi=lane>>5; const int wid=__builtin_amdgcn_readfirstlane(tid>>6);
  const long rowbase=(long)b*SEQ; const int q0=qb*QB;
  const bf16*Qw=Q+(rowbase+q0+wid*QBLK)*DM+h*D;
  const bf16*Kh=K+(rowbase+(long)ts*KVBLK)*DM+h*D,*Vh=V+(rowbase+(long)ts*KVBLK)*DM+h*D;
  const lds_cptr shm3=(lds_cptr)shm;
  const unsigned lds0=(unsigned)(uintptr_t)shm;
  float*wsf=(float*)(shm+LDS_WS)+wid*64;
  const bf16*ksrc=Kh+(long)lane*DM+wid*8;
  const bf16*vsrc=Vh+(long)(16*(wid&3)+(lane>>2))*DM+(wid>>2)*32+(lane&3)*8;
  const unsigned kdst=lds0+LDS_K+wid*1024, vdst=lds0+LDS_V+wid*1024;
  #define DMA_K(t,slot) glds16(ksrc+(long)(t)*KVBLK*DM,(unsigned)__builtin_amdgcn_readfirstlane(kdst+(slot)))
  #define DMA_V(t,slot) glds16(vsrc+(long)(t)*KVBLK*DM,(unsigned)__builtin_amdgcn_readfirstlane(vdst+(slot)))
  const int vb0=(int)(lds0+LDS_V)+((lane>>4)&1)*32+(lane&3)*8+(4*hi+((lane&15)>>2))*64;
  const char*Kbase=shm+LDS_K; bf16x8 kf[8];
  const lds_cptr kp0=shm3+LDS_K+hi*1024+r32*16; const lds_cptr vp0=shm3+LDS_V+((lane>>4)&1)*32+(lane&3)*8+(4*hi+((lane&15)>>2))*64;
  const int NT=(q0+QB)/KVBLK-ts;
  DMA_K(0,0);DMA_V(0,0);DMA_K(1,SLOTB);
  bf16x8 qr[4];
  #pragma unroll
  for(int d0=0;d0<4;++d0)qr[d0]=*reinterpret_cast<const bf16x8*>(&Qw[(long)r32*DM+d0*16+hi*8]);
  const int qrel=wid*QBLK+r32;
  const __attribute__((address_space(3))) float* cum3=(const __attribute__((address_space(3))) float*)(shm3+LDS_CUM);
  const float cqv=cum3[q0+qrel];
  float mhat=0.f,l_reg=0.f;f32x16 o[2];o[0]=f32x16{};o[1]=f32x16{};f32x16 negm;
  _Pragma("unroll") for(int r=0;r<16;++r)negm[r]=cqv; asm volatile("":"+v"(negm));
  #define FBIAS(P0,P1,t) do{ const __attribute__((address_space(3))) float* cp_=cum3+((t)+ts)*KVBLK+4*hi; \
    _Pragma("unroll") for(int g_=0;g_<4;++g_){ const f32x4_t a_=*(const __attribute__((address_space(3))) f32x4_t*)(cp_+8*g_), b_=*(const __attribute__((address_space(3))) f32x4_t*)(cp_+32+8*g_); \
      P0[4*g_]-=a_[0];P0[4*g_+1]-=a_[1];P0[4*g_+2]-=a_[2];P0[4*g_+3]-=a_[3]; P1[4*g_]-=b_[0];P1[4*g_+1]-=b_[1];P1[4*g_+2]-=b_[2];P1[4*g_+3]-=b_[3]; } }while(0)
  #define CMASK(P0,P1,t) do{int jb_=(t)-(NT-4); if(jb_>=0)cmask(P0,P1,jb_,qrel,hi);}while(0)
  bool resc=false;
  #define START(P0,P1) do{ const float rm=rowmax(P0,P1); resc=false; \
    { const float dl=max2f(rm,MFLOOR); mhat=fadd_s(mhat,dl); \
      _Pragma("unroll") for(int r=0;r<16;++r){P0[r]=fsub_s(P0[r],dl);P1[r]=fsub_s(P1[r],dl);} \
      _Pragma("unroll") for(int r=0;r<16;++r)negm[r]=cqv-mhat; asm volatile("":"+v"(negm)); } \
    _Pragma("unroll") for(int r=0;r<16;++r)P0[r]=__builtin_amdgcn_exp2f(P0[r]); }while(0)
  #define RESC() do{ if(resc){ asm volatile("s_waitcnt lgkmcnt(0)":::"memory"); \
      _Pragma("unroll") for(int d_=0;d_<2;++d_) _Pragma("unroll") for(int r=0;r<16;++r)o[d_][r]*=wsf[crow(r,hi)]; } }while(0)
  f32x16 pA0,pA1,pB0,pB1;
  int sl_prev=0,sl_cur=0,sl_next=SLOTB;
  #define ROT() do{sl_prev=sl_cur;sl_cur=sl_next;sl_next=(sl_next==(NSLOT-1)*SLOTB)?0:sl_next+SLOTB;}while(0)
  DMA_K(2,2*SLOTB);
  WAIT_BAR(3);
  qkt(pA0,pA1,Kbase,qr,negm,r32,hi);asm volatile("s_nop 15\n\ts_nop 7":"+v"(pA0),"+v"(pA1));FBIAS(pA0,pA1,0);CMASK(pA0,pA1,0);
  START(pA0,pA1);
  _Pragma("unroll") for(int r=0;r<16;++r)pA1[r]=__builtin_amdgcn_exp2f(pA1[r]);
  WAIT_BAR(0);
  DMA_K(3,0);DMA_V(1,SLOTB);
  ROT();
  kload8(kf,kp0+sl_cur);
  WAIT_BAR(2);
  s16x4 vlo[8],vhi[8]; u32x4 pw0,pw1,pw2,pw3;
  #define PKW(P,B) cvtpk_s(P[B],P[B+1])
  #define PAF(k) __builtin_bit_cast(bf16x8,pw##k)
  #define VFR(i) (bf16x8){vlo[i][0],vlo[i][1],vlo[i][2],vlo[i][3],vhi[i][0],vhi[i][1],vhi[i][2],vhi[i][3]}
  #define PIN(x) asm volatile("":"+v"(x))
  #define MX3(a,b,c) __builtin_fmaxf(__builtin_fmaxf((a),(b)),(c))
  #define GAPA(MF,A0,A1,A2,A3,W0,W1,PW) do{ MF; sacc+=A0; sacc+=A1; sacc+=A2; sacc+=A3; PIN(sacc); W0; W1; PIN(PW); SBAR(); }while(0)
  #define EX(v) __builtin_amdgcn_exp2f(v)
  #define GAPB(MF,X,B) do{ MF; X[B]=EX(X[B]); X[B+1]=EX(X[B+1]); X[B+2]=EX(X[B+2]); X[B+3]=EX(X[B+3]); PIN(X); SBAR(); }while(0)
  #define VRD(i) do{ vlo[i]=vtr(vp_+(((i)>>2)*4096+((i)&3)*1024)); vhi[i]=vtr(vp_+(((i)>>2)*4096+((i)&3)*1024+512)); }while(0)
  #define KRD(G,j) do{ if(G){ kload2(kf,kp0+sl_next,j); SBAR(); } }while(0)
  #define STEP(C0,C1,P0,P1,t,GK,GV,GL) do{ SBAR(); \
    const lds_cptr vp_=vp0+sl_prev; \
    VRD(0); SBAR(); float sacc=(P0[0]+P0[1]); \
    GAPA(C0=__builtin_amdgcn_mfma_f32_32x32x16_bf16(kf[0],qr[0],negm,0,0,0), P0[2],P0[3],P0[4],P0[5],     pw0[0]=PKW(P0,0), pw0[1]=PKW(P0,2), pw0); \
    VRD(4); SBAR(); GAPA(C1=__builtin_amdgcn_mfma_f32_32x32x16_bf16(kf[1],qr[0],negm,0,0,0), P0[6],P0[7],P0[8],P0[9],     pw0[2]=PKW(P0,4), pw0[3]=PKW(P0,6), pw0); \
    VRD(1); SBAR(); GAPA(C0=__builtin_amdgcn_mfma_f32_32x32x16_bf16(kf[2],qr[1],C0,0,0,0),   P0[10],P0[11],P0[12],P0[13], pw1[0]=PKW(P0,8), pw1[1]=PKW(P0,10), pw1); \
    VRD(5); SBAR(); GAPA(C1=__builtin_amdgcn_mfma_f32_32x32x16_bf16(kf[3],qr[1],C1,0,0,0),   P0[14],P0[15],P1[0],P1[1],   pw1[2]=PKW(P0,12),pw1[3]=PKW(P0,14), pw1); \
    VRD(2); SBAR(); GAPA(C0=__builtin_amdgcn_mfma_f32_32x32x16_bf16(kf[4],qr[2],C0,0,0,0),   P1[2],P1[3],P1[4],P1[5],     pw2[0]=PKW(P1,0), pw2[1]=PKW(P1,2), pw2); \
    VRD(6); SBAR(); GAPA(C1=__builtin_amdgcn_mfma_f32_32x32x16_bf16(kf[5],qr[2],C1,0,0,0),   P1[6],P1[7],P1[8],P1[9],     pw2[2]=PKW(P1,4), pw2[3]=PKW(P1,6), pw2); \
    VRD(3); SBAR(); GAPA(C0=__builtin_amdgcn_mfma_f32_32x32x16_bf16(kf[6],qr[3],C0,0,0,0),   P1[10],P1[11],P1[12],P1[13], pw3[0]=PKW(P1,8), pw3[1]=PKW(P1,10), pw3); \
    VRD(7); SBAR(); GAPA(C1=__builtin_amdgcn_mfma_f32_32x32x16_bf16(kf[7],qr[3],C1,0,0,0),   P1[14],P1[15],0.f,0.f,       pw3[2]=PKW(P1,12),pw3[3]=PKW(P1,14), pw3); \
    l_reg+=sacc; \
    if(GK){DMA_K((t)+3,sl_cur);} if(GV){DMA_V((t)+1,sl_next);} \
    FBIAS(C0,C1,t); CMASK(C0,C1,t); \
    { float a=MX3(C0[0],C0[1],C1[0]),b=MX3(C0[2],C0[3],C1[1]); a=MX3(a,C1[2],C1[3]); \
      _Pragma("unroll") for(int r=4;r<16;r+=4){a=MX3(a,C0[r],C0[r+1]);b=MX3(b,C0[r+2],C0[r+3]);a=MX3(a,C1[r],C1[r+1]);b=MX3(b,C1[r+2],C1[r+3]);} \
      float rm=__builtin_fmaxf(a,b); { auto rr=__builtin_amdgcn_permlane32_swap(__float_as_uint(rm),__float_as_uint(rm),false,false); rm=__builtin_fmaxf(__uint_as_float(rr[0]),__uint_as_float(rr[1])); } \
      resc=false; \
      if(__builtin_expect(__any(rm>(float)THRL),0)){ const float dl=__builtin_fmaxf(rm,0.f); mhat+=dl; \
        _Pragma("unroll") for(int r=0;r<16;++r){C0[r]-=dl;C1[r]-=dl;} \
        _Pragma("unroll") for(int r=0;r<16;++r)negm[r]=cqv-mhat; asm volatile("":"+v"(negm)); \
        const float f=__builtin_amdgcn_exp2f(-dl); l_reg*=f; if(hi==0)wsf[r32]=f; resc=true; } } \
    SBAR(); \
    GAPB(o[0]=__builtin_amdgcn_mfma_f32_32x32x16_bf16(PAF(0),VFR(0),o[0],0,0,0), C0,0); \
    GAPB(o[1]=__builtin_amdgcn_mfma_f32_32x32x16_bf16(PAF(0),VFR(4),o[1],0,0,0), C0,4); \
    KRD(GL,0); GAPB(o[0]=__builtin_amdgcn_mfma_f32_32x32x16_bf16(PAF(1),VFR(1),o[0],0,0,0), C0,8); \
    KRD(GL,1); GAPB(o[1]=__builtin_amdgcn_mfma_f32_32x32x16_bf16(PAF(1),VFR(5),o[1],0,0,0), C0,12); \
    KRD(GL,2); GAPB(o[0]=__builtin_amdgcn_mfma_f32_32x32x16_bf16(PAF(2),VFR(2),o[0],0,0,0), C1,0); \
    KRD(GL,3); GAPB(o[1]=__builtin_amdgcn_mfma_f32_32x32x16_bf16(PAF(2),VFR(6),o[1],0,0,0), C1,4); \
    GAPB(o[0]=__builtin_amdgcn_mfma_f32_32x32x16_bf16(PAF(3),VFR(3),o[0],0,0,0), C1,8); \
    GAPB(o[1]=__builtin_amdgcn_mfma_f32_32x32x16_bf16(PAF(3),VFR(7),o[1],0,0,0), C1,12); \
    }while(0)
  int t=1;
  #undef CMASK
  #define CMASK(P0,P1,t) do{}while(0)
  for(;t+5<NT;t+=2){
    STEP(pB0,pB1,pA0,pA1,t,true,true,true);     WAIT_BAR(2); RESC(); ROT();
    STEP(pA0,pA1,pB0,pB1,t+1,true,true,true);   WAIT_BAR(2); RESC(); ROT();
  }
  #undef CMASK
  #define CMASK(P0,P1,t) do{int jb_=(t)-(NT-4); if(jb_>=0)cmask(P0,P1,jb_,qrel,hi);}while(0)
  #define ENDW(tt) do{ if((tt)+3<NT){WAIT_BAR(2);} else if((tt)+2<NT){WAIT_BAR(1);} else {WAIT_BAR(0);} }while(0)
  for(;t+1<NT;t+=2){
    STEP(pB0,pB1,pA0,pA1,t,(t+3<NT),(t+1<NT),(t+1<NT));       ENDW(t);   RESC(); ROT();
    STEP(pA0,pA1,pB0,pB1,t+1,(t+4<NT),(t+2<NT),(t+2<NT));     ENDW(t+1); RESC(); ROT();
  }
  STEP(pB0,pB1,pA0,pA1,NT-1,false,false,false); RESC();
  { float sacc=pB0[0]+pB0[1]; _Pragma("unroll") for(int r=2;r<16;++r)sacc+=pB0[r]; _Pragma("unroll") for(int r=0;r<16;++r)sacc+=pB1[r]; l_reg+=sacc;
    pw0=(u32x4){PKW(pB0,0),PKW(pB0,2),PKW(pB0,4),PKW(pB0,6)};pw1=(u32x4){PKW(pB0,8),PKW(pB0,10),PKW(pB0,12),PKW(pB0,14)};pw2=(u32x4){PKW(pB1,0),PKW(pB1,2),PKW(pB1,4),PKW(pB1,6)};pw3=(u32x4){PKW(pB1,8),PKW(pB1,10),PKW(pB1,12),PKW(pB1,14)};
    SBAR(); pv(o,vb0+sl_cur,PAF(0),PAF(1),PAF(2),PAF(3)); }
  #undef PKW
  #undef PAF
  #undef VFR
  #undef PIN
  #undef MX3
  #undef GAPA
  #undef GAPB
  #undef EX
  #undef VRD
  #undef KRD
  #undef STEP
  #undef ENDW
  {auto rr=__builtin_amdgcn_permlane32_swap(__float_as_uint(l_reg),__float_as_uint(l_reg),false,false);l_reg=__uint_as_float(rr[0])+__uint_as_float(rr[1]);}
  if(hi==0)wsf[32+r32]=l_reg;asm volatile("s_waitcnt lgkmcnt(0)":::"memory");
  float rli[16];
  #pragma unroll
  for(int r=0;r<16;++r)rli[r]=__builtin_amdgcn_rcpf(wsf[32+crow(r,hi)]);
  bf16*Ow=O+(rowbase+q0+wid*QBLK)*DM+h*D;
  { bf16*stg=(bf16*)(shm+LDS_OST)+wid*2048;
    #pragma unroll
    for(int r=0;r<16;++r){const int orow=crow(r,hi);
      #pragma unroll
      for(int d0=0;d0<2;++d0)stg[orow*64+d0*32+r32]=__float2bfloat16(o[d0][r]*rli[r]);}
    asm volatile("s_waitcnt lgkmcnt(0)":::"memory");
    const bf16*Gw=OG+(rowbase+q0+wid*QBLK)*DM+h*D;
    #pragma unroll
    for(int i=0;i<4;++i){const int row=i*8+(lane>>3),ch=lane&7; const u32x4 v=*(const u32x4*)(stg+row*64+ch*8); const u32x4 g=*(const u32x4*)(Gw+(long)row*DM+ch*8); u32x4 w;
      _Pragma("unroll") for(int e=0;e<4;++e){ const float lo=__uint_as_float(v[e]<<16)*__uint_as_float(g[e]<<16), hi2=__uint_as_float(v[e]&0xffff0000u)*__uint_as_float(g[e]&0xffff0000u); w[e]=cvtpk_s(lo,hi2); }
      ATTN_STORE16(Ow+(long)row*DM+ch*8,w);} }
  asm volatile("s_waitcnt lgkmcnt(0)\n\ts_barrier":::"memory");
  #undef DMA_K
  #undef DMA_V
  #undef CMASK
  #undef FBIAS
  #undef START
  #undef RESC
  #undef ROT
}
constexpr int ATTN_LDS_BYTES=LDS_BYTES;
struct AttnTensors { const bf16* Q; const bf16* K; const bf16* V; const bf16* G; bf16* O; };
struct AttnUnit { int bh; int qb; };
struct StaticOrder {
  int vcu;
  __device__ __forceinline__ explicit StaticOrder(int grid,int block):vcu((block%8)*(grid/8)+block/8){}
  __device__ __forceinline__ bool next(int i,AttnUnit&u)const{ if(i>=8)return false; const int s=2*(i>>1)+(vcu&1); u.bh=vcu>>1; u.qb=(i&1)?15-s:s; return true; }
  __device__ __forceinline__ void a_ready(const AttnUnit&)const{}
  __device__ __forceinline__ void done(const AttnUnit&)const{}
};
template<class Sched,int THRL=8> __device__ __forceinline__ void attn_phase(char*lds,const AttnTensors&T,const Sched&S){
  AttnUnit u;
  for(int i=0;S.next(i,u);++i){ S.a_ready(u); attn_unit<THRL>(u.bh/NHEAD,u.bh%NHEAD,u.qb,0,T.Q,T.K,T.V,T.G,T.O,lds); S.done(u); }
}
#undef SBAR
#undef WAIT_BAR
}

__device__ __forceinline__ void fox_cum_phase(LAS unsigned char* lds, const float* lf, float* cumg, int G) {
    const int tid = opaque_tid();
    LAS float* SCN = (LAS float*)lds;
    for (int bh = blockIdx.x; bh < NB * 16; bh += G) {
        const int b = bh >> 4, h = bh & 15;
        float loc[8]; float s = 0.f;
#pragma unroll
        for (int i = 0; i < 8; ++i) { s += lf[((size_t)b * SEQ + 8 * tid + i) * 16 + h]; loc[i] = s; }
        float ws_ = s;
        asm volatile("s_nop 1\n\t"
                     "v_add_f32_dpp %0, %0, %0 row_shr:1 row_mask:0xf bank_mask:0xf bound_ctrl:1\n\ts_nop 1\n\t"
                     "v_add_f32_dpp %0, %0, %0 row_shr:2 row_mask:0xf bank_mask:0xf bound_ctrl:1\n\ts_nop 1\n\t"
                     "v_add_f32_dpp %0, %0, %0 row_shr:4 row_mask:0xf bank_mask:0xf bound_ctrl:1\n\ts_nop 1\n\t"
                     "v_add_f32_dpp %0, %0, %0 row_shr:8 row_mask:0xf bank_mask:0xf bound_ctrl:1\n\ts_nop 1\n\t"
                     "v_add_f32_dpp %0, %0, %0 row_bcast:15 row_mask:0xa bank_mask:0xf\n\ts_nop 1\n\t"
                     "v_add_f32_dpp %0, %0, %0 row_bcast:31 row_mask:0xc bank_mask:0xf\n\ts_nop 1" : "+v"(ws_));
        __syncthreads();
        if ((tid & 63) == 63) SCN[tid >> 6] = ws_;
        __syncthreads();
        float base = ws_ - s;
        for (int w8 = 0; w8 < (tid >> 6); ++w8) base += SCN[w8];
        f32x4 o0, o1;
#pragma unroll
        for (int i = 0; i < 4; ++i) { o0[i] = (base + loc[i]) * LOG2E; o1[i] = (base + loc[4 + i]) * LOG2E; }
        *(f32x4*)(cumg + (size_t)bh * SEQ + 8 * tid) = o0; *(f32x4*)(cumg + (size_t)bh * SEQ + 8 * tid + 4) = o1;
    }
    __syncthreads();
}
__device__ __forceinline__ void fox_attn_phase(unsigned char* ldsg, LAS unsigned char* lds, const float* qg, const float* kg) {
    LAS float* CUM = (LAS float*)(lds + attn_body::LDS_CUM);
    LAS int* BC = (LAS int*)(lds + LDS_TAB);
    float gq = 0.f, gk = 0.f;
    for (int i = 0; i < 64; ++i) { gq = fmaxf(gq, fabsf(qg[i])); gk = fmaxf(gk, fabsf(kg[i])); }
    if (opaque_tid() == 0) ((LAS float*)BC)[2] = 2.0f * 64.0f * attn_body::C2 * gq * gk + 48.0f;
    __syncthreads();
#define Tskip (((const LAS float*)BC)[2])
    int cur_bh = -1;
    for (;;) {
        const int tid = opaque_tid();
        unsigned char* const wsb = karg_ws();
        const float* cumg = (const float*)(wsb + WS_CUMG);
        if (tid == 0) BC[0] = (int)atomicAdd((unsigned*)(wsb + WS_CTL) + CW_ATTQ, 1u);
        __syncthreads();
        const int u = __builtin_amdgcn_readfirstlane(BC[0]);
        if (u >= NB * 16 * 16) break;
        const int qb = 15 - (u >> 7), bh = u & 127;
        if (bh != cur_bh) { cur_bh = bh;
            *(LAS f32x4*)(CUM + 8 * tid) = *(const f32x4*)(cumg + (size_t)bh * SEQ + 8 * tid); *(LAS f32x4*)(CUM + 8 * tid + 4) = *(const f32x4*)(cumg + (size_t)bh * SEQ + 8 * tid + 4); }
        __syncthreads();
        if (tid < 64) { const int ntf = 4 * qb + 4; const bool dead = (tid < ntf) && (CUM[qb * 256] - CUM[64 * tid + 63] < -Tskip);
            const unsigned long long m = __ballot(dead);
            if (tid == 0) { int ts = __popcll(m) & ~1; ts = ts > ntf - 4 ? ntf - 4 : ts; BC[1] = ts; } }
        __syncthreads();
        const int ts = __builtin_amdgcn_readfirstlane(BC[1]);
        unsigned char* const sb = wsb + WS_SCR;
        attn_body::attn_unit<8>(bh >> 4, bh & 15, qb, ts, (const attn_body::bf16*)(sb + S_FQ), (const attn_body::bf16*)(sb + S_FK), (const attn_body::bf16*)(sb + S_FV), (const attn_body::bf16*)(sb + S_FG), (attn_body::bf16*)(sb + S_A2), (char*)ldsg);
    }
#undef Tskip
}

constexpr int PH_PER_LAYER = 8, N_PHASES = 1 + DEPTH * PH_PER_LAYER + 1;

__device__ __forceinline__ void moe_tab(LAS unsigned char* lds, const unsigned* cnt) {
    LAS int* TAB = (LAS int*)(lds + LDS_TAB);
    if (threadIdx.x == 0) { int s = 0; for (int e = 0; e < NE; ++e) { const int c = (int)cnt[e]; TAB[e] = s; TAB[16 + e] = c; s += (c + 255) >> 8; } TAB[8] = s; }
    __syncthreads();
}

__global__ void __launch_bounds__(NTHR, 2) mk_fwd(Args args) {
#define bWS (karg_ws())
#define bCTL ((unsigned*)(bWS + WS_CTL))
#define bMOD ((float*)(bWS + WS_MOD))
#define bX ((bf16_t*)(bWS + WS_X))
#define bH ((bf16_t*)(bWS + WS_H))
#define bY ((bf16_t*)(bWS + WS_Y))
#define bTOK ((int*)(bWS + WS_TOK))
#define bTINFO ((u32x4*)(bWS + WS_TINFO))
#define bLF ((float*)(bWS + WS_LF))
#define bSCR (bWS + WS_SCR)
#define bA2 ((bf16_t*)(bSCR + S_A2))
    extern __shared__ __attribute__((aligned(16))) unsigned char lds_raw[];
    LAS unsigned char* lds = (LAS unsigned char*)lds_raw;
    const int tid = threadIdx.x, G = gridDim.x;
    const int vcu = (G % 8 == 0) ? ((int)blockIdx.x % 8) * (G / 8) + (int)blockIdx.x / 8 : (int)blockIdx.x;
    if (tid < 8) ((volatile LAS unsigned*)(lds + LDS_MISC))[tid] = 0u;
    __syncthreads();
#if MK_N_LAUNCHES == 1
    XcdBarrier bar = xcd_barrier_post(bCTL + CW_BAR, (volatile LAS unsigned*)(lds + LDS_MISC));
#define SEAM() xcd_barrier(bar)
#else
#define SEAM() do { } while (0)
#endif
    const int lo = args.ph_lo, hi = args.ph_hi;
#define IN(k) (lo <= (k) && (k) < hi)
#define BOTH(k) (IN(k) && IN((k) + 1))

    if (IN(0)) for (int rep = 0; rep < NREP(0); ++rep) { phase_prologue(lds, args, vcu, G); if (BOTH(0)) SEAM(); }

    for (int L = 0; L < DEPTH; ++L) {
        const int pb = 1 + PH_PER_LAYER * L, mixer = L % 3, mj = L / 3, fj = L >> 1; const bool moe = (L & 1) != 0, prev_moe = (L > 0) && (((L - 1) & 1) != 0);
#define modL (bMOD + (size_t)L * NB * MOD_W)
#define modP (bMOD + (size_t)(L > 0 ? L - 1 : 0) * NB * MOD_W)
#define xin_first ((L == 0) ? karg_in(I_X) : (const float*)bX)
        if (IN(pb + 0)) for (int rep = 0; rep < NREP(pb + 0); ++rep) {
            NormArgs na{}; na.xin = xin_first; na.xout = (float*)bX; na.H = bH; na.sc = modL + D; na.sh = modL; na.combine = prev_moe; na.cscale = (float)(int)(ABLATE != 2 * (L - 1) + 1); na.Y = bY; na.tinfo = bTINFO; na.g2p = modP + 5 * D; na.cntp = bCTL + CW_CNT + 64 * ((L - 1) >> 1);
            if (mixer == 0) { na.wx = karg_in(I_GLA_WIN) + (size_t)mj * D * GLA_IN + 3072; na.wx_pitch = GLA_IN; na.w2 = karg_in(I_GLA_WG2) + (size_t)mj * 16 * 512; na.bvec = karg_in(I_GLA_BG) + mj * 512;
                na.Dk = (float*)(bSCR + S_DK); na.dref = (float*)(bSCR + S_DR); na.etot = (float*)(bSCR + S_ET); if (L == 0) norm_mfma2<1, true>(lds, na, opq(G)); else norm_mfma2<1, false>(lds, na, opq(G)); }
            else if (mixer == 1) { na.wx_pitch = CONV_FP8 ? -1 : 0; norm_phase<0>(lds, na, opq(G)); }
            else { na.wx = karg_in(I_FOX_WIN) + 3072; na.wx_pitch = FOX_IN; na.bvec = karg_in(I_FOX_BF); na.lf = bLF; norm_mfma2<2>(lds, na, opq(G)); }
            if (BOTH(pb + 0)) SEAM();
        }
        if (IN(pb + 1)) for (int rep = 0; rep < NREP(pb + 1); ++rep) {
            if (mixer == 0) {
                pg8::DenseSched S{NTOK / 256, 3072 / 256, opq(G), opq((int)blockIdx.x), 2 * D, (const char*)(bWS + W_GLA_IN + mj * SZ_GLA_IN)};
                pg8::EpiGlaIn E{(bf16_t*)(bSCR + S_QG), (bf16_t*)(bSCR + S_KD), (bf16_t*)(bSCR + S_V), (bf16_t*)(bSCR + S_R), (const float*)(bSCR + S_DK), (const float*)(bSCR + S_DR)};
                pg8::gemm_phase(lds, (const char*)bH, S, E);
            } else if (mixer == 1) {
                pg8::DenseSched S{NTOK / 256, 2048 / 256, opq(G), opq((int)blockIdx.x), CONV_FP8 ? D : 2 * D, (const char*)(bWS + W_CONV_IN)};
                pg8::EpiGated<1> E{(bf16_t*)bSCR, D, karg_in(I_CONV_BIN), 1024, CONV_FP8 ? 1.0f / F8_W13 : 1.0f, 1.0f};
                pg8::gemm_phase<pg8::EpiGated<1>, pg8::DenseSched, CONV_FP8 != 0>(lds, (const char*)bH, S, E);
            } else {
                if (rep == 0) fox_cum_phase(lds, bLF, (float*)(bWS + WS_CUMG), opq(G));
                { pg8::DenseSched S{NTOK / 256, FOX_BF_COLS / 256, opq(G), opq((int)blockIdx.x), 2 * D, (const char*)(bWS + W_FOX_IN)};
                  pg8::EpiFoxIn E{(bf16_t*)(bSCR + S_FQ), (bf16_t*)(bSCR + S_FK), (bf16_t*)(bSCR + S_FV), (bf16_t*)(bSCR + S_FG), karg_in(I_FOX_QN), karg_in(I_FOX_KN), 0, 1.0f};
                  pg8::gemm_phase(lds, (const char*)bH, S, E); }
                { pg8::DenseSched S{NTOK / 256, (4096 - FOX_BF_COLS) / 256, opq(G), opq((int)blockIdx.x), FOXG_FP8 ? D : 2 * D, (const char*)(bWS + W_FOX_IN + (size_t)FOX_BF_COLS * D * 2)};
                  pg8::EpiFoxIn E{(bf16_t*)(bSCR + S_FQ), (bf16_t*)(bSCR + S_FK), (bf16_t*)(bSCR + S_FV), (bf16_t*)(bSCR + S_FG), karg_in(I_FOX_QN), karg_in(I_FOX_KN), FOX_BF_COLS / 256, FOXG_FP8 ? 1.0f / F8_W13 : 1.0f};
                  pg8::gemm_phase<pg8::EpiFoxIn, pg8::DenseSched, FOXG_FP8 != 0>(lds, FOXG_FP8 ? (const char*)(bWS + WS_H8) : (const char*)bH, S, E); }
            }
            if (BOTH(pb + 1)) SEAM();
        }
        if (IN(pb + 2)) for (int rep = 0; rep < NREP(pb + 2); ++rep) {
            if (mixer == 0) gla_scan_mfma(lds, (const bf16_t*)(bSCR + S_QG), (const bf16_t*)(bSCR + S_KD), (const bf16_t*)(bSCR + S_V), (const float*)(bSCR + S_ET), (bf16_t*)(bSCR + S_O), opq(vcu), opq(G));
            else if (mixer == 1) conv_phase(lds, (const bf16_t*)bSCR, karg_in(I_CONV_DW), karg_in(I_CONV_DWB), karg_in(I_CONV_LNG), karg_in(I_CONV_LNB), bA2, opq(vcu), opq(G));
            else fox_attn_phase(lds_raw, lds, karg_in(I_FOX_QN), karg_in(I_FOX_KN));
            if (BOTH(pb + 2)) SEAM();
        }
        if (IN(pb + 3)) for (int rep = 0; rep < NREP(pb + 3); ++rep) {
            if (mixer == 0) { gla_gn_phase((const bf16_t*)(bSCR + S_O), (const bf16_t*)(bSCR + S_R), karg_in(I_GLA_GN) + mj * D, bA2, opq(vcu), opq(G)); if (BOTH(pb + 3)) SEAM(); }
        }
        if (IN(pb + 4)) for (int rep = 0; rep < NREP(pb + 4); ++rep) {
            const float* wsrc = nullptr; const float* bias = nullptr; size_t woff = 0;
            if (mixer == 0) woff = W_GLA_OUT + mj * SZ_SQ; else if (mixer == 1) { woff = W_CONV_OUT; bias = karg_in(I_CONV_BOUT); } else woff = W_FOX_OUT;
            (void)wsrc;
            pg8::DenseSched S{NTOK / 256, D / 256, opq(G), opq((int)blockIdx.x), 2 * D, (const char*)(bWS + woff)};
            pg8::EpiOut E{(L == 0) ? karg_in(I_X) : (const float*)nullptr, bX, bX, modL + 2 * D, bias, (float)(int)(ABLATE != 2 * L)};
            pg8::gemm_phase(lds, (const char*)bA2, S, E);
            if (BOTH(pb + 4)) SEAM();
        }
        if (IN(pb + 5)) for (int rep = 0; rep < NREP(pb + 5); ++rep) {
            NormArgs na{}; na.xin = (const float*)bX; na.xout = (float*)bX; na.H = bH; na.sc = modL + 4 * D; na.sh = modL + 3 * D; na.combine = false;
            if (!moe) { na.wx_pitch = FFN_FP8 ? -1 : 0; norm_phase<0>(lds, na, opq(G)); if (DUP_NORM == 1) { __syncthreads(); norm_phase<0>(lds, na, opq(G)); } }
            else { na.wx = karg_in(I_MOE_R) + (size_t)fj * D * NE; na.wx_pitch = NE; na.tok = bTOK; na.tinfo_out = bTINFO; na.cnt = bCTL + CW_CNT + 64 * fj; norm_mfma2<3>(lds, na, opq(G)); }
            if (BOTH(pb + 5)) SEAM();
        }
        if (IN(pb + 6)) for (int rep = 0; rep < NREP(pb + 6); ++rep) {
            if (!moe) {
                pg8::DenseSched S{NTOK / 256, 2 * DFF / 256, opq(G), opq((int)blockIdx.x), FFN_FP8 ? D : 2 * D, (const char*)(bWS + W_FFN13 + fj * SZ_FFN13)};
                pg8::EpiGated<0> E{(bf16_t*)bSCR, DFF, nullptr, DFF, FFN_FP8 ? 1.0f / F8_W13 : 1.0f, 1.0f};
                pg8::gemm_phase<pg8::EpiGated<0>, pg8::DenseSched, FFN_FP8 != 0>(lds, (const char*)bH, S, E);
            } else {
                moe_tab(lds, bCTL + CW_CNT + 64 * fj);
                const LAS int* TAB = (const LAS int*)(lds + LDS_TAB);
                pg8::MoeSched S{TAB[8], 2 * DFE / 256, opq(G), opq((int)blockIdx.x), MOE_FP8 ? D : 2 * D, (const char*)(bWS + W_MOE13 + (size_t)fj * 8 * MOE13_STRIDE), MOE13_STRIDE, bTOK, TAB};
                pg8::EpiGated<0, MOE_FP8 != 0> E{(bf16_t*)bSCR, DFE, nullptr, DFE, MOE_FP8 ? 1.0f / F8_W13 : 1.0f, F8_HID};
                pg8::gemm_phase<pg8::EpiGated<0, MOE_FP8 != 0>, pg8::MoeSched, MOE_FP8 != 0>(lds, (const char*)bH, S, E);
            }
            if (BOTH(pb + 6)) SEAM();
        }
        if (IN(pb + 7)) for (int rep = 0; rep < NREP(pb + 7); ++rep) {
            if (!moe) {
                pg8::DenseSched S{NTOK / 256, D / 256, opq(G), opq((int)blockIdx.x), 2 * DFF, (const char*)(bWS + W_FFN2 + fj * SZ_FFN2)};
                pg8::EpiOut E{nullptr, bX, bX, modL + 5 * D, nullptr, (float)(int)(ABLATE != 2 * L + 1)};
                pg8::gemm_phase(lds, (const char*)bSCR, S, E);
            } else {
                moe_tab(lds, bCTL + CW_CNT + 64 * fj);
                const LAS int* TAB = (const LAS int*)(lds + LDS_TAB);
                pg8::MoeSched S{TAB[8], D / 256, opq(G), opq((int)blockIdx.x), MOE_FP8 ? DFE : 2 * DFE, (const char*)(bWS + W_MOE2 + (size_t)fj * 8 * MOE2_STRIDE), MOE2_STRIDE, nullptr, TAB};
                pg8::EpiBf16 E{bY, D, MOE_FP8 ? 1.0f / (F8_HID * F8_W2) : 1.0f};
                pg8::gemm_phase<pg8::EpiBf16, pg8::MoeSched, MOE_FP8 != 0>(lds, (const char*)bSCR, S, E);
            }
            if (BOTH(pb + 7)) SEAM();
        }
    }
    if (IN(N_PHASES - 1)) {
        NormArgs na{}; na.xin = (const float*)bX; na.xout = (float*)bX; na.combine = true; na.cscale = (ABLATE == 7) ? 0.f : 1.f; na.Y = bY; na.tinfo = bTINFO; na.g2p = bMOD + (size_t)3 * NB * MOD_W + 5 * D; na.cntp = bCTL + CW_CNT + 64 * 1;
        na.gamma = karg_in(I_NORMF); na.out = args.out;
        norm_phase<4>(lds, na, G);
        if (DUP_NORM == 4) { __syncthreads(); norm_phase<4>(lds, na, G); }
    }
#undef IN
#undef BOTH
#undef SEAM
#undef bWS
#undef bCTL
#undef bMOD
#undef bX
#undef bH
#undef bY
#undef bTOK
#undef bTINFO
#undef bLF
#undef bSCR
#undef bA2
#undef modL
#undef modP
#undef xin_first
}


#ifdef DBG_CHECK
constexpr int CW_DBG = 20000;
__global__ void dbg_check_router(const float* X, const float* mod  , const float* router, const u32x4* tinfo, const int* tok, unsigned* flags) {
    const int row = blockIdx.x * blockDim.x + threadIdx.x; if (row >= NTOK) return;
    const int b = row / SEQ; const float* x = X + (size_t)row * D; const float* sc = mod + (size_t)b * MOD_W + 4 * D; const float* sh = mod + (size_t)b * MOD_W + 3 * D;
    float ss = 0.f; for (int k = 0; k < D; ++k) ss += x[k] * x[k];
    const float rstd = 1.0f / sqrtf(ss / D + EPS);
    float lg[8]; for (int n = 0; n < 8; ++n) lg[n] = 0.f;
    for (int k = 0; k < D; ++k) { const float h = x[k] * rstd * (1.0f + sc[k]) + sh[k]; for (int n = 0; n < 8; ++n) lg[n] += h * router[k * 8 + n]; }
    int e0 = 0; for (int n = 1; n < 8; ++n) if (lg[n] > lg[e0]) e0 = n;
    int e1 = -1; for (int n = 0; n < 8; ++n) if (n != e0 && (e1 < 0 || lg[n] > lg[e1])) e1 = n;
    float l2 = -1e30f; for (int n = 0; n < 8; ++n) if (n != e0 && n != e1 && lg[n] > l2) l2 = lg[n];
    const float g0 = 1.0f / (1.0f + expf(lg[e1] - lg[e0]));
    const u32x4 ti = tinfo[row]; const int k0 = ti.x >> 15, k1 = ti.y >> 15;
    const bool safe = (lg[e0] - lg[e1] > 1e-3f) && (lg[e1] - l2 > 1e-3f);
    if (safe && (k0 != e0 || k1 != e1)) atomicAdd(flags + 0, 1u);
    if (safe && fabsf(__uint_as_float(ti.z) - g0) > 2e-3f) atomicAdd(flags + 1, 1u);
    if (safe && fabsf(__uint_as_float(ti.w) - (1.0f - g0)) > 2e-3f) atomicAdd(flags + 1, 1u);
    if (tok[ti.x] != row || tok[ti.y] != row) atomicAdd(flags + 2, 1u);
}
#ifndef DBG_FLAG
#define DBG_FLAG 0
#endif
__global__ void dbg_report(const unsigned* flags, float* out) {
    if (threadIdx.x == 0 && blockIdx.x == 0) out[0] = 50.0f + (float)flags[DBG_FLAG];
}
#endif
extern "C" void kernel_launch(void* const* d_in, const int* in_sizes, int n_in, void* d_out, int out_size, void* d_ws, size_t ws_size, hipStream_t stream) {
    static int grid = 0;
    if (grid == 0) {
        if (n_in != 28 || in_sizes[0] != NTOK * D || out_size != NTOK * D || ws_size < WS_END) {
            fprintf(stderr, "kernel_launch: unexpected shapes (n_in %d, in0 %d, out %d, ws %zu, need %zu); nothing launched\n", n_in, n_in > 0 ? in_sizes[0] : -1, out_size, ws_size, (size_t)WS_END); grid = -1; return; }
        int dev = 0, cus = 0, per_cu = 0;
        if (hipGetDevice(&dev) != hipSuccess || hipDeviceGetAttribute(&cus, hipDeviceAttributeMultiprocessorCount, dev) != hipSuccess) { grid = -1; return; }
        if (hipFuncSetAttribute((const void*)mk_fwd, hipFuncAttributeMaxDynamicSharedMemorySize, LDS_BYTES) != hipSuccess) { fprintf(stderr, "kernel_launch: hipFuncSetAttribute failed\n"); grid = -1; return; }
        if (hipOccupancyMaxActiveBlocksPerMultiprocessor(&per_cu, (const void*)mk_fwd, NTHR, LDS_BYTES) != hipSuccess || per_cu < 1)
            fprintf(stderr, "kernel_launch: note: occupancy query reports %d workgroups per CU\n", per_cu);
        (void)hipGetLastError();
        grid = cus;
    }
    if (grid < 0) return;
    if (hipMemsetAsync((char*)d_ws + WS_CTL, 0, CTL_ZERO_BYTES, stream) != hipSuccess) return;
    Args a{};
    for (int i = 0; i < 28; ++i) a.in[i] = (const float*)d_in[i];
    a.out = (float*)d_out; a.ws = (unsigned char*)d_ws;
#if MK_N_LAUNCHES == 1
    a.ph_lo = 0; a.ph_hi = N_PHASES;
    hipLaunchKernelGGL(mk_fwd, dim3(grid), dim3(NTHR), LDS_BYTES, stream, a);
#else
    for (int p = 0; p < N_PHASES; ++p) {
        const int L = (p - 1) / PH_PER_LAYER, slot = (p - 1) % PH_PER_LAYER;
        if (p >= 1 && p < N_PHASES - 1 && slot == 3 && (L % 3) != 0) continue;
        a.ph_lo = p; a.ph_hi = p + 1;
        hipLaunchKernelGGL(mk_fwd, dim3(grid), dim3(NTHR), LDS_BYTES, stream, a);
#ifdef DBG_CHECK
        if (p >= 1 && p < N_PHASES - 1 && slot == 5 && (L & 1)) {
            unsigned char* ws = (unsigned char*)d_ws;
            hipLaunchKernelGGL(dbg_check_router, dim3(NTOK / 256), dim3(256), 0, stream, (const float*)(ws + WS_X), (const float*)(ws + WS_MOD) + (size_t)L * NB * MOD_W, a.in[I_MOE_R] + (size_t)(L >> 1) * D * NE,
                               (const u32x4*)(ws + WS_TINFO), (const int*)(ws + WS_TOK), (unsigned*)(ws + WS_CTL) + CW_DBG + 4 * (L >> 1));
        }
#endif
    }
#ifdef DBG_CHECK
    hipLaunchKernelGGL(dbg_report, dim3(1), dim3(64), 0, stream, (const unsigned*)((unsigned char*)d_ws + WS_CTL) + CW_DBG, (float*)d_out);
#endif
#endif
}
```
